# Optimizing an MI355X kernel written in HIP

```python
import math
import jax, jax.numpy as jnp
from jax import lax
import numpy as np

D_MODEL = 1024
BATCH = 8
SEQ = 4096
DEPTH = 1
DEC_BATCH = 8
DEC_SEQ = 64
PAST_LEN = 2048

CHUNK = 64
GMLP_CHUNK = 128
GMLP_GROUPS = 4
GMLP_HEAD = 128
GMLP_WIDTH = GMLP_GROUPS * GMLP_HEAD
N_HEADS = 8
QK_NOPE = 64
QK_ROPE = 32
QK_HEAD = QK_NOPE + QK_ROPE
V_HEAD = 64
Q_LORA = 384
KV_LORA = 256
MLA_WIDTH = N_HEADS * V_HEAD
MIX_WIDTH = GMLP_WIDTH + MLA_WIDTH
IN_WIDTH = 2 * GMLP_WIDTH + Q_LORA + KV_LORA + QK_ROPE
IN_SPLITS = (GMLP_WIDTH, 2 * GMLP_WIDTH, 2 * GMLP_WIDTH + Q_LORA, 2 * GMLP_WIDTH + Q_LORA + KV_LORA)
D_FF = -(-8 * D_MODEL // (3 * 256)) * 256
ROPE_THETA = 10000.0
EPS = 1e-6
Q_BLOCK = 128
SCALE = QK_HEAD ** -0.5

kernel_name = 'hybrid_gmlp_mla_streaming_step'


def rmsnorm(x, g):
    xf = x.astype(jnp.float32)
    y = xf * lax.rsqrt(jnp.mean(xf * xf, axis=-1, keepdims=True) + EPS)
    return (y * g.astype(jnp.float32)).astype(x.dtype)


def rope(x, pos):
    half = QK_ROPE // 2
    inv = ROPE_THETA ** (-jnp.arange(half, dtype=jnp.float32) / half)
    ang = pos.astype(jnp.float32)[:, None] * inv[None, :]
    ang = ang.reshape(ang.shape[:1] + (1,) * (x.ndim - 3) + (half,))
    cos, sin = jnp.cos(ang), jnp.sin(ang)
    xf = x.astype(jnp.float32)
    x1, x2 = xf[..., :half], xf[..., half:]
    return jnp.concatenate([x1 * cos - x2 * sin, x2 * cos + x1 * sin], axis=-1).astype(x.dtype)


def ada_modulation(c, w, b):
    m = jax.nn.silu(c) @ w + b
    return jnp.split(m[:, None, :], 6, axis=-1)


def gmlp_mix(u, v, w_s, b_s):
    B, T, _ = v.shape
    L = min(T, GMLP_CHUNK)
    n = T // L
    p = jnp.arange(L)
    mask = (p[None, :] // CHUNK) <= (p[:, None] // CHUNK)
    ws = jnp.where(mask[None], w_s[:, :L, :L], 0.0)
    vc = v.reshape(B, n, L, GMLP_GROUPS, GMLP_HEAD)
    mixed = jnp.einsum('gij,bnjgc->bnigc', ws, vc) + b_s[:, :L].T[None, None, :, :, None]
    return u * mixed.reshape(B, T, GMLP_WIDTH)


def mla_queries(c_q, pos, q_norm_g, w_uq, qn_g, qr_g):
    B, T, _ = c_q.shape
    q = (rmsnorm(c_q, q_norm_g) @ w_uq).reshape(B, T, N_HEADS, QK_HEAD)
    q_nope = rmsnorm(q[..., :QK_NOPE], qn_g)
    q_rope = rope(rmsnorm(q[..., QK_NOPE:], qr_g), pos)
    return jnp.concatenate([q_nope, q_rope], axis=-1)


def mla_keys_values(ckv, krope, w_ukv, kn_g):
    B, S, _ = ckv.shape
    kv = (ckv @ w_ukv).reshape(B, S, N_HEADS, QK_NOPE + V_HEAD)
    k_nope = rmsnorm(kv[..., :QK_NOPE], kn_g)
    k = jnp.concatenate([k_nope, jnp.broadcast_to(krope[:, :, None, :], (B, S, N_HEADS, QK_ROPE))], axis=-1)
    return k, kv[..., QK_NOPE:]


def attend(q, k, v, q_pos, k_pos):
    s = jnp.einsum('bqhd,bkhd->bhqk', q, k).astype(jnp.float32) * SCALE
    mask = (k_pos[None, :] // CHUNK) <= (q_pos[:, None] // CHUNK)
    s = jnp.where(mask[None, None], s, jnp.finfo(jnp.float32).min)
    p = jax.nn.softmax(s, axis=-1).astype(v.dtype)
    return jnp.einsum('bhqk,bkhd->bqhd', p, v)


def prompt_attention(q, k, v):
    B, T, H, Dk = q.shape
    nb = T // Q_BLOCK
    qb = q.reshape(B, nb, Q_BLOCK, H, Dk).transpose(1, 0, 2, 3, 4)
    k_pos = jnp.arange(T)

    def block(args):
        qi, i = args
        q_pos = i * Q_BLOCK + jnp.arange(Q_BLOCK)
        return attend(qi, k, v, q_pos, k_pos)

    out = lax.map(block, (qb, jnp.arange(nb)))
    return out.transpose(1, 0, 2, 3, 4).reshape(B, T, MLA_WIDTH)


def trunk_layer(x, c, pos, past, w):
    B, T, _ = x.shape
    sh1, sc1, g1, sh2, sc2, g2 = ada_modulation(c, w['w_ada'], w['b_ada'])
    h = rmsnorm(x, w['norm1_g']) * (1.0 + sc1) + sh1
    z = h @ w['w_in']
    u, v, c_q, c_kv, k_r = jnp.split(z, IN_SPLITS, axis=-1)
    u = jax.nn.gelu(u)
    v = jax.nn.gelu(v)
    y_a = gmlp_mix(u, v, w['w_s'], w['b_s'])
    q = mla_queries(c_q, pos, w['q_norm_g'], w['w_uq'], w['qn_g'], w['qr_g'])
    ckv = rmsnorm(c_kv, w['kv_norm_g'])
    krope = rope(rmsnorm(k_r, w['kr_g']), pos)
    if past is None:
        k, vv = mla_keys_values(ckv, krope, w['w_ukv'], w['kn_g'])
        y_b = prompt_attention(q, k, vv)
    else:
        ckv_all = jnp.concatenate([past[0], ckv], axis=1)
        krope_all = jnp.concatenate([past[1], krope], axis=1)
        k, vv = mla_keys_values(ckv_all, krope_all, w['w_ukv'], w['kn_g'])
        k_pos = jnp.arange(ckv_all.shape[1])
        y_b = attend(q, k, vv, pos, k_pos).reshape(B, T, MLA_WIDTH)
    x = x + g1 * (jnp.concatenate([y_a, y_b], axis=-1) @ w['w_out'])
    h2 = rmsnorm(x, w['norm2_g']) * (1.0 + sc2) + sh2
    gate, up = jnp.split(h2 @ w['w_ffn_in'], 2, axis=-1)
    x = x + g2 * ((jax.nn.silu(gate) * up) @ w['w_ffn_out'])
    return x, ckv, krope, v


def setup_inputs(seed: int = 0) -> dict:
    key = jax.random.key(seed)
    ks = jax.random.split(key, 24)

    def nrm(k, shape, scale):
        return jax.random.normal(k, shape, jnp.float32) * scale

    def gain(k, n):
        return 1.0 + 0.1 * jax.random.normal(k, (DEPTH, n), jnp.float32)

    L = DEPTH
    return {
        'x_prompt': nrm(ks[0], (BATCH, SEQ, D_MODEL), 1.0),
        'x_sample': nrm(ks[1], (DEC_BATCH, DEC_SEQ, D_MODEL), 1.0),
        'cache_ckv': nrm(ks[2], (L, DEC_BATCH, PAST_LEN, KV_LORA), 1.0),
        'cache_krope': nrm(ks[3], (L, DEC_BATCH, PAST_LEN, QK_ROPE), 1.0),
        'c_prompt': nrm(ks[4], (BATCH, D_MODEL), 1.0),
        'c_sample': nrm(ks[5], (DEC_BATCH, D_MODEL), 1.0),
        'w_ada': nrm(ks[6], (L, D_MODEL, 6 * D_MODEL), 0.5 * D_MODEL ** -0.5),
        'b_ada': nrm(ks[7], (L, 6 * D_MODEL), 0.02),
        'norm1_g': gain(ks[8], D_MODEL),
        'w_in': nrm(ks[9], (L, D_MODEL, IN_WIDTH), D_MODEL ** -0.5),
        'w_s': nrm(ks[10], (L, GMLP_GROUPS, GMLP_CHUNK, GMLP_CHUNK), GMLP_CHUNK ** -0.5),
        'b_s': 1.0 + nrm(ks[11], (L, GMLP_GROUPS, GMLP_CHUNK), 0.1),
        'q_norm_g': gain(ks[12], Q_LORA),
        'w_uq': nrm(ks[13], (L, Q_LORA, N_HEADS * QK_HEAD), Q_LORA ** -0.5),
        'kv_norm_g': gain(ks[14], KV_LORA),
        'w_ukv': nrm(ks[15], (L, KV_LORA, N_HEADS * (QK_NOPE + V_HEAD)), KV_LORA ** -0.5),
        'qn_g': gain(ks[16], QK_NOPE),
        'qr_g': gain(ks[17], QK_ROPE),
        'kn_g': gain(ks[18], QK_NOPE),
        'kr_g': gain(ks[19], QK_ROPE),
        'w_out': nrm(ks[20], (L, MIX_WIDTH, D_MODEL), MIX_WIDTH ** -0.5),
        'norm2_g': gain(ks[21], D_MODEL),
        'w_ffn_in': nrm(ks[22], (L, D_MODEL, 2 * D_FF), D_MODEL ** -0.5),
        'w_ffn_out': nrm(ks[23], (L, D_FF, D_MODEL), D_FF ** -0.5),
    }


def reference(x_prompt, x_sample, cache_ckv, cache_krope, c_prompt, c_sample, w_ada, b_ada, norm1_g, w_in, w_s, b_s, q_norm_g, w_uq, kv_norm_g, w_ukv, qn_g, qr_g, kn_g, kr_g, w_out, norm2_g, w_ffn_in, w_ffn_out):
    past_len = cache_ckv.shape[2]
    pos_p = jnp.arange(x_prompt.shape[1])
    pos_s = past_len + jnp.arange(x_sample.shape[1])
    yp, ys = x_prompt, x_sample
    ckv_p, kr_p, ckv_s, kr_s, v_s = [], [], [], [], []
    for l in range(DEPTH):
        w = dict(w_ada=w_ada[l], b_ada=b_ada[l], norm1_g=norm1_g[l], w_in=w_in[l], w_s=w_s[l], b_s=b_s[l],
                 q_norm_g=q_norm_g[l], w_uq=w_uq[l], kv_norm_g=kv_norm_g[l], w_ukv=w_ukv[l],
                 qn_g=qn_g[l], qr_g=qr_g[l], kn_g=kn_g[l], kr_g=kr_g[l], w_out=w_out[l],
                 norm2_g=norm2_g[l], w_ffn_in=w_ffn_in[l], w_ffn_out=w_ffn_out[l])
        yp, a_ckv, a_kr, _ = trunk_layer(yp, c_prompt, pos_p, None, w)
        ys, b_ckv, b_kr, b_v = trunk_layer(ys, c_sample, pos_s, (cache_ckv[l], cache_krope[l]), w)
        ckv_p.append(a_ckv)
        kr_p.append(a_kr)
        ckv_s.append(b_ckv)
        kr_s.append(b_kr)
        v_s.append(b_v)
    return (yp, ys, jnp.stack(ckv_p), jnp.stack(kr_p), jnp.stack(ckv_s), jnp.stack(kr_s), jnp.stack(v_s))
```

```cpp
#include <hip/hip_runtime.h>
#include <hip/hip_cooperative_groups.h>
#include <cstdio>
#include <cstdint>
namespace cg = cooperative_groups;

#define LAS __attribute__((address_space(3)))
typedef unsigned short bf16_t;
typedef short bf16x8 __attribute__((ext_vector_type(8)));
typedef short s16x4 __attribute__((ext_vector_type(4)));
typedef float f32x4 __attribute__((ext_vector_type(4)));
typedef float f32x16 __attribute__((ext_vector_type(16)));
typedef unsigned u32x4 __attribute__((ext_vector_type(4)));
typedef unsigned u32x2 __attribute__((ext_vector_type(2)));

constexpr int MP = 32768, MS = 512, MT = MP + MS;
constexpr int DM = 1024, DFF = 2816;
constexpr int KVR = MP + 8 * 2112;
constexpr float EPS = 1e-6f;
constexpr float QSCALE = 0.10206207261596577f * 1.4426950408889634f;
constexpr size_t OFF_CKVP = 34078720, OFF_KRP = 42467328, OFF_CKVS = 43515904, OFF_KRS = 43646976, OFF_VS = 43663360;

constexpr size_t MiB = 1u << 20;
constexpr size_t WS_MOD = 0, WS_ROPE = 512 * 1024, WS_SSQ = 1 * MiB, WS_WM = 3 * MiB, WS_WIN = 4 * MiB, WS_WUQ = 8 * MiB, WS_WUKV = 9 * MiB,
                 WS_WOUT = 10 * MiB, WS_WFI = 12 * MiB, WS_WFO = 23 * MiB, WS_H = 29 * MiB, WS_YAB = 94 * MiB, WS_G = 159 * MiB,
                 WS_U = 159 * MiB, WS_VT = 192 * MiB, WS_CQ = 225 * MiB, WS_CKV = 250 * MiB, WS_KR = 275 * MiB, WS_KN = 279 * MiB,
                 WS_VVT = 328 * MiB, WS_Q = 377 * MiB, WS_END = 450 * MiB, WS_CTR = 3 * MiB - 4096, WS_BAR = 3 * MiB - 32768, WS_PART = 426 * MiB, WS_X1B = 345 * MiB;

constexpr int LDS_BYTES = 147456;
constexpr int LDS_X = 131072;

__device__ __forceinline__ unsigned cvt_pk_bf16(float lo, float hi) { unsigned r; asm("v_cvt_pk_bf16_f32 %0, %1, %2" : "=v"(r) : "v"(lo), "v"(hi)); return r; }
__device__ __forceinline__ float bf2f(unsigned short h) { return __uint_as_float(((unsigned)h) << 16); }
__device__ __forceinline__ float gelu_tanh(float x) {
    const float y2 = 1.5957691216057308f * x * (1.f + 0.044715f * x * x);
    const float e = __builtin_amdgcn_exp2f(-y2 * 1.4426950408889634f);
    return x * __builtin_amdgcn_rcpf(1.f + e);
}
__device__ __forceinline__ float silu_f(float x) { const float e = __builtin_amdgcn_exp2f(-x * 1.4426950408889634f); return x * __builtin_amdgcn_rcpf(1.f + e); }
__device__ __forceinline__ float wave_sum(float v) {
#pragma unroll
    for (int o = 1; o < 64; o <<= 1) v += __shfl_xor(v, o);
    return v;
}
typedef float f32x2 __attribute__((ext_vector_type(2)));
__device__ __forceinline__ float max3f(float a, float b, float c) { float r; asm("v_max3_f32 %0, %1, %2, %3" : "=v"(r) : "v"(a), "v"(b), "v"(c)); return r; }
#define LDS_WAIT() asm volatile("s_waitcnt lgkmcnt(0)" ::: "memory")
__device__ __forceinline__ int fresh_tid() { int t = threadIdx.x; asm volatile("" : "+v"(t)); return t; }

namespace pg8 {
constexpr int BM = 256, BK = 64, HALF = 128, HTB = HALF * BK * 2, STAGE_BYTES = 8 * HTB, NXCD = 8, WGM = 8;
__host__ __device__ __forceinline__ int lds_byte(int r, int c) { const int st = (r >> 4) * 2 + (c >> 5), rr = r & 15, cc = c & 31, ob = rr * 64 + cc * 2; return st * 1024 + (ob ^ (((ob >> 9) & 1) << 5)); }
__host__ __device__ __forceinline__ void stage_rc(int b, int& R, int& C) { const int st = b / 1024, sb = b % 1024, swz = sb ^ (((sb >> 9) & 1) << 5); R = (st >> 1) * 16 + swz / 64; C = (st & 1) * 32 + (swz % 64) / 2; }
__host__ __device__ __forceinline__ int perm32(int rho) { const int n = rho >> 4, i = rho & 15; return 8 * (i >> 2) + 4 * n + (i & 3); }

struct Unit { int pm, pn, kind; };
__device__ __forceinline__ int xcd_map(int L, int nwg) { const int q = nwg / NXCD, r = nwg % NXCD, xcd = L % NXCD, off = L / NXCD; return (xcd < r ? xcd * (q + 1) : r * (q + 1) + (xcd - r) * q) + off; }
__device__ __forceinline__ void grouped(int wgid, int nM, int nN, int& pm, int& pn) {
    const int nig = WGM * nN, gid = wgid / nig, fm = gid * WGM, gsz = (nM - fm) < WGM ? (nM - fm) : WGM;
    pm = fm + ((wgid % nig) % gsz); pn = (wgid % nig) / gsz;
}
template <class Prog>
__device__ __forceinline__ void gemm_phase(LAS unsigned char* lds, const Prog& P) {
    const int tid = fresh_tid(), wid = __builtin_amdgcn_readfirstlane(tid >> 6), lane = tid & 63, wr = wid >> 2, wc = wid & 3, fr = lane & 15, fq = lane >> 4;
    const int lda = P.lda, ldb = P.ldb;
    unsigned voffA[2], voffB[2];
#pragma unroll
    for (int i = 0; i < 2; ++i) { int R, C; stage_rc(tid * 16 + i * 8192, R, C); const int Rb = (R & ~31) + perm32(R & 31);
        voffA[i] = (unsigned)(R * lda + C) * 2u; voffB[i] = (unsigned)(Rb * ldb + C) * 2u; }
    const size_t kstep = (size_t)(BK * 2);
    const size_t hstepA = (size_t)HALF * lda * 2, hstepB = (size_t)HALF * ldb * 2;
    const unsigned ldsw = (unsigned)wid * 1024u;
    const int aoff = lds_byte(wr * 64 + fr, fq * 8), boff = lds_byte(wc * 32 + fr, fq * 8);
#define PG8_SA(b, h) (((b) * 2 + (h)) * HTB)
#define PG8_SB(b, h) ((4 + (b) * 2 + (h)) * HTB)
#define PG8_STAGE(bufoff, gbase, voff) do { _Pragma("unroll") for (int _i = 0; _i < 2; ++_i) \
        __builtin_amdgcn_global_load_lds((const unsigned*)((const char*)(gbase) + (voff)[_i]), (LAS unsigned*)(lds + (bufoff) + ldsw + _i * 8192), 16, 0, 0); } while (0)
#define PG8_LDA(dst, b, h) do { _Pragma("unroll") for (int m = 0; m < 4; ++m) _Pragma("unroll") for (int k = 0; k < 2; ++k) dst[m][k] = *(const LAS bf16x8*)(lds + PG8_SA(b, h) + aoff + m * 2048 + k * 1024); } while (0)
#define PG8_LDB(dst, b, h) do { _Pragma("unroll") for (int n = 0; n < 2; ++n) _Pragma("unroll") for (int k = 0; k < 2; ++k) dst[n][k] = *(const LAS bf16x8*)(lds + PG8_SB(b, h) + boff + n * 2048 + k * 1024); } while (0)
#define PG8_MMA(ai, bj, At, Bt) do { __builtin_amdgcn_s_setprio(1); _Pragma("unroll") for (int m = 0; m < 4; ++m) _Pragma("unroll") for (int n = 0; n < 2; ++n) _Pragma("unroll") for (int k = 0; k < 2; ++k) \
        acc[ai][bj][m][n] = __builtin_amdgcn_mfma_f32_16x16x32_bf16(Bt[n][k], At[m][k], acc[ai][bj][m][n], 0, 0, 0); __builtin_amdgcn_s_setprio(0); } while (0)
#define PG8_WAIT_V(n) asm volatile("s_waitcnt vmcnt(" #n ")" ::: "memory")
#define PG8_WAIT_L(n) asm volatile("s_waitcnt lgkmcnt(" #n ")" ::: "memory")
#define PG8_BAR __builtin_amdgcn_s_barrier()
#define PG8_SCHED __builtin_amdgcn_sched_barrier(0)
    Unit cur, nxt; int ui = 0;
    if (!P.next(0, cur)) return;
    f32x4 acc[2][2][4][2];
#pragma unroll
    for (int a = 0; a < 2; ++a)
#pragma unroll
        for (int b = 0; b < 2; ++b)
#pragma unroll
            for (int m = 0; m < 4; ++m)
#pragma unroll
                for (int n = 0; n < 2; ++n) acc[a][b][m][n] = (f32x4){0.f, 0.f, 0.f, 0.f};
    bf16x8 At[4][2], B0[2][2], B1[2][2];
    const char* cA = P.aptr(cur); const char* cB = P.bptr(cur);
    PG8_STAGE(PG8_SB(0, 0), cB, voffB); PG8_STAGE(PG8_SB(0, 1), cB + hstepB, voffB); PG8_STAGE(PG8_SA(0, 0), cA, voffA); PG8_STAGE(PG8_SA(0, 1), cA + hstepA, voffA);
    if (wr == 1) PG8_BAR;
    PG8_WAIT_V(2); PG8_BAR;
    PG8_STAGE(PG8_SB(1, 0), cB + kstep, voffB); PG8_STAGE(PG8_SA(1, 0), cA + kstep, voffA); PG8_STAGE(PG8_SB(1, 1), cB + hstepB + kstep, voffB);
    PG8_WAIT_V(6); PG8_BAR;
    for (;;) {
        const bool has_next = P.next(ui + 1, nxt);
        const int nt = P.nt(cur);
        const char* nA = has_next ? P.aptr(nxt) : cA; const char* nB = has_next ? P.bptr(nxt) : cB;
        for (int t = 0; t < nt; t += 2) {
            const bool last = (t == nt - 2);
            const char* a1 = cA + (size_t)(t + 1) * kstep;
            const char* a2 = last ? nA : cA + (size_t)(t + 2) * kstep; const char* b2 = last ? nB : cB + (size_t)(t + 2) * kstep;
            const char* a3 = a2 + kstep; const char* b3 = b2 + kstep;
            PG8_LDB(B0, 0, 0); PG8_LDB(B1, 0, 1); PG8_SCHED; PG8_LDA(At, 0, 0); PG8_STAGE(PG8_SA(1, 1), a1 + hstepA, voffA);
            PG8_WAIT_V(8); PG8_WAIT_L(0); PG8_BAR; PG8_MMA(0, 0, At, B0); PG8_MMA(0, 1, At, B1); PG8_BAR; PG8_SCHED;
            PG8_LDA(At, 0, 1); PG8_STAGE(PG8_SB(0, 0), b2, voffB); PG8_STAGE(PG8_SB(0, 1), b2 + hstepB, voffB); PG8_STAGE(PG8_SA(0, 0), a2, voffA);
            PG8_WAIT_V(8); PG8_WAIT_L(0); PG8_BAR; PG8_MMA(1, 0, At, B0); PG8_MMA(1, 1, At, B1); PG8_BAR; PG8_SCHED;
            PG8_LDB(B0, 1, 0); PG8_LDB(B1, 1, 1); PG8_SCHED; PG8_LDA(At, 1, 0); PG8_STAGE(PG8_SA(0, 1), a2 + hstepA, voffA);
            PG8_WAIT_V(8); PG8_WAIT_L(0); PG8_BAR; PG8_MMA(0, 0, At, B0); PG8_MMA(0, 1, At, B1); PG8_BAR; PG8_SCHED;
            PG8_LDA(At, 1, 1); PG8_STAGE(PG8_SB(1, 0), b3, voffB); PG8_STAGE(PG8_SB(1, 1), b3 + hstepB, voffB); PG8_STAGE(PG8_SA(1, 0), a3, voffA);
            PG8_WAIT_V(8); PG8_WAIT_L(0); PG8_BAR; PG8_MMA(1, 0, At, B0); PG8_MMA(1, 1, At, B1); PG8_BAR; PG8_SCHED;
        }
        if (wr == 0) PG8_BAR;
        P.epi(acc, cur, wr, wc, fr, fq);
        if (!has_next) break;
#pragma unroll
        for (int a = 0; a < 2; ++a)
#pragma unroll
            for (int b = 0; b < 2; ++b)
#pragma unroll
                for (int m = 0; m < 4; ++m)
#pragma unroll
                    for (int n = 0; n < 2; ++n) acc[a][b][m][n] = (f32x4){0.f, 0.f, 0.f, 0.f};
        cur = nxt; cA = nA; cB = nB; ++ui;
        if (wr == 1) PG8_BAR;
    }
    PG8_WAIT_V(0);
    PG8_BAR;
#undef PG8_SA
#undef PG8_SB
#undef PG8_STAGE
#undef PG8_LDA
#undef PG8_LDB
#undef PG8_MMA
#undef PG8_WAIT_V
#undef PG8_WAIT_L
#undef PG8_SCHED
}
}
using pg8::Unit;
typedef f32x4 Acc[2][2][4][2];

struct Args {
    const float* in[24];
    float* out;
    unsigned char* ws;
};

struct ProgIn {
    int K, lda, ldb, G, c;
    const bf16_t* H; const bf16_t* Wt;
    bf16_t *U, *Vt, *CQ, *CKV, *KR; float* SSQ; float* out; const float* rope; const float *kvg, *krg;
    LAS float* xl;
    static constexpr int NM = 130, NMAIN = 130 * 5, NSW = 2 * 130, NTOT = NMAIN + NSW;
    __device__ __forceinline__ bool next(int i, Unit& u) const {
        const int L = i * G + c; if (L >= NTOT) return false;
        const int w = pg8::xcd_map(L, NTOT);
        if (w < NMAIN) { pg8::grouped(w, NM, 5, u.pm, u.pn); u.kind = u.pn < 2 ? 0 : (u.pn == 2 ? 1 : 2); }
        else { pg8::grouped(w - NMAIN, 2, NM, u.pm, u.pn); u.kind = 3; }
        return true;
    }
    __device__ __forceinline__ int nt(const Unit&) const { return K / 64; }
    __device__ __forceinline__ const char* aptr(const Unit& u) const { return u.kind < 3 ? (const char*)(H + (size_t)u.pm * 256 * DM) : (const char*)(Wt + (size_t)(1280 + u.pm * 256) * DM); }
    __device__ __forceinline__ const char* bptr(const Unit& u) const { return u.kind < 3 ? (const char*)(Wt + (size_t)u.pn * 256 * DM) : (const char*)(H + (size_t)u.pn * 256 * DM); }
    __device__ __forceinline__ void epi(Acc& acc, const Unit& u, int wr, int wc, int fr, int fq) const {
        asm volatile("" : "+v"(fr), "+v"(fq));
        const int rl0 = wr * 64 + fr;
        if (u.kind == 0) {
#pragma unroll
            for (int ai = 0; ai < 2; ++ai)
#pragma unroll
                for (int m = 0; m < 4; ++m) { const size_t row = (size_t)u.pm * 256 + ai * 128 + rl0 + m * 16;
#pragma unroll
                    for (int bj = 0; bj < 2; ++bj) { const f32x4 v0 = acc[ai][bj][m][0], v1 = acc[ai][bj][m][1]; u32x4 w;
                        w.x = cvt_pk_bf16(gelu_tanh(v0[0]), gelu_tanh(v0[1])); w.y = cvt_pk_bf16(gelu_tanh(v0[2]), gelu_tanh(v0[3]));
                        w.z = cvt_pk_bf16(gelu_tanh(v1[0]), gelu_tanh(v1[1])); w.w = cvt_pk_bf16(gelu_tanh(v1[2]), gelu_tanh(v1[3]));
                        *(u32x4*)(U + row * 512 + u.pn * 256 + bj * 128 + wc * 32 + fq * 8) = w; } }
        } else if (u.kind == 3) {
            const bool samp = u.pn >= 128;
#pragma unroll
            for (int ai = 0; ai < 2; ++ai)
#pragma unroll
                for (int m = 0; m < 4; ++m) { const int ch = u.pm * 256 + ai * 128 + rl0 + m * 16;
#pragma unroll
                    for (int bj = 0; bj < 2; ++bj) { const f32x4 v0 = acc[ai][bj][m][0], v1 = acc[ai][bj][m][1];
                        float g[8] = {gelu_tanh(v0[0]), gelu_tanh(v0[1]), gelu_tanh(v0[2]), gelu_tanh(v0[3]), gelu_tanh(v1[0]), gelu_tanh(v1[1]), gelu_tanh(v1[2]), gelu_tanh(v1[3])};
                        u32x4 w; w.x = cvt_pk_bf16(g[0], g[1]); w.y = cvt_pk_bf16(g[2], g[3]); w.z = cvt_pk_bf16(g[4], g[5]); w.w = cvt_pk_bf16(g[6], g[7]);
                        const int tok = u.pn * 256 + bj * 128 + wc * 32 + fq * 8;
                        *(u32x4*)(Vt + (size_t)ch * MT + tok) = w;
                        if (samp) {
#pragma unroll
                            for (int e = 0; e < 8; ++e) out[OFF_VS + (size_t)(tok - MP + e) * 512 + ch] = g[e]; } } }
        } else if (u.kind == 1) {
#pragma unroll
            for (int ai = 0; ai < 2; ++ai)
#pragma unroll
                for (int m = 0; m < 4; ++m) { float s = 0.f;
#pragma unroll
                    for (int bj = 0; bj < 2; ++bj)
#pragma unroll
                        for (int n = 0; n < 2; ++n) { const f32x4 x = acc[ai][bj][m][n]; s += (x[0] * x[0] + x[1] * x[1]) + (x[2] * x[2] + x[3] * x[3]); }
                    s += __shfl_xor(s, 16); s += __shfl_xor(s, 32);
                    if (fq == 0) xl[(ai * 128 + rl0 + m * 16) * 4 + wc] = s; }
            LDS_WAIT(); __builtin_amdgcn_s_barrier(); asm volatile("" ::: "memory");
            f32x4 gv[2][2];
#pragma unroll
            for (int bj = 0; bj < 2; ++bj)
#pragma unroll
                for (int n = 0; n < 2; ++n) gv[bj][n] = *(const f32x4*)(kvg + bj * 128 + wc * 32 + fq * 8 + n * 4);
#pragma unroll
            for (int ai = 0; ai < 2; ++ai)
#pragma unroll
                for (int m = 0; m < 4; ++m) { const int rl = ai * 128 + rl0 + m * 16; const f32x4 p = *(const LAS f32x4*)(xl + rl * 4);
                    const float rstd = rsqrtf(((p[0] + p[1]) + (p[2] + p[3])) * (1.f / 256.f) + EPS);
                    const int row = u.pm * 256 + rl; size_t kvrow; float* o;
                    if (row < MP) { kvrow = row; o = out + OFF_CKVP + (size_t)row * 256; }
                    else { const int s = row - MP, b = s >> 6, t = s & 63; kvrow = (size_t)MP + b * 2112 + 2048 + t; o = out + OFF_CKVS + (size_t)s * 256; }
#pragma unroll
                    for (int bj = 0; bj < 2; ++bj) { const f32x4 v0 = acc[ai][bj][m][0] * rstd * gv[bj][0], v1 = acc[ai][bj][m][1] * rstd * gv[bj][1];
                        const int col = bj * 128 + wc * 32 + fq * 8;
                        __builtin_nontemporal_store(v0, (f32x4*)(o + col)); __builtin_nontemporal_store(v1, (f32x4*)(o + col + 4));
                        u32x4 w; w.x = cvt_pk_bf16(v0[0], v0[1]); w.y = cvt_pk_bf16(v0[2], v0[3]); w.z = cvt_pk_bf16(v1[0], v1[1]); w.w = cvt_pk_bf16(v1[2], v1[3]);
                        *(u32x4*)(CKV + kvrow * 256 + col) = w; } }
            LDS_WAIT(); __builtin_amdgcn_s_barrier(); asm volatile("" ::: "memory");
        } else {
            const int t2 = u.pn - 3;
#pragma unroll
            for (int ai = 0; ai < 2; ++ai)
#pragma unroll
                for (int m = 0; m < 4; ++m) { const int row = u.pm * 256 + ai * 128 + rl0 + m * 16; float s = 0.f;
#pragma unroll
                    for (int bj = 0; bj < 2; ++bj) { if (t2 == 1 && bj == 1) continue;
                        const f32x4 v0 = acc[ai][bj][m][0], v1 = acc[ai][bj][m][1];
                        s += (v0[0] * v0[0] + v0[1] * v0[1]) + (v0[2] * v0[2] + v0[3] * v0[3]) + (v1[0] * v1[0] + v1[1] * v1[1]) + (v1[2] * v1[2] + v1[3] * v1[3]);
                        u32x4 w; w.x = cvt_pk_bf16(v0[0], v0[1]); w.y = cvt_pk_bf16(v0[2], v0[3]); w.z = cvt_pk_bf16(v1[0], v1[1]); w.w = cvt_pk_bf16(v1[2], v1[3]);
                        *(u32x4*)(CQ + (size_t)row * 384 + t2 * 256 + bj * 128 + wc * 32 + fq * 8) = w; }
                    s += __shfl_xor(s, 16); s += __shfl_xor(s, 32);
                    if (fq == 0) SSQ[(size_t)row * 8 + t2 * 4 + wc] = s; }
            if (t2 == 1 && wc == 0) {
                const f32x4 g0 = *(const f32x4*)(krg + fq * 8), g1 = *(const f32x4*)(krg + fq * 8 + 4);
#pragma unroll
                for (int ai = 0; ai < 2; ++ai)
#pragma unroll
                    for (int m = 0; m < 4; ++m) { const int row = u.pm * 256 + ai * 128 + rl0 + m * 16;
                        f32x4 v0 = acc[ai][1][m][0], v1 = acc[ai][1][m][1];
                        float s = (v0[0] * v0[0] + v0[1] * v0[1]) + (v0[2] * v0[2] + v0[3] * v0[3]) + (v1[0] * v1[0] + v1[1] * v1[1]) + (v1[2] * v1[2] + v1[3] * v1[3]);
                        s += __shfl_xor(s, 16); s += __shfl_xor(s, 32);
                        const float rstd = rsqrtf(s * (1.f / 32.f) + EPS);
                        v0 = v0 * rstd * g0; v1 = v1 * rstd * g1;
                        int pos; size_t kvrow; float* o;
                        if (row < MP) { pos = row & 4095; kvrow = row; o = out + OFF_KRP + (size_t)row * 32; }
                        else { const int sr = row - MP, b = sr >> 6, t = sr & 63; pos = 2048 + t; kvrow = (size_t)MP + b * 2112 + 2048 + t; o = out + OFF_KRS + (size_t)sr * 32; }
                        const float* rp = rope + (size_t)pos * 32 + (fq & 1) * 8;
                        const f32x4 c0 = *(const f32x4*)rp, c1 = *(const f32x4*)(rp + 4), s0 = *(const f32x4*)(rp + 16), s1 = *(const f32x4*)(rp + 20);
                        f32x4 p0, p1;
#pragma unroll
                        for (int e = 0; e < 4; ++e) { p0[e] = __shfl_xor(v0[e], 32); p1[e] = __shfl_xor(v1[e], 32); }
                        const float sg = fq < 2 ? -1.f : 1.f;
                        const f32x4 r0 = v0 * c0 + p0 * s0 * sg, r1 = v1 * c1 + p1 * s1 * sg;
                        __builtin_nontemporal_store(r0, (f32x4*)(o + fq * 8)); __builtin_nontemporal_store(r1, (f32x4*)(o + fq * 8 + 4));
                        u32x4 w; w.x = cvt_pk_bf16(r0[0], r0[1]); w.y = cvt_pk_bf16(r0[2], r0[3]); w.z = cvt_pk_bf16(r1[0], r1[1]); w.w = cvt_pk_bf16(r1[2], r1[3]);
                        *(u32x4*)(KR + kvrow * 32 + fq * 8) = w; }
            }
        }
    }
};

struct ProgQ {
    int K, lda, ldb, G, c;
    const bf16_t* CQ; const bf16_t* Wt; const float* SSQ; bf16_t* Q; const float* rope; const float *qng, *qrg;
    static constexpr int NM = 130, NTOT = 130 * 3;
    __device__ __forceinline__ bool next(int i, Unit& u) const { const int L = i * G + c; if (L >= NTOT) return false; pg8::grouped(pg8::xcd_map(L, NTOT), NM, 3, u.pm, u.pn); u.kind = 0; return true; }
    __device__ __forceinline__ int nt(const Unit&) const { return K / 64; }
    __device__ __forceinline__ const char* aptr(const Unit& u) const { return (const char*)(CQ + (size_t)u.pm * 256 * 384); }
    __device__ __forceinline__ const char* bptr(const Unit& u) const { return (const char*)(Wt + (size_t)u.pn * 256 * 384); }
    __device__ __forceinline__ void epi(Acc& acc, const Unit& u, int wr, int wc, int fr, int fq) const {
        asm volatile("" : "+v"(fr), "+v"(fq));
        const int rl0 = wr * 64 + fr;
#pragma unroll
        for (int ai = 0; ai < 2; ++ai)
#pragma unroll
            for (int m = 0; m < 4; ++m) { const int row = u.pm * 256 + ai * 128 + rl0 + m * 16;
                const f32x4 q0 = *(const f32x4*)(SSQ + (size_t)row * 8), q1 = *(const f32x4*)(SSQ + (size_t)row * 8 + 4);
                const float rq = rsqrtf((((q0[0] + q0[1]) + (q0[2] + q0[3])) + ((q1[0] + q1[1]) + (q1[2] + q1[3]))) * (1.f / 384.f) + EPS);
                if (u.pn < 2) {
                    const int head = u.pn * 4 + wc; float s = 0.f; f32x4 v[2][2];
#pragma unroll
                    for (int bj = 0; bj < 2; ++bj)
#pragma unroll
                        for (int n = 0; n < 2; ++n) { v[bj][n] = acc[ai][bj][m][n] * rq; const f32x4 x = v[bj][n]; s += (x[0] * x[0] + x[1] * x[1]) + (x[2] * x[2] + x[3] * x[3]); }
                    s += __shfl_xor(s, 16); s += __shfl_xor(s, 32);
                    const float r2 = rsqrtf(s * (1.f / 64.f) + EPS) * QSCALE;
#pragma unroll
                    for (int bj = 0; bj < 2; ++bj) { const f32x4 g0 = *(const f32x4*)(qng + bj * 32 + fq * 8), g1 = *(const f32x4*)(qng + bj * 32 + fq * 8 + 4);
                        const f32x4 a = v[bj][0] * r2 * g0, b = v[bj][1] * r2 * g1;
                        u32x4 w; w.x = cvt_pk_bf16(a[0], a[1]); w.y = cvt_pk_bf16(a[2], a[3]); w.z = cvt_pk_bf16(b[0], b[1]); w.w = cvt_pk_bf16(b[2], b[3]);
                        *(u32x4*)(Q + (size_t)row * 768 + head * 96 + bj * 32 + fq * 8) = w; }
                } else {
                    const int pos = row < MP ? (row & 4095) : 2048 + ((row - MP) & 63);
                    const float* rp = rope + (size_t)pos * 32 + (fq & 1) * 8;
                    const f32x4 c0 = *(const f32x4*)rp, c1 = *(const f32x4*)(rp + 4), s0 = *(const f32x4*)(rp + 16), s1 = *(const f32x4*)(rp + 20);
                    const f32x4 g0 = *(const f32x4*)(qrg + fq * 8), g1 = *(const f32x4*)(qrg + fq * 8 + 4);
                    const float sg = fq < 2 ? -1.f : 1.f;
#pragma unroll
                    for (int bj = 0; bj < 2; ++bj) { const int head = bj * 4 + wc;
                        f32x4 v0 = acc[ai][bj][m][0] * rq, v1 = acc[ai][bj][m][1] * rq;
                        float s = (v0[0] * v0[0] + v0[1] * v0[1]) + (v0[2] * v0[2] + v0[3] * v0[3]) + (v1[0] * v1[0] + v1[1] * v1[1]) + (v1[2] * v1[2] + v1[3] * v1[3]);
                        s += __shfl_xor(s, 16); s += __shfl_xor(s, 32);
                        const float r2 = rsqrtf(s * (1.f / 32.f) + EPS);
                        v0 = v0 * r2 * g0; v1 = v1 * r2 * g1;
                        f32x4 p0, p1;
#pragma unroll
                        for (int e = 0; e < 4; ++e) { p0[e] = __shfl_xor(v0[e], 32); p1[e] = __shfl_xor(v1[e], 32); }
                        const f32x4 r0 = (v0 * c0 + p0 * s0 * sg) * QSCALE, r1 = (v1 * c1 + p1 * s1 * sg) * QSCALE;
                        u32x4 w; w.x = cvt_pk_bf16(r0[0], r0[1]); w.y = cvt_pk_bf16(r0[2], r0[3]); w.z = cvt_pk_bf16(r1[0], r1[1]); w.w = cvt_pk_bf16(r1[2], r1[3]);
                        *(u32x4*)(Q + (size_t)row * 768 + head * 96 + 64 + fq * 8) = w; }
                } }
    }
};

struct ProgKV {
    int K, lda, ldb, G, c;
    const bf16_t* CKV; const bf16_t* Wt; bf16_t *KN, *VVt; const float* kng;
    static constexpr int NM = 194, NA = 194 * 2, NTOT = 194 * 4;
    __device__ __forceinline__ bool next(int i, Unit& u) const {
        const int L = i * G + c; if (L >= NTOT) return false;
        const int w = pg8::xcd_map(L, NTOT);
        if (w < NA) { pg8::grouped(w, NM, 2, u.pm, u.pn); u.kind = 0; } else { pg8::grouped(w - NA, 2, NM, u.pm, u.pn); u.kind = 1; }
        return true;
    }
    __device__ __forceinline__ int nt(const Unit&) const { return K / 64; }
    __device__ __forceinline__ const char* aptr(const Unit& u) const { return u.kind == 0 ? (const char*)(CKV + (size_t)u.pm * 256 * 256) : (const char*)(Wt + (size_t)(512 + u.pm * 256) * 256); }
    __device__ __forceinline__ const char* bptr(const Unit& u) const { return u.kind == 0 ? (const char*)(Wt + (size_t)u.pn * 256 * 256) : (const char*)(CKV + (size_t)u.pn * 256 * 256); }
    __device__ __forceinline__ void epi(Acc& acc, const Unit& u, int wr, int wc, int fr, int fq) const {
        asm volatile("" : "+v"(fr), "+v"(fq));
        const int rl0 = wr * 64 + fr;
#pragma unroll
        for (int ai = 0; ai < 2; ++ai)
#pragma unroll
            for (int m = 0; m < 4; ++m) { const size_t row = (size_t)u.pm * 256 + ai * 128 + rl0 + m * 16;
                if (u.kind == 0) {
                    const int head = u.pn * 4 + wc; float s = 0.f;
#pragma unroll
                    for (int bj = 0; bj < 2; ++bj)
#pragma unroll
                        for (int n = 0; n < 2; ++n) { const f32x4 x = acc[ai][bj][m][n]; s += (x[0] * x[0] + x[1] * x[1]) + (x[2] * x[2] + x[3] * x[3]); }
                    s += __shfl_xor(s, 16); s += __shfl_xor(s, 32);
                    const float r2 = rsqrtf(s * (1.f / 64.f) + EPS);
#pragma unroll
                    for (int bj = 0; bj < 2; ++bj) { const f32x4 g0 = *(const f32x4*)(kng + bj * 32 + fq * 8), g1 = *(const f32x4*)(kng + bj * 32 + fq * 8 + 4);
                        const f32x4 a = acc[ai][bj][m][0] * r2 * g0, b = acc[ai][bj][m][1] * r2 * g1;
                        u32x4 w; w.x = cvt_pk_bf16(a[0], a[1]); w.y = cvt_pk_bf16(a[2], a[3]); w.z = cvt_pk_bf16(b[0], b[1]); w.w = cvt_pk_bf16(b[2], b[3]);
                        *(u32x4*)(KN + row * 512 + head * 64 + bj * 32 + fq * 8) = w; }
                } else {
#pragma unroll
                    for (int bj = 0; bj < 2; ++bj) { const f32x4 a = acc[ai][bj][m][0], b = acc[ai][bj][m][1];
                        u32x4 w; w.x = cvt_pk_bf16(a[0], a[1]); w.y = cvt_pk_bf16(a[2], a[3]); w.z = cvt_pk_bf16(b[0], b[1]); w.w = cvt_pk_bf16(b[2], b[3]);
                        *(u32x4*)(VVt + row * KVR + (size_t)u.pn * 256 + bj * 128 + wc * 32 + fq * 8) = w; }
                } }
    }
};

template <int MODE>
struct ProgRes {
    int K, lda, ldb, G, c, nsk;
    const bf16_t* Ab; const bf16_t* Wt; const float* xp; float* Y; bf16_t* X1; const float* gate; float* part;
    __device__ __forceinline__ bool next(int i, Unit& u) const {
        const int L = i * G + c; if (L >= 512 + 8 * nsk) return false;
        int pm, pn; pg8::grouped(pg8::xcd_map(L < 512 ? L : 0, 512), 128, 4, pm, pn);
        const int idx = L - 512, rem = idx & 7; const bool sp = L >= 512;
        if (MODE == 1) pm = 127 - pm;
        u.pm = sp ? 128 + (rem >> 2) : pm; u.pn = sp ? (rem & 3) : pn; u.kind = sp ? 1 + (idx >> 3) : 0;
        return true;
    }
    __device__ __forceinline__ int nt(const Unit& u) const { return u.kind == 0 ? K / 64 : 4; }
    __device__ __forceinline__ const char* aptr(const Unit& u) const { return (const char*)(Ab + (size_t)u.pm * 256 * K + (u.kind ? (u.kind - 1) * 256 : 0)); }
    __device__ __forceinline__ const char* bptr(const Unit& u) const { return (const char*)(Wt + (size_t)u.pn * 256 * K + (u.kind ? (u.kind - 1) * 256 : 0)); }
    __device__ __forceinline__ void epi(Acc& acc, const Unit& u, int wr, int wc, int fr, int fq) const {
        asm volatile("" : "+v"(fr), "+v"(fq));
        const int rl0 = wr * 64 + fr;
        if (u.kind == 0) {
            const int b16 = u.pm >> 4;
#pragma unroll
            for (int ai = 0; ai < 2; ++ai) {
                f32x4 gv[2][2];
#pragma unroll
                for (int bj = 0; bj < 2; ++bj)
#pragma unroll
                    for (int n = 0; n < 2; ++n) gv[bj][n] = *(const f32x4*)(gate + (size_t)b16 * 6144 + u.pn * 256 + bj * 128 + wc * 32 + fq * 8 + n * 4);
#pragma unroll
                for (int m = 0; m < 4; ++m) { const int row = u.pm * 256 + ai * 128 + rl0 + m * 16;
#pragma unroll
                    for (int bj = 0; bj < 2; ++bj) { const int col = u.pn * 256 + bj * 128 + wc * 32 + fq * 8;
                        if constexpr (MODE == 0) {
                            const float* bp = xp + (size_t)row * DM;
                            const f32x4 r0 = *(const f32x4*)(bp + col) + gv[bj][0] * acc[ai][bj][m][0], r1 = *(const f32x4*)(bp + col + 4) + gv[bj][1] * acc[ai][bj][m][1];
                            u32x4 w; w.x = cvt_pk_bf16(r0[0], r0[1]); w.y = cvt_pk_bf16(r0[2], r0[3]); w.z = cvt_pk_bf16(r1[0], r1[1]); w.w = cvt_pk_bf16(r1[2], r1[3]);
                            *(u32x4*)(X1 + (size_t)row * DM + col) = w;
                        } else {
                            const u32x4 w = *(const u32x4*)(X1 + (size_t)row * DM + col);
                            const f32x4 b0 = (f32x4){__uint_as_float(w.x << 16), __uint_as_float(w.x & 0xffff0000u), __uint_as_float(w.y << 16), __uint_as_float(w.y & 0xffff0000u)};
                            const f32x4 b1 = (f32x4){__uint_as_float(w.z << 16), __uint_as_float(w.z & 0xffff0000u), __uint_as_float(w.w << 16), __uint_as_float(w.w & 0xffff0000u)};
                            __builtin_nontemporal_store(b0 + gv[bj][0] * acc[ai][bj][m][0], (f32x4*)(Y + (size_t)row * DM + col));
                            __builtin_nontemporal_store(b1 + gv[bj][1] * acc[ai][bj][m][1], (f32x4*)(Y + (size_t)row * DM + col + 4));
                        } } }
            }
        } else {
            float* pb = part + (size_t)(u.kind - 1) * 512 * DM;
#pragma unroll
            for (int ai = 0; ai < 2; ++ai)
#pragma unroll
                for (int m = 0; m < 4; ++m) { const int srow = (u.pm - 128) * 256 + ai * 128 + rl0 + m * 16;
#pragma unroll
                    for (int bj = 0; bj < 2; ++bj) { const int col = u.pn * 256 + bj * 128 + wc * 32 + fq * 8;
                        *(f32x4*)(pb + (size_t)srow * DM + col) = acc[ai][bj][m][0];
                        *(f32x4*)(pb + (size_t)srow * DM + col + 4) = acc[ai][bj][m][1]; } }
        }
    }
};

struct ProgFfn {
    int K, lda, ldb, G, c;
    const bf16_t* Ab; const bf16_t* Wt; bf16_t* Gb;
    static constexpr int NM = 130, NN = 22, NTOT = 130 * 22;
    __device__ __forceinline__ bool next(int i, Unit& u) const { const int L = i * G + c; if (L >= NTOT) return false; pg8::grouped(pg8::xcd_map(L, NTOT), NM, NN, u.pm, u.pn); u.kind = 0; return true; }
    __device__ __forceinline__ int nt(const Unit&) const { return K / 64; }
    __device__ __forceinline__ const char* aptr(const Unit& u) const { return (const char*)(Ab + (size_t)u.pm * 256 * DM); }
    __device__ __forceinline__ const char* bptr(const Unit& u) const { return (const char*)(Wt + (size_t)u.pn * 256 * DM); }
    __device__ __forceinline__ void epi(Acc& acc, const Unit& u, int wr, int wc, int fr, int fq) const {
        asm volatile("" : "+v"(fr), "+v"(fq));
        const int rl0 = wr * 64 + fr;
#pragma unroll
        for (int ai = 0; ai < 2; ++ai)
#pragma unroll
            for (int m = 0; m < 4; ++m) { const size_t row = (size_t)u.pm * 256 + ai * 128 + rl0 + m * 16;
                const f32x4 g0 = acc[ai][0][m][0], g1 = acc[ai][0][m][1], u0 = acc[ai][1][m][0], u1 = acc[ai][1][m][1];
                u32x4 w; w.x = cvt_pk_bf16(silu_f(g0[0]) * u0[0], silu_f(g0[1]) * u0[1]); w.y = cvt_pk_bf16(silu_f(g0[2]) * u0[2], silu_f(g0[3]) * u0[3]);
                w.z = cvt_pk_bf16(silu_f(g1[0]) * u1[0], silu_f(g1[1]) * u1[1]); w.w = cvt_pk_bf16(silu_f(g1[2]) * u1[2], silu_f(g1[3]) * u1[3]);
                *(u32x4*)(Gb + row * DFF + u.pn * 128 + wc * 32 + fq * 8) = w; }
    }
};

__device__ __forceinline__ void p0_transpose_item(const float* W, int ldw, int c0, int k0, bf16_t* WT, int K, int n0, const float* kscale, LAS float* scr, int lane) {
#pragma unroll
    for (int i = 0; i < 32; ++i) { const int kk = 2 * i + (lane >> 5); float v = 0.f;
        if (c0 >= 0) v = __builtin_nontemporal_load(W + (size_t)(k0 + kk) * ldw + c0 + (lane & 31));
        if (kscale) v *= kscale[k0 + kk];
        scr[kk * 33 + (lane & 31)] = v; }
    LDS_WAIT(); asm volatile("" ::: "memory");
    const int c = lane & 7;
#pragma unroll
    for (int j = 0; j < 4; ++j) { const int n = (lane >> 3) + 8 * j; const LAS float* s = scr + (8 * c) * 33 + n;
        u32x4 o; o.x = cvt_pk_bf16(s[0 * 33], s[1 * 33]); o.y = cvt_pk_bf16(s[2 * 33], s[3 * 33]); o.z = cvt_pk_bf16(s[4 * 33], s[5 * 33]); o.w = cvt_pk_bf16(s[6 * 33], s[7 * 33]);
        *(u32x4*)(WT + (size_t)(n0 + n) * K + k0 + 8 * c) = o; }
    LDS_WAIT(); asm volatile("" ::: "memory");
}
__device__ __forceinline__ void norm_load(const float* xrow, f32x4 (&v)[4], int lane) {
#pragma unroll
    for (int j = 0; j < 4; ++j) v[j] = __builtin_nontemporal_load((const f32x4*)xrow + lane + 64 * j);
}
__device__ __forceinline__ void norm_apply(const f32x4 (&v)[4], const float* g, const float* sc, const float* sh, bf16_t* orow, int lane) {
    float s = 0.f;
#pragma unroll
    for (int j = 0; j < 4; ++j) s += (v[j][0] * v[j][0] + v[j][1] * v[j][1]) + (v[j][2] * v[j][2] + v[j][3] * v[j][3]);
    const float rstd = rsqrtf(wave_sum(s) * (1.f / 1024.f) + EPS);
#pragma unroll
    for (int j = 0; j < 4; ++j) { const int c4 = lane + 64 * j;
        const f32x4 gg = *((const f32x4*)g + c4), cc = *((const f32x4*)sc + c4), hh = *((const f32x4*)sh + c4);
        const f32x4 h = v[j] * rstd * gg * (cc + 1.f) + hh;
        u32x2 w; w.x = cvt_pk_bf16(h[0], h[1]); w.y = cvt_pk_bf16(h[2], h[3]);
        *((u32x2*)orow + c4) = w; }
}
__device__ __forceinline__ void sample_combine(const float* gate, const float* part, int nsk, int srow, f32x4 (&v)[4], int lane) {
#pragma unroll
    for (int j = 0; j < 4; ++j) { const int c4 = lane + 64 * j; f32x4 a = (f32x4){0.f, 0.f, 0.f, 0.f};
        for (int k = 0; k < nsk; ++k) a += *((const f32x4*)(part + ((size_t)k * 512 + srow) * DM) + c4);
        v[j] = v[j] + *((const f32x4*)gate + c4) * a; }
}
__device__ __forceinline__ void row_load_bf16(const bf16_t* row, f32x4 (&v)[4], int lane) {
#pragma unroll
    for (int j = 0; j < 4; ++j) { const u32x2 w = __builtin_nontemporal_load((const u32x2*)row + lane + 64 * j);
        v[j] = (f32x4){__uint_as_float(w.x << 16), __uint_as_float(w.x & 0xffff0000u), __uint_as_float(w.y << 16), __uint_as_float(w.y & 0xffff0000u)}; }
}
__device__ __forceinline__ void row_store_bf16(bf16_t* row, const f32x4 (&v)[4], int lane) {
#pragma unroll
    for (int j = 0; j < 4; ++j) { u32x2 w; w.x = cvt_pk_bf16(v[j][0], v[j][1]); w.y = cvt_pk_bf16(v[j][2], v[j][3]); *((u32x2*)row + lane + 64 * j) = w; }
}

constexpr int GM_PITCH = 272;
__device__ __forceinline__ void gmlp_phase(LAS unsigned char* lds, int it0, int G, const bf16_t* Wm, const bf16_t* Vt, const bf16_t* U, const float* bs, bf16_t* YAB) {
    const int tid = fresh_tid(), lane = tid & 63, wid = __builtin_amdgcn_readfirstlane(tid >> 6), fr = lane & 15, fq = lane >> 4;
    constexpr int NIT = 1024 + 32;
    u32x4 st[4];
#define GM_LOAD(item) do { const bool samp_ = (item) >= 1024; const int g_ = (item) & 3; const int tok_ = samp_ ? MP + 64 * (((item) - 1024) >> 2) : 128 * ((item) >> 2); \
        _Pragma("unroll") for (int q = 0; q < 4; ++q) { const int c_ = tid + 512 * q, row_ = c_ >> 4, ch_ = c_ & 15; \
            if (!samp_ || ch_ < 8) st[q] = __builtin_nontemporal_load((const u32x4*)(Vt + (size_t)(128 * g_ + row_) * MT + tok_ + ch_ * 8)); else st[q] = (u32x4){0u, 0u, 0u, 0u}; } } while (0)
    int item = it0;
    if (item < NIT) GM_LOAD(item);
    for (; item < NIT; item += G) {
        const bool samp = item >= 1024; const int g = item & 3;
        const int tok0 = samp ? MP + 64 * ((item - 1024) >> 2) : 128 * (item >> 2);
        const bool active = !(samp && wid >= 4);
        const int nk = (samp || wid < 4) ? 2 : 4;
        const int row = tok0 + 16 * wid + fr;
        bf16x8 bfr[4]; u32x2 uu8[8]; float bias = 0.f;
        if (active) {
            const bf16_t* wrow = Wm + (size_t)(g * 128 + 16 * wid + fr) * 128 + 8 * fq;
#pragma unroll
            for (int kk = 0; kk < 4; ++kk) bfr[kk] = *(const bf16x8*)(wrow + 32 * kk);
#pragma unroll
            for (int n = 0; n < 8; ++n) uu8[n] = __builtin_nontemporal_load((const u32x2*)(U + (size_t)row * 512 + 128 * g + 16 * n + 4 * fq));
            bias = bs[g * 128 + 16 * wid + fr];
        }
#pragma unroll
        for (int q = 0; q < 4; ++q) { const int c = tid + 512 * q; *(LAS u32x4*)(lds + (c >> 4) * GM_PITCH + (c & 15) * 16) = st[q]; }
        __syncthreads();
        if (item + G < NIT) GM_LOAD(item + G);
        if (active) {
            f32x4 acc[8];
#pragma unroll
            for (int n = 0; n < 8; ++n) acc[n] = (f32x4){0.f, 0.f, 0.f, 0.f};
            const LAS unsigned char* ab = lds + fr * GM_PITCH + fq * 16;
#pragma unroll
            for (int kk = 0; kk < 4; ++kk) { if (kk < nk) {
#pragma unroll
                for (int n = 0; n < 8; ++n) { const bf16x8 afr = *(const LAS bf16x8*)(ab + (16 * n) * GM_PITCH + kk * 64);
                    acc[n] = __builtin_amdgcn_mfma_f32_16x16x32_bf16(afr, bfr[kk], acc[n], 0, 0, 0); } } }
#pragma unroll
            for (int n = 0; n < 8; ++n) { const int col = 128 * g + 16 * n + 4 * fq; const u32x2 uu = uu8[n];
                const float y0 = __uint_as_float(uu.x << 16) * (acc[n][0] + bias), y1 = __uint_as_float(uu.x & 0xffff0000u) * (acc[n][1] + bias);
                const float y2 = __uint_as_float(uu.y << 16) * (acc[n][2] + bias), y3 = __uint_as_float(uu.y & 0xffff0000u) * (acc[n][3] + bias);
                u32x2 w; w.x = cvt_pk_bf16(y0, y1); w.y = cvt_pk_bf16(y2, y3);
                *(u32x2*)(YAB + (size_t)row * DM + col) = w; }
        }
        __syncthreads();
    }
#undef GM_LOAD
}

constexpr int KPITCH = 208, VPITCH = 136, KBUF = 64 * KPITCH, VBUF = 64 * VPITCH, ATT_V0 = 2 * KBUF;
template <bool QK, bool SM>
__device__ __forceinline__ void attn_step(const LAS unsigned char* kb, const LAS unsigned char* vbp, const bf16x8 (&qr)[6],
                                          f32x16& s0, f32x16& s1, f32x16& o0, f32x16& o1, float& mrow, float& lsum) {
    f32x16 n0 = {}, n1 = {};
    if constexpr (QK) {
#pragma unroll
        for (int s = 0; s < 6; ++s) { const bf16x8 ka = *(const LAS bf16x8*)(kb + s * 32), kc = *(const LAS bf16x8*)(kb + 32 * KPITCH + s * 32);
            n0 = __builtin_amdgcn_mfma_f32_32x32x16_bf16(ka, qr[s], n0, 0, 0, 0); n1 = __builtin_amdgcn_mfma_f32_32x32x16_bf16(kc, qr[s], n1, 0, 0, 0); }
    }
    if constexpr (SM) {
        float mx = max3f(s0[0], s1[0], s0[1]); mx = max3f(mx, s1[1], s0[2]); float my = max3f(s1[2], s0[3], s1[3]);
#pragma unroll
        for (int r = 4; r < 16; r += 4) { mx = max3f(mx, s0[r], s1[r]); my = max3f(my, s0[r + 1], s1[r + 1]); mx = max3f(mx, s0[r + 2], s1[r + 2]); my = max3f(my, s0[r + 3], s1[r + 3]); }
        mx = fmaxf(mx, my);
        { const auto rr = __builtin_amdgcn_permlane32_swap(__float_as_uint(mx), __float_as_uint(mx), false, false); mx = fmaxf(__uint_as_float(rr[0]), __uint_as_float(rr[1])); }
        const float mnew = fmaxf(mrow, mx), alpha = __builtin_amdgcn_exp2f(mrow - mnew); mrow = mnew;
        const f32x2 m2 = (f32x2){mnew, mnew}; f32x2 ps2 = (f32x2){0.f, 0.f};
#pragma unroll
        for (int r = 0; r < 16; r += 2) { f32x2 a = (f32x2){s0[r], s0[r + 1]} - m2, b = (f32x2){s1[r], s1[r + 1]} - m2;
            a.x = __builtin_amdgcn_exp2f(a.x); a.y = __builtin_amdgcn_exp2f(a.y); b.x = __builtin_amdgcn_exp2f(b.x); b.y = __builtin_amdgcn_exp2f(b.y);
            s0[r] = a.x; s0[r + 1] = a.y; s1[r] = b.x; s1[r + 1] = b.y; ps2 += a + b; }
        const float ps = ps2.x + ps2.y;
        lsum = lsum * alpha + ps;
#pragma unroll
        for (int r = 0; r < 16; ++r) { o0[r] *= alpha; o1[r] *= alpha; }
        bf16x8 pb[4];
#pragma unroll
        for (int S = 0; S < 4; ++S) { u32x4 w;
            if (S < 2) { w.x = cvt_pk_bf16(s0[8 * S + 0], s0[8 * S + 1]); w.y = cvt_pk_bf16(s0[8 * S + 2], s0[8 * S + 3]); w.z = cvt_pk_bf16(s0[8 * S + 4], s0[8 * S + 5]); w.w = cvt_pk_bf16(s0[8 * S + 6], s0[8 * S + 7]); }
            else { w.x = cvt_pk_bf16(s1[8 * S - 16], s1[8 * S - 15]); w.y = cvt_pk_bf16(s1[8 * S - 14], s1[8 * S - 13]); w.z = cvt_pk_bf16(s1[8 * S - 12], s1[8 * S - 11]); w.w = cvt_pk_bf16(s1[8 * S - 10], s1[8 * S - 9]); }
            pb[S] = __builtin_bit_cast(bf16x8, w); }
#pragma unroll
        for (int S = 0; S < 4; ++S) {
            const u32x2 a0 = *(const LAS u32x2*)(vbp + S * 32), a1 = *(const LAS u32x2*)(vbp + S * 32 + 16);
            const u32x2 c0 = *(const LAS u32x2*)(vbp + 32 * VPITCH + S * 32), c1 = *(const LAS u32x2*)(vbp + 32 * VPITCH + S * 32 + 16);
            const bf16x8 va = __builtin_bit_cast(bf16x8, (u32x4){a0.x, a0.y, a1.x, a1.y}), vc = __builtin_bit_cast(bf16x8, (u32x4){c0.x, c0.y, c1.x, c1.y});
            o0 = __builtin_amdgcn_mfma_f32_32x32x16_bf16(va, pb[S], o0, 0, 0, 0); o1 = __builtin_amdgcn_mfma_f32_32x32x16_bf16(vc, pb[S], o1, 0, 0, 0); }
    }
    s0 = n0; s1 = n1;
}
__device__ __forceinline__ void attn_unit(LAS unsigned char* lds, const bf16_t* Qrow0, int nqw, int limbase, bool prompt, size_t kv0, int NT, int h,
                                          const bf16_t* KN, const bf16_t* KR, const bf16_t* VVt, bf16_t* Yrow0) {
    const int tid = fresh_tid(), lane = tid & 63, wid = __builtin_amdgcn_readfirstlane(tid >> 6), r32 = lane & 31, hi = lane >> 5;
    const int lim = wid < nqw ? (prompt ? limbase + (wid >> 1) + 1 : NT) : 0;
    const int kr0 = tid / 12, kp0 = tid % 12, kr1 = (tid + 512) / 12, kp1 = (tid + 512) % 12;
    const bf16_t* ksrc0 = kp0 < 8 ? KN + (kv0 + kr0) * 512 + h * 64 + kp0 * 8 : KR + (kv0 + kr0) * 32 + (kp0 - 8) * 8;
    const size_t kstr0 = kp0 < 8 ? 512 * 64 : 32 * 64;
    const bf16_t* ksrc1 = kp1 < 8 ? KN + (kv0 + kr1) * 512 + h * 64 + kp1 * 8 : KR + (kv0 + kr1) * 32 + (kp1 - 8) * 8;
    const size_t kstr1 = kp1 < 8 ? 512 * 64 : 32 * 64;
    const bool k1 = tid < 256;
    const bf16_t* vsrc = VVt + (size_t)(h * 64 + (tid >> 3)) * KVR + kv0 + (tid & 7) * 8;
    const int kd0 = kr0 * KPITCH + kp0 * 16, kd1 = kr1 * KPITCH + kp1 * 16, vd = (tid >> 3) * VPITCH + (tid & 7) * 16;
    u32x4 ak0, ak1, av, bk0, bk1, bv;
    const bf16_t* ksrc1c = k1 ? ksrc1 : ksrc0; const size_t kstr1c = k1 ? kstr1 : kstr0;
    const int ntm = NT - 1;
#define ATT_LDK(K0, K1, t) do { const int t_ = (t) < ntm ? (t) : ntm; K0 = *(const u32x4*)(ksrc0 + (size_t)t_ * kstr0); K1 = *(const u32x4*)(ksrc1c + (size_t)t_ * kstr1c); } while (0)
#define ATT_LDV(V, t) do { const int t_ = (t) < ntm ? (t) : ntm; V = *(const u32x4*)(vsrc + (size_t)t_ * 64); } while (0)
#define ATT_STK(K0, K1, b) do { *(LAS u32x4*)(lds + (b) * KBUF + kd0) = K0; if (k1) *(LAS u32x4*)(lds + (b) * KBUF + kd1) = K1; } while (0)
#define ATT_STV(V, b) do { *(LAS u32x2*)(lds + ATT_V0 + (b) * VBUF + vd) = (u32x2){V.x, V.y}; *(LAS u32x2*)(lds + ATT_V0 + (b) * VBUF + vd + 8) = (u32x2){V.z, V.w}; } while (0)
#define ATT_BAR() asm volatile("s_waitcnt lgkmcnt(0)\n\ts_barrier" ::: "memory")
    ATT_LDK(ak0, ak1, 0); ATT_LDV(av, 0); ATT_LDK(bk0, bk1, 1);
    bf16x8 qr[6];
    if (wid < nqw) {
#pragma unroll
        for (int s = 0; s < 6; ++s) qr[s] = *(const bf16x8*)(Qrow0 + (size_t)(wid * 32 + r32) * 768 + h * 96 + s * 16 + hi * 8);
    } else {
#pragma unroll
        for (int s = 0; s < 6; ++s) qr[s] = (bf16x8){0, 0, 0, 0, 0, 0, 0, 0};
    }
    ATT_STK(ak0, ak1, 0); ATT_STV(av, 0); ATT_STK(bk0, bk1, 1);
    ATT_LDK(ak0, ak1, 2); ATT_LDV(av, 1);
    ATT_BAR();
    float mrow = -1e30f, lsum = 0.f; f32x16 o0 = {}, o1 = {}, s0 = {}, s1 = {};
    if (wid >= 4) __builtin_amdgcn_s_setprio(1);
    const LAS unsigned char* kbase = lds + r32 * KPITCH + hi * 16;
    const LAS unsigned char* vbase = lds + ATT_V0 + r32 * VPITCH + hi * 8;
    if (lim > 0) attn_step<true, false>(kbase, vbase, qr, s0, s1, o0, o1, mrow, lsum);
    ATT_BAR();
#define ATT_ITER(t, XK0, XK1, XV, YK0, YK1, YV) do { const int buf_ = (t) & 1; \
        ATT_LDK(YK0, YK1, (t) + 3); ATT_LDV(YV, (t) + 2); \
        if ((t) + 1 < lim) attn_step<true, true>(kbase + (buf_ ^ 1) * KBUF, vbase + buf_ * VBUF, qr, s0, s1, o0, o1, mrow, lsum); \
        else if ((t) < lim) attn_step<false, true>(kbase + (buf_ ^ 1) * KBUF, vbase + buf_ * VBUF, qr, s0, s1, o0, o1, mrow, lsum); \
        ATT_STK(XK0, XK1, buf_); ATT_STV(XV, buf_ ^ 1); \
        ATT_BAR(); } while (0)
    for (int t = 0; t < NT; t += 2) {
        ATT_ITER(t, ak0, ak1, av, bk0, bk1, bv);
        if (t + 1 < NT) ATT_ITER(t + 1, bk0, bk1, bv, ak0, ak1, av);
    }
    asm volatile("s_waitcnt vmcnt(0)" ::: "memory");
    __builtin_amdgcn_s_setprio(0);
#undef ATT_LDK
#undef ATT_LDV
#undef ATT_STK
#undef ATT_STV
#undef ATT_ITER
    if (wid < nqw) {
        lsum += __shfl_xor(lsum, 32);
        const float inv = 1.f / lsum;
        bf16_t* yp = Yrow0 + (size_t)(wid * 32 + r32) * DM + 512 + h * 64 + 4 * hi;
#pragma unroll
        for (int g = 0; g < 4; ++g) {
            u32x2 w; w.x = cvt_pk_bf16(o0[4 * g] * inv, o0[4 * g + 1] * inv); w.y = cvt_pk_bf16(o0[4 * g + 2] * inv, o0[4 * g + 3] * inv);
            *(u32x2*)(yp + 8 * g) = w;
            u32x2 x; x.x = cvt_pk_bf16(o1[4 * g] * inv, o1[4 * g + 1] * inv); x.y = cvt_pk_bf16(o1[4 * g + 2] * inv, o1[4 * g + 3] * inv);
            *(u32x2*)(yp + 32 + 8 * g) = x; }
    }
}


#define XB_TMO      128
#define XB_XCNT(j)  (256  + 64 * (j))
#define XB_XSUB(j)  (1280 + 64 * (j))
#define XB_XGEN(j)  (2304 + 64 * (j))
#define XB_TOP      3328
#define XB_TOPGEN   3392
#define XCD_BAR_WORDS 3456
#define XB_SPIN_CAP (1u << 18)
__device__ __forceinline__ unsigned xb_ld(unsigned* p)              { return __hip_atomic_load(p, __ATOMIC_RELAXED, __HIP_MEMORY_SCOPE_AGENT); }
__device__ __forceinline__ unsigned xb_add(unsigned* p, unsigned v) { return __hip_atomic_fetch_add(p, v, __ATOMIC_RELAXED, __HIP_MEMORY_SCOPE_AGENT); }
__device__ __forceinline__ unsigned xb_xcc_id() { return (unsigned)__builtin_amdgcn_s_getreg((3 << 11) | 20) & 0xFu; }
#define XB_SPIN(cond, bar) do { unsigned _sp = 0; while (cond) { __builtin_amdgcn_s_sleep(1); \
    if ((++_sp & 255u) == 0u) { if (xb_ld(&(bar)[XB_TMO])) break; if (_sp > XB_SPIN_CAP) { atomicAdd(&(bar)[XB_TMO], 1u); break; } } } } while (0)
struct XcdBarrier { unsigned* bar; unsigned x; volatile LAS unsigned* st; };
__device__ __forceinline__ XcdBarrier xcd_barrier_post(unsigned* bar, volatile LAS unsigned* st) {
    XcdBarrier b; b.bar = bar; b.x = xb_xcc_id(); b.st = st;
    if (threadIdx.x == 0) (void)xb_add(&bar[XB_XCNT(b.x)], 1u);
    return b;
}
__device__ __forceinline__ void xcd_barrier_complete(unsigned* bar, unsigned x, unsigned& nloc, unsigned& nx) {
    const unsigned G = gridDim.x * gridDim.y * gridDim.z;
    unsigned sum, cnt, mine, sp = 0u;
    for (;;) {
        sum = 0u; cnt = 0u; mine = 0u;
#pragma unroll
        for (unsigned j = 0; j < 16; ++j) { const unsigned c = xb_ld(&bar[XB_XCNT(j)]); sum += c; cnt += (c > 0u) ? 1u : 0u; mine = (j == x) ? c : mine; }
        if (sum == G) break;
        __builtin_amdgcn_s_sleep(1);
        if ((++sp & 255u) == 0u) { if (xb_ld(&bar[XB_TMO])) break; if (sp > XB_SPIN_CAP) { atomicAdd(&bar[XB_TMO], 1u); break; } }
    }
    nloc = mine > 0u ? mine : 1u; nx = cnt > 0u ? cnt : 1u;
}
__device__ __forceinline__ void xcd_barrier(const XcdBarrier& b) {
    asm volatile("s_waitcnt vmcnt(0)" ::: "memory");
    __syncthreads();
    if (threadIdx.x == 0) {
        unsigned* bar = b.bar;
        __builtin_amdgcn_s_waitcnt(0);
        unsigned nloc = b.st[0], nx = b.st[1];
        if (nloc == 0u) { xcd_barrier_complete(bar, b.x, nloc, nx); b.st[0] = nloc; b.st[1] = nx; }
        const unsigned old = xb_add(&bar[XB_XSUB(b.x)], 1u);
        const unsigned gen = old / nloc;
        if (old + 1u == (gen + 1u) * nloc) {
            __builtin_amdgcn_fence(__ATOMIC_RELEASE, "agent");
            asm volatile("s_waitcnt vmcnt(0)" ::: "memory");
            const unsigned og = xb_add(&bar[XB_TOP], 1u);
            const unsigned tg = og / nx;
            if (og + 1u == (tg + 1u) * nx) xb_add(&bar[XB_TOPGEN], 1u);
            else XB_SPIN(xb_ld(&bar[XB_TOPGEN]) == tg, bar);
            __builtin_amdgcn_fence(__ATOMIC_ACQUIRE, "agent");
            xb_add(&bar[XB_XGEN(b.x)], 1u);
            asm volatile("s_waitcnt vmcnt(0)" ::: "memory");
        } else {
            XB_SPIN(xb_ld(&bar[XB_XGEN(b.x)]) == gen, bar);
            __builtin_amdgcn_fence(__ATOMIC_ACQUIRE, "agent");
            asm volatile("s_waitcnt vmcnt(0)" ::: "memory");
        }
    }
    __syncthreads();
}

__global__ void __launch_bounds__(512, 2) mega_fwd(Args a) {
    extern __shared__ __attribute__((aligned(16))) unsigned char lds_raw[];
    LAS unsigned char* lds = (LAS unsigned char*)lds_raw;
    cg::grid_group grid = cg::this_grid();
    const int G = gridDim.x, bx = blockIdx.x;
#define FRESH_IDS() const int tid = fresh_tid(), lane = tid & 63, wid = __builtin_amdgcn_readfirstlane(tid >> 6); (void)tid; (void)lane; (void)wid
    unsigned char* ws = a.ws;
    const float *x_p = a.in[0], *x_s = a.in[1], *cache_ckv = a.in[2], *cache_kr = a.in[3], *c_p = a.in[4], *c_s = a.in[5], *w_ada = a.in[6], *b_ada = a.in[7],
                *norm1_g = a.in[8], *w_in = a.in[9], *w_s = a.in[10], *b_s = a.in[11], *q_norm_g = a.in[12], *w_uq = a.in[13], *kv_norm_g = a.in[14], *w_ukv = a.in[15],
                *qn_g = a.in[16], *qr_g = a.in[17], *kn_g = a.in[18], *kr_g = a.in[19], *w_out = a.in[20], *norm2_g = a.in[21], *w_fi = a.in[22], *w_fo = a.in[23];
    float* out = a.out;
    float* PART = (float*)(ws + WS_PART); bf16_t* X1B = (bf16_t*)(ws + WS_X1B);
    float* MOD = (float*)(ws + WS_MOD); float* ROPE = (float*)(ws + WS_ROPE); float* SSQ = (float*)(ws + WS_SSQ);
    bf16_t *Wm = (bf16_t*)(ws + WS_WM), *Wt_in = (bf16_t*)(ws + WS_WIN), *Wt_uq = (bf16_t*)(ws + WS_WUQ), *Wt_ukv = (bf16_t*)(ws + WS_WUKV), *Wt_out = (bf16_t*)(ws + WS_WOUT),
           *Wt_fi = (bf16_t*)(ws + WS_WFI), *Wt_fo = (bf16_t*)(ws + WS_WFO), *Hb = (bf16_t*)(ws + WS_H), *YAB = (bf16_t*)(ws + WS_YAB), *Gb = (bf16_t*)(ws + WS_G),
           *Ub = (bf16_t*)(ws + WS_U), *Vt = (bf16_t*)(ws + WS_VT), *CQ = (bf16_t*)(ws + WS_CQ), *CKV = (bf16_t*)(ws + WS_CKV), *KR = (bf16_t*)(ws + WS_KR),
           *KN = (bf16_t*)(ws + WS_KN), *VVt = (bf16_t*)(ws + WS_VVT), *Qb = (bf16_t*)(ws + WS_Q);

    { const int t0 = threadIdx.x; if (t0 < 2) ((volatile LAS unsigned*)(lds + LDS_X + 8192))[t0] = 0u; }
    __syncthreads();
    const XcdBarrier xbar = xcd_barrier_post((unsigned*)(ws + WS_BAR), (volatile LAS unsigned*)(lds + LDS_X + 8192));
    {
        FRESH_IDS();
        for (int it = bx; it < 96; it += G) {
            LAS float* sl = (LAS float*)lds; LAS float* red = (LAS float*)(lds + 65536);
            for (int e = tid; e < 16384; e += 512) { const int r = e >> 10, k = e & 1023; const float c = r < 8 ? c_p[r * 1024 + k] : c_s[(r - 8) * 1024 + k]; sl[e] = silu_f(c); }
            __syncthreads();
            float acc[16];
#pragma unroll
            for (int r = 0; r < 16; ++r) acc[r] = 0.f;
            const float* wp = w_ada + (size_t)(wid * 128) * 6144 + it * 64 + lane;
            for (int k = 0; k < 128; k += 16) {
                float wv[16];
#pragma unroll
                for (int j = 0; j < 16; ++j) wv[j] = __builtin_nontemporal_load(wp + (size_t)(k + j) * 6144);
#pragma unroll
                for (int jj = 0; jj < 4; ++jj)
#pragma unroll
                    for (int r = 0; r < 16; ++r) { const f32x4 s4 = *(const LAS f32x4*)(sl + r * 1024 + wid * 128 + k + 4 * jj);
                        acc[r] += (s4[0] * wv[4 * jj] + s4[1] * wv[4 * jj + 1]) + (s4[2] * wv[4 * jj + 2] + s4[3] * wv[4 * jj + 3]); }
            }
#pragma unroll
            for (int r = 0; r < 16; ++r) red[(wid * 16 + r) * 64 + lane] = acc[r];
            __syncthreads();
            for (int e = tid; e < 1024; e += 512) { const int r = e >> 6, col = e & 63; float s = b_ada[it * 64 + col];
#pragma unroll
                for (int w = 0; w < 8; ++w) s += red[(w * 16 + r) * 64 + col];
                MOD[(size_t)r * 6144 + it * 64 + col] = s; }
            __syncthreads();
        }
        LAS float* scr = (LAS float*)(lds + wid * 16384);
        const int gw = ((bx + G - 96 % G) % G) * 8 + wid, NGW = G * 8;
        constexpr int I_IN = 16 * 56, I_UQ = 6 * 24, I_UKV = 4 * 32, I_OUT = 16 * 32, I_FI = 16 * 176, I_FO = 44 * 32, I_CKV = 4096, I_CKR = 2048, I_ROPE = 1024, I_WM = 1024;
        constexpr int NITEMS = I_IN + I_UQ + I_UKV + I_OUT + I_FI + I_FO + I_CKV + I_CKR + I_ROPE + I_WM;
        for (int it = gw; it < NITEMS; it += NGW) {
            int r = it;
            if (r < I_IN) { const int kb = r / 56, nb = r % 56, n0 = nb * 32;
                const int c0 = n0 < 512 ? n0 : n0 < 768 ? 1408 + (n0 - 512) : n0 < 1152 ? 1024 + (n0 - 768) : n0 < 1184 ? 1664 : n0 < 1280 ? -1 : 512 + (n0 - 1280);
                p0_transpose_item(w_in, 1696, c0, kb * 64, Wt_in, 1024, n0, nullptr, scr, lane); continue; } r -= I_IN;
            if (r < I_UQ) { const int kb = r / 24, nb = r % 24, pn = nb >> 3, bj = (nb >> 2) & 1, wc = nb & 3;
                const int c0 = pn < 2 ? 96 * (4 * pn + wc) + 32 * bj : 96 * (4 * bj + wc) + 64;
                p0_transpose_item(w_uq, 768, c0, kb * 64, Wt_uq, 384, nb * 32, q_norm_g, scr, lane); continue; } r -= I_UQ;
            if (r < I_UKV) { const int kb = r / 32, nb = r % 32; int c0;
                if (nb < 16) { const int pn = nb >> 3, bj = (nb >> 2) & 1, wc = nb & 3; c0 = 128 * (4 * pn + wc) + 32 * bj; }
                else { const int ch0 = (nb - 16) * 32; c0 = 128 * (ch0 >> 6) + 64 + (ch0 & 63); }
                p0_transpose_item(w_ukv, 1024, c0, kb * 64, Wt_ukv, 256, nb * 32, nullptr, scr, lane); continue; } r -= I_UKV;
            if (r < I_OUT) { const int kb = r / 32, nb = r % 32; p0_transpose_item(w_out, 1024, nb * 32, kb * 64, Wt_out, 1024, nb * 32, nullptr, scr, lane); continue; } r -= I_OUT;
            if (r < I_FI) { const int kb = r / 176, nb = r % 176, n0 = nb * 32, pn = n0 >> 8, bj = (n0 >> 7) & 1, rr = n0 & 127;
                p0_transpose_item(w_fi, 5632, bj * 2816 + 128 * pn + rr, kb * 64, Wt_fi, 1024, n0, nullptr, scr, lane); continue; } r -= I_FI;
            if (r < I_FO) { const int kb = r / 32, nb = r % 32; p0_transpose_item(w_fo, 1024, nb * 32, kb * 64, Wt_fo, 2816, nb * 32, nullptr, scr, lane); continue; } r -= I_FO;
            if (r < I_CKV) { const int row0 = r * 4, b = row0 >> 11, p = row0 & 2047; f32x4 v[4];
#pragma unroll
                for (int q = 0; q < 4; ++q) v[q] = __builtin_nontemporal_load((const f32x4*)(cache_ckv + (size_t)(row0 + q) * 256) + lane);
#pragma unroll
                for (int q = 0; q < 4; ++q) { u32x2 w; w.x = cvt_pk_bf16(v[q][0], v[q][1]); w.y = cvt_pk_bf16(v[q][2], v[q][3]);
                    *((u32x2*)(CKV + ((size_t)MP + b * 2112 + p + q) * 256) + lane) = w; }
                continue; } r -= I_CKV;
            if (r < I_CKR) { const int row = r * 8 + (lane >> 3), b = row >> 11, p = row & 2047; const f32x4 v = *((const f32x4*)(cache_kr + (size_t)row * 32) + (lane & 7));
                u32x2 w; w.x = cvt_pk_bf16(v[0], v[1]); w.y = cvt_pk_bf16(v[2], v[3]);
                *((u32x2*)(KR + ((size_t)MP + b * 2112 + p) * 32) + (lane & 7)) = w; continue; } r -= I_CKR;
            if (r < I_ROPE) { const int e = r * 64 + lane, pos = e >> 4, j = e & 15;
                const double inv = exp(-(double)j * (1.0 / 16.0) * 9.210340371976184);
                const double rev = (double)pos * inv * 0.15915494309189535; const float fr = (float)(rev - floor(rev));
                ROPE[(size_t)pos * 32 + j] = __builtin_amdgcn_cosf(fr); ROPE[(size_t)pos * 32 + 16 + j] = __builtin_amdgcn_sinf(fr); continue; } r -= I_ROPE;
            { const int e = r * 64 + lane, i = (e >> 7) & 127, j = e & 127; const float v = (j >> 6) <= (i >> 6) ? w_s[e] : 0.f; Wm[e] = (bf16_t)(cvt_pk_bf16(v, 0.f) & 0xffffu); }
        }
    }
    xcd_barrier(xbar);
    if (G == 0x7fffffff) grid.sync();

    { FRESH_IDS();
        int row = bx * 8 + wid; f32x4 nv[4];
        if (row < MT) norm_load(row < MP ? x_p + (size_t)row * DM : x_s + (size_t)(row - MP) * DM, nv, lane);
        for (; row < MT; row += G * 8) {
            f32x4 v[4];
#pragma unroll
            for (int j = 0; j < 4; ++j) v[j] = nv[j];
            const int nr = row + G * 8;
            if (nr < MT) norm_load(nr < MP ? x_p + (size_t)nr * DM : x_s + (size_t)(nr - MP) * DM, nv, lane);
            const int b16 = row < MP ? (row >> 12) : 8 + ((row - MP) >> 6);
            norm_apply(v, norm1_g, MOD + (size_t)b16 * 6144 + 1024, MOD + (size_t)b16 * 6144, Hb + (size_t)row * DM, lane);
        } }
    xcd_barrier(xbar);

    {
        ProgIn P; P.K = 1024; P.lda = 1024; P.ldb = 1024; P.G = G; P.c = bx; P.H = Hb; P.Wt = Wt_in; P.U = Ub; P.Vt = Vt; P.CQ = CQ; P.CKV = CKV; P.KR = KR; P.SSQ = SSQ; P.out = out;
        P.rope = ROPE; P.kvg = kv_norm_g; P.krg = kr_g; P.xl = (LAS float*)(lds + LDS_X);
        pg8::gemm_phase(lds, P);
    }
    xcd_barrier(xbar);

    {
        ProgQ P; P.K = 384; P.lda = 384; P.ldb = 384; P.G = G; P.c = bx; P.CQ = CQ; P.Wt = Wt_uq; P.SSQ = SSQ; P.Q = Qb; P.rope = ROPE; P.qng = qn_g; P.qrg = qr_g;
        pg8::gemm_phase(lds, P);
    }
    {
        ProgKV P; P.K = 256; P.lda = 256; P.ldb = 256; P.G = G; P.c = (G == 256) ? ((bx + 140) & 255) : bx;
        P.CKV = CKV; P.Wt = Wt_ukv; P.KN = KN; P.VVt = VVt; P.kng = kn_g;
        pg8::gemm_phase(lds, P);
    }
    gmlp_phase(lds, (G == 256) ? ((bx + 96) & 255) : bx, G, Wm, Vt, Ub, b_s, YAB);
    xcd_barrier(xbar);

    {
        const int vcu = (G % 8 == 0) ? (bx % 8) * (G / 8) + bx / 8 : bx;
        if (G == 256) {
            const int xcd = bx & 7; unsigned* ctr = (unsigned*)(ws + WS_CTR) + xcd * 64;
            volatile LAS int* qw = (volatile LAS int*)(lds + LDS_X + 8192 + 64);
            for (;;) {
                if (threadIdx.x == 0) qw[0] = (int)atomicAdd(ctr, 1u);
                __syncthreads();
                const int j = qw[0];
                __syncthreads();
                if (j >= 136) break;
                if (j < 96 || j >= 104) { const int jj = j < 96 ? j : j - 104, qb = j < 96 ? 15 - (jj >> 3) : 3 - (jj >> 3), bh = xcd * 8 + (jj & 7), b = bh >> 3, h = bh & 7;
                    const size_t r0 = (size_t)b * 4096 + qb * 256;
                    attn_unit(lds, Qb + r0 * 768, 8, 4 * qb, true, (size_t)b * 4096, 4 * qb + 4, h, KN, KR, VVt, YAB + r0 * DM);
                } else { const int bh = xcd * 8 + (j - 96), b2 = bh >> 3, h2 = bh & 7; const size_t r0 = (size_t)MP + b2 * 64;
                    attn_unit(lds, Qb + r0 * 768, 2, 0, false, (size_t)MP + b2 * 2112, 33, h2, KN, KR, VVt, YAB + r0 * DM); }
            }
        } else {
            for (int it = vcu; it < 1024 + 64; it += G) {
                if (it < 1024) { const int bh = it >> 4, qb = it & 15, b = bh >> 3, h = bh & 7;
                    const size_t r0 = (size_t)b * 4096 + qb * 256;
                    attn_unit(lds, Qb + r0 * 768, 8, 4 * qb, true, (size_t)b * 4096, 4 * qb + 4, h, KN, KR, VVt, YAB + r0 * DM);
                } else { const int bh = it - 1024, b = bh >> 3, h = bh & 7; const size_t r0 = (size_t)MP + b * 64;
                    attn_unit(lds, Qb + r0 * 768, 2, 0, false, (size_t)MP + b * 2112, 33, h, KN, KR, VVt, YAB + r0 * DM); }
            }
        }
    }
    xcd_barrier(xbar);

    {
        ProgRes<0> P; P.K = 1024; P.lda = 1024; P.ldb = 1024; P.G = G; P.c = bx; P.Ab = YAB; P.Wt = Wt_out; P.xp = x_p; P.Y = out; P.X1 = X1B; P.gate = MOD + 2048; P.part = PART; P.nsk = 4;
        pg8::gemm_phase(lds, P);
    }
    xcd_barrier(xbar);

    { FRESH_IDS();
        int row = bx * 8 + wid; f32x4 nv[4];
        if (row < MP) row_load_bf16(X1B + (size_t)row * DM, nv, lane);
        for (; row < MP; row += G * 8) {
            f32x4 v[4];
#pragma unroll
            for (int j = 0; j < 4; ++j) v[j] = nv[j];
            const int nr = row + G * 8;
            if (nr < MP) row_load_bf16(X1B + (size_t)nr * DM, nv, lane);
            const int b16 = row >> 12;
            norm_apply(v, norm2_g, MOD + (size_t)b16 * 6144 + 4096, MOD + (size_t)b16 * 6144 + 3072, Hb + (size_t)row * DM, lane);
        }
        for (int sr = ((bx + 128) % G) * 8 + wid; sr < MS; sr += G * 8) { const int b16 = 8 + (sr >> 6); f32x4 v[4];
            norm_load(x_s + (size_t)sr * DM, v, lane);
            sample_combine(MOD + (size_t)b16 * 6144 + 2048, PART, 4, sr, v, lane);
            row_store_bf16(X1B + (size_t)(MP + sr) * DM, v, lane);
            row_load_bf16(X1B + (size_t)(MP + sr) * DM, v, lane);
            norm_apply(v, norm2_g, MOD + (size_t)b16 * 6144 + 4096, MOD + (size_t)b16 * 6144 + 3072, Hb + (size_t)(MP + sr) * DM, lane);
        } }
    xcd_barrier(xbar);

    {
        ProgFfn P; P.K = 1024; P.lda = 1024; P.ldb = 1024; P.G = G; P.c = bx; P.Ab = Hb; P.Wt = Wt_fi; P.Gb = Gb;
        pg8::gemm_phase(lds, P);
    }
    xcd_barrier(xbar);

    {
        ProgRes<1> P; P.K = DFF; P.lda = DFF; P.ldb = DFF; P.G = G; P.c = bx; P.Ab = Gb; P.Wt = Wt_fo; P.xp = nullptr; P.Y = out; P.X1 = X1B; P.gate = MOD + 5120; P.part = PART; P.nsk = 11;
        pg8::gemm_phase(lds, P);
    }
    xcd_barrier(xbar);

    { FRESH_IDS();
        for (int sr = bx * 8 + wid; sr < MS; sr += G * 8) { const int b16 = 8 + (sr >> 6); f32x4 v[4];
            row_load_bf16(X1B + (size_t)(MP + sr) * DM, v, lane);
            sample_combine(MOD + (size_t)b16 * 6144 + 5120, PART, 11, sr, v, lane);
#pragma unroll
            for (int j = 0; j < 4; ++j) *((f32x4*)(out + (size_t)(MP + sr) * DM) + lane + 64 * j) = v[j]; } }
}

extern "C" void kernel_launch(void* const* d_in, const int* in_sizes, int n_in, void* d_out, int out_size, void* d_ws, size_t ws_size, hipStream_t stream) {
    static int grid = 0;
    if (grid == 0) {
        if (n_in != 24 || ws_size < WS_END) { fprintf(stderr, "kernel_launch: unexpected n_in %d / ws_size %zu (need %zu)\n", n_in, ws_size, (size_t)WS_END); grid = -1; return; }
        int dev = 0, cus = 0, per_cu = 0;
        hipGetDevice(&dev); hipDeviceGetAttribute(&cus, hipDeviceAttributeMultiprocessorCount, dev);
        if (hipFuncSetAttribute((const void*)mega_fwd, hipFuncAttributeMaxDynamicSharedMemorySize, LDS_BYTES) != hipSuccess) { fprintf(stderr, "kernel_launch: hipFuncSetAttribute failed\n"); grid = -1; return; }
        if (hipOccupancyMaxActiveBlocksPerMultiprocessor(&per_cu, (const void*)mega_fwd, 512, LDS_BYTES) != hipSuccess || per_cu < 1) { fprintf(stderr, "kernel_launch: occupancy query gave %d\n", per_cu); per_cu = 1; }
        (void)hipGetLastError();
        grid = cus;
        fprintf(stderr, "kernel_launch: grid %d (cus %d, per_cu %d)\n", grid, cus, per_cu);
    }
    if (grid < 0) return;
    if (hipMemsetAsync((char*)d_ws + WS_BAR, 0, 32768, stream) != hipSuccess) { fprintf(stderr, "kernel_launch: memset of control words failed\n"); return; }
    Args a{};
    for (int i = 0; i < 24; ++i) a.in[i] = (const float*)d_in[i];
    a.out = (float*)d_out; a.ws = (unsigned char*)d_ws;
    void* args[] = {&a};
    hipError_t e = hipLaunchCooperativeKernel((const void*)mega_fwd, dim3(grid), dim3(512), args, LDS_BYTES, stream);
    if (e != hipSuccess) fprintf(stderr, "kernel_launch: cooperative launch failed: %s (grid %d)\n", hipGetErrorString(e), grid);
}
```

```cpp
#include <hip/hip_runtime.h>
#include <hip/hip_cooperative_groups.h>
#include <cstdio>
#include <cstdint>
namespace cg = cooperative_groups;

#define LAS __attribute__((address_space(3)))
typedef unsigned short bf16_t;
typedef short bf16x8 __attribute__((ext_vector_type(8)));
typedef short s16x4 __attribute__((ext_vector_type(4)));
typedef float f32x4 __attribute__((ext_vector_type(4)));
typedef float f32x16 __attribute__((ext_vector_type(16)));
typedef unsigned u32x4 __attribute__((ext_vector_type(4)));
typedef unsigned u32x2 __attribute__((ext_vector_type(2)));

constexpr int MP = 32768, MS = 512, MT = MP + MS;
constexpr int DM = 1024, DFF = 2816;
constexpr int KVR = MP + 8 * 2112;
constexpr float EPS = 1e-6f;
constexpr float QSCALE = 0.10206207261596577f * 1.4426950408889634f;
constexpr size_t OFF_CKVP = 34078720, OFF_KRP = 42467328, OFF_CKVS = 43515904, OFF_KRS = 43646976, OFF_VS = 43663360;

constexpr size_t MiB = 1u << 20;
constexpr size_t WS_MOD = 0, WS_ROPE = 512 * 1024, WS_SSQ = 1 * MiB, WS_WM = 3 * MiB, WS_WIN = 4 * MiB, WS_WUQ = 8 * MiB, WS_WUKV = 9 * MiB,
                 WS_WOUT = 10 * MiB, WS_WFI = 12 * MiB, WS_WFO = 23 * MiB, WS_H = 29 * MiB, WS_YAB = 94 * MiB, WS_G = 159 * MiB,
                 WS_U = 159 * MiB, WS_VT = 192 * MiB, WS_CQ = 225 * MiB, WS_CKV = 250 * MiB, WS_KR = 275 * MiB, WS_KN = 279 * MiB,
                 WS_VVT = 328 * MiB, WS_Q = 377 * MiB, WS_END = 450 * MiB, WS_CTR = 3 * MiB - 4096, WS_BAR = 3 * MiB - 32768, WS_PART = 426 * MiB, WS_X1B = 345 * MiB;

constexpr int LDS_BYTES = 147456;
constexpr int LDS_X = 131072;

__device__ __forceinline__ unsigned cvt_pk_bf16(float lo, float hi) { unsigned r; asm("v_cvt_pk_bf16_f32 %0, %1, %2" : "=v"(r) : "v"(lo), "v"(hi)); return r; }
__device__ __forceinline__ float bf2f(unsigned short h) { return __uint_as_float(((unsigned)h) << 16); }
__device__ __forceinline__ float gelu_tanh(float x) {
    const float y2 = 1.5957691216057308f * x * (1.f + 0.044715f * x * x);
    const float e = __builtin_amdgcn_exp2f(-y2 * 1.4426950408889634f);
    return x * __builtin_amdgcn_rcpf(1.f + e);
}
__device__ __forceinline__ float silu_f(float x) { const float e = __builtin_amdgcn_exp2f(-x * 1.4426950408889634f); return x * __builtin_amdgcn_rcpf(1.f + e); }
__device__ __forceinline__ float wave_sum(float v) {
#pragma unroll
    for (int o = 1; o < 64; o <<= 1) v += __shfl_xor(v, o);
    return v;
}
typedef float f32x2 __attribute__((ext_vector_type(2)));
__device__ __forceinline__ float max3f(float a, float b, float c) { float r; asm("v_max3_f32 %0, %1, %2, %3" : "=v"(r) : "v"(a), "v"(b), "v"(c)); return r; }
#define LDS_WAIT() asm volatile("s_waitcnt lgkmcnt(0)" ::: "memory")
__device__ __forceinline__ int fresh_tid() { int t = threadIdx.x; asm volatile("" : "+v"(t)); return t; }

namespace pg8 {
constexpr int BM = 256, BK = 64, HALF = 128, HTB = HALF * BK * 2, STAGE_BYTES = 8 * HTB, NXCD = 8, WGM = 8;
__host__ __device__ __forceinline__ int lds_byte(int r, int c) { const int st = (r >> 4) * 2 + (c >> 5), rr = r & 15, cc = c & 31, ob = rr * 64 + cc * 2; return st * 1024 + (ob ^ (((ob >> 9) & 1) << 5)); }
__host__ __device__ __forceinline__ void stage_rc(int b, int& R, int& C) { const int st = b / 1024, sb = b % 1024, swz = sb ^ (((sb >> 9) & 1) << 5); R = (st >> 1) * 16 + swz / 64; C = (st & 1) * 32 + (swz % 64) / 2; }
__host__ __device__ __forceinline__ int perm32(int rho) { const int n = rho >> 4, i = rho & 15; return 8 * (i >> 2) + 4 * n + (i & 3); }

struct Unit { int pm, pn, kind; };
__device__ __forceinline__ int xcd_map(int L, int nwg) { const int q = nwg / NXCD, r = nwg % NXCD, xcd = L % NXCD, off = L / NXCD; return (xcd < r ? xcd * (q + 1) : r * (q + 1) + (xcd - r) * q) + off; }
__device__ __forceinline__ void grouped(int wgid, int nM, int nN, int& pm, int& pn) {
    const int nig = WGM * nN, gid = wgid / nig, fm = gid * WGM, gsz = (nM - fm) < WGM ? (nM - fm) : WGM;
    pm = fm + ((wgid % nig) % gsz); pn = (wgid % nig) / gsz;
}
template <class Prog>
__device__ __forceinline__ void gemm_phase(LAS unsigned char* lds, const Prog& P) {
    const int tid = fresh_tid(), wid = __builtin_amdgcn_readfirstlane(tid >> 6), lane = tid & 63, wr = wid >> 2, wc = wid & 3, fr = lane & 15, fq = lane >> 4;
    const int lda = P.lda, ldb = P.ldb;
    unsigned voffA[2], voffB[2];
#pragma unroll
    for (int i = 0; i < 2; ++i) { int R, C; stage_rc(tid * 16 + i * 8192, R, C); const int Rb = (R & ~31) + perm32(R & 31);
        voffA[i] = (unsigned)(R * lda + C) * 2u; voffB[i] = (unsigned)(Rb * ldb + C) * 2u; }
    const size_t kstep = (size_t)(BK * 2);
    const size_t hstepA = (size_t)HALF * lda * 2, hstepB = (size_t)HALF * ldb * 2;
    const unsigned ldsw = (unsigned)wid * 1024u;
    const int aoff = lds_byte(wr * 64 + fr, fq * 8), boff = lds_byte(wc * 32 + fr, fq * 8);
#define PG8_SA(b, h) (((b) * 2 + (h)) * HTB)
#define PG8_SB(b, h) ((4 + (b) * 2 + (h)) * HTB)
#define PG8_STAGE(bufoff, gbase, voff) do { _Pragma("unroll") for (int _i = 0; _i < 2; ++_i) \
        __builtin_amdgcn_global_load_lds((const unsigned*)((const char*)(gbase) + (voff)[_i]), (LAS unsigned*)(lds + (bufoff) + ldsw + _i * 8192), 16, 0, 0); } while (0)
#define PG8_LDA(dst, b, h) do { _Pragma("unroll") for (int m = 0; m < 4; ++m) _Pragma("unroll") for (int k = 0; k < 2; ++k) dst[m][k] = *(const LAS bf16x8*)(lds + PG8_SA(b, h) + aoff + m * 2048 + k * 1024); } while (0)
#define PG8_LDB(dst, b, h) do { _Pragma("unroll") for (int n = 0; n < 2; ++n) _Pragma("unroll") for (int k = 0; k < 2; ++k) dst[n][k] = *(const LAS bf16x8*)(lds + PG8_SB(b, h) + boff + n * 2048 + k * 1024); } while (0)
#define PG8_MMA(ai, bj, At, Bt) do { __builtin_amdgcn_s_setprio(1); _Pragma("unroll") for (int m = 0; m < 4; ++m) _Pragma("unroll") for (int n = 0; n < 2; ++n) _Pragma("unroll") for (int k = 0; k < 2; ++k) \
        acc[ai][bj][m][n] = __builtin_amdgcn_mfma_f32_16x16x32_bf16(Bt[n][k], At[m][k], acc[ai][bj][m][n], 0, 0, 0); __builtin_amdgcn_s_setprio(0); } while (0)
#define PG8_WAIT_V(n) asm volatile("s_waitcnt vmcnt(" #n ")" ::: "memory")
#define PG8_WAIT_L(n) asm volatile("s_waitcnt lgkmcnt(" #n ")" ::: "memory")
#define PG8_BAR __builtin_amdgcn_s_barrier()
#define PG8_SCHED __builtin_amdgcn_sched_barrier(0)
    Unit cur, nxt; int ui = 0;
    if (!P.next(0, cur)) return;
    f32x4 acc[2][2][4][2];
#pragma unroll
    for (int a = 0; a < 2; ++a)
#pragma unroll
        for (int b = 0; b < 2; ++b)
#pragma unroll
            for (int m = 0; m < 4; ++m)
#pragma unroll
                for (int n = 0; n < 2; ++n) acc[a][b][m][n] = (f32x4){0.f, 0.f, 0.f, 0.f};
    bf16x8 At[4][2], B0[2][2], B1[2][2];
    const char* cA = P.aptr(cur); const char* cB = P.bptr(cur);
    PG8_STAGE(PG8_SB(0, 0), cB, voffB); PG8_STAGE(PG8_SB(0, 1), cB + hstepB, voffB); PG8_STAGE(PG8_SA(0, 0), cA, voffA); PG8_STAGE(PG8_SA(0, 1), cA + hstepA, voffA);
    if (wr == 1) PG8_BAR;
    PG8_WAIT_V(2); PG8_BAR;
    PG8_STAGE(PG8_SB(1, 0), cB + kstep, voffB); PG8_STAGE(PG8_SA(1, 0), cA + kstep, voffA); PG8_STAGE(PG8_SB(1, 1), cB + hstepB + kstep, voffB);
    PG8_WAIT_V(6); PG8_BAR;
    for (;;) {
        const bool has_next = P.next(ui + 1, nxt);
        const int nt = P.nt(cur);
        const char* nA = has_next ? P.aptr(nxt) : cA; const char* nB = has_next ? P.bptr(nxt) : cB;
        for (int t = 0; t < nt; t += 2) {
            const bool last = (t == nt - 2);
            const char* a1 = cA + (size_t)(t + 1) * kstep;
            const char* a2 = last ? nA : cA + (size_t)(t + 2) * kstep; const char* b2 = last ? nB : cB + (size_t)(t + 2) * kstep;
            const char* a3 = a2 + kstep; const char* b3 = b2 + kstep;
            PG8_LDB(B0, 0, 0); PG8_LDB(B1, 0, 1); PG8_SCHED; PG8_LDA(At, 0, 0); PG8_STAGE(PG8_SA(1, 1), a1 + hstepA, voffA);
            PG8_WAIT_V(8); PG8_WAIT_L(0); PG8_BAR; PG8_MMA(0, 0, At, B0); PG8_MMA(0, 1, At, B1); PG8_BAR; PG8_SCHED;
            PG8_LDA(At, 0, 1); PG8_STAGE(PG8_SB(0, 0), b2, voffB); PG8_STAGE(PG8_SB(0, 1), b2 + hstepB, voffB); PG8_STAGE(PG8_SA(0, 0), a2, voffA);
            PG8_WAIT_V(8); PG8_WAIT_L(0); PG8_BAR; PG8_MMA(1, 0, At, B0); PG8_MMA(1, 1, At, B1); PG8_BAR; PG8_SCHED;
            PG8_LDB(B0, 1, 0); PG8_LDB(B1, 1, 1); PG8_SCHED; PG8_LDA(At, 1, 0); PG8_STAGE(PG8_SA(0, 1), a2 + hstepA, voffA);
            PG8_WAIT_V(8); PG8_WAIT_L(0); PG8_BAR; PG8_MMA(0, 0, At, B0); PG8_MMA(0, 1, At, B1); PG8_BAR; PG8_SCHED;
            PG8_LDA(At, 1, 1); PG8_STAGE(PG8_SB(1, 0), b3, voffB); PG8_STAGE(PG8_SB(1, 1), b3 + hstepB, voffB); PG8_STAGE(PG8_SA(1, 0), a3, voffA);
            PG8_WAIT_V(8); PG8_WAIT_L(0); PG8_BAR; PG8_MMA(1, 0, At, B0); PG8_MMA(1, 1, At, B1); PG8_BAR; PG8_SCHED;
        }
        if (wr == 0) PG8_BAR;
        P.epi(acc, cur, wr, wc, fr, fq);
        if (!has_next) break;
#pragma unroll
        for (int a = 0; a < 2; ++a)
#pragma unroll
            for (int b = 0; b < 2; ++b)
#pragma unroll
                for (int m = 0; m < 4; ++m)
#pragma unroll
                    for (int n = 0; n < 2; ++n) acc[a][b][m][n] = (f32x4){0.f, 0.f, 0.f, 0.f};
        cur = nxt; cA = nA; cB = nB; ++ui;
        if (wr == 1) PG8_BAR;
    }
    PG8_WAIT_V(0);
    PG8_BAR;
#undef PG8_SA
#undef PG8_SB
#undef PG8_STAGE
#undef PG8_LDA
#undef PG8_LDB
#undef PG8_MMA
#undef PG8_WAIT_V
#undef PG8_WAIT_L
#undef PG8_SCHED
}
}
using pg8::Unit;
typedef f32x4 Acc[2][2][4][2];

struct Args {
    const float* in[24];
    float* out;
    unsigned char* ws;
};

struct ProgIn {
    int K, lda, ldb, G, c;
    const bf16_t* H; const bf16_t* Wt;
    bf16_t *U, *Vt, *CQ, *CKV, *KR; float* SSQ; float* out; const float* rope; const float *kvg, *krg;
    LAS float* xl;
    static constexpr int NM = 130, NMAIN = 130 * 5, NSW = 2 * 130, NTOT = NMAIN + NSW;
    __device__ __forceinline__ bool next(int i, Unit& u) const {
        const int L = i * G + c; if (L >= NTOT) return false;
        const int w = pg8::xcd_map(L, NTOT);
        if (w < NMAIN) { pg8::grouped(w, NM, 5, u.pm, u.pn); u.kind = u.pn < 2 ? 0 : (u.pn == 2 ? 1 : 2); }
        else { pg8::grouped(w - NMAIN, 2, NM, u.pm, u.pn); u.kind = 3; }
        return true;
    }
    __device__ __forceinline__ int nt(const Unit&) const { return K / 64; }
    __device__ __forceinline__ const char* aptr(const Unit& u) const { return u.kind < 3 ? (const char*)(H + (size_t)u.pm * 256 * DM) : (const char*)(Wt + (size_t)(1280 + u.pm * 256) * DM); }
    __device__ __forceinline__ const char* bptr(const Unit& u) const { return u.kind < 3 ? (const char*)(Wt + (size_t)u.pn * 256 * DM) : (const char*)(H + (size_t)u.pn * 256 * DM); }
    __device__ __forceinline__ void epi(Acc& acc, const Unit& u, int wr, int wc, int fr, int fq) const {
        asm volatile("" : "+v"(fr), "+v"(fq));
        const int rl0 = wr * 64 + fr;
        if (u.kind == 0) {
#pragma unroll
            for (int ai = 0; ai < 2; ++ai)
#pragma unroll
                for (int m = 0; m < 4; ++m) { const size_t row = (size_t)u.pm * 256 + ai * 128 + rl0 + m * 16;
#pragma unroll
                    for (int bj = 0; bj < 2; ++bj) { const f32x4 v0 = acc[ai][bj][m][0], v1 = acc[ai][bj][m][1]; u32x4 w;
                        w.x = cvt_pk_bf16(gelu_tanh(v0[0]), gelu_tanh(v0[1])); w.y = cvt_pk_bf16(gelu_tanh(v0[2]), gelu_tanh(v0[3]));
                        w.z = cvt_pk_bf16(gelu_tanh(v1[0]), gelu_tanh(v1[1])); w.w = cvt_pk_bf16(gelu_tanh(v1[2]), gelu_tanh(v1[3]));
                        *(u32x4*)(U + row * 512 + u.pn * 256 + bj * 128 + wc * 32 + fq * 8) = w; } }
        } else if (u.kind == 3) {
            const bool samp = u.pn >= 128;
#pragma unroll
            for (int ai = 0; ai < 2; ++ai)
#pragma unroll
                for (int m = 0; m < 4; ++m) { const int ch = u.pm * 256 + ai * 128 + rl0 + m * 16;
#pragma unroll
                    for (int bj = 0; bj < 2; ++bj) { const f32x4 v0 = acc[ai][bj][m][0], v1 = acc[ai][bj][m][1];
                        float g[8] = {gelu_tanh(v0[0]), gelu_tanh(v0[1]), gelu_tanh(v0[2]), gelu_tanh(v0[3]), gelu_tanh(v1[0]), gelu_tanh(v1[1]), gelu_tanh(v1[2]), gelu_tanh(v1[3])};
                        u32x4 w; w.x = cvt_pk_bf16(g[0], g[1]); w.y = cvt_pk_bf16(g[2], g[3]); w.z = cvt_pk_bf16(g[4], g[5]); w.w = cvt_pk_bf16(g[6], g[7]);
                        const int tok = u.pn * 256 + bj * 128 + wc * 32 + fq * 8;
                        *(u32x4*)(Vt + (size_t)ch * MT + tok) = w;
                        if (samp) {
#pragma unroll
                            for (int e = 0; e < 8; ++e) out[OFF_VS + (size_t)(tok - MP + e) * 512 + ch] = g[e]; } } }
        } else if (u.kind == 1) {
#pragma unroll
            for (int ai = 0; ai < 2; ++ai)
#pragma unroll
                for (int m = 0; m < 4; ++m) { float s = 0.f;
#pragma unroll
                    for (int bj = 0; bj < 2; ++bj)
#pragma unroll
                        for (int n = 0; n < 2; ++n) { const f32x4 x = acc[ai][bj][m][n]; s += (x[0] * x[0] + x[1] * x[1]) + (x[2] * x[2] + x[3] * x[3]); }
                    s += __shfl_xor(s, 16); s += __shfl_xor(s, 32);
                    if (fq == 0) xl[(ai * 128 + rl0 + m * 16) * 4 + wc] = s; }
            LDS_WAIT(); __builtin_amdgcn_s_barrier(); asm volatile("" ::: "memory");
            f32x4 gv[2][2];
#pragma unroll
            for (int bj = 0; bj < 2; ++bj)
#pragma unroll
                for (int n = 0; n < 2; ++n) gv[bj][n] = *(const f32x4*)(kvg + bj * 128 + wc * 32 + fq * 8 + n * 4);
#pragma unroll
            for (int ai = 0; ai < 2; ++ai)
#pragma unroll
                for (int m = 0; m < 4; ++m) { const int rl = ai * 128 + rl0 + m * 16; const f32x4 p = *(const LAS f32x4*)(xl + rl * 4);
                    const float rstd = rsqrtf(((p[0] + p[1]) + (p[2] + p[3])) * (1.f / 256.f) + EPS);
                    const int row = u.pm * 256 + rl; size_t kvrow; float* o;
                    if (row < MP) { kvrow = row; o = out + OFF_CKVP + (size_t)row * 256; }
                    else { const int s = row - MP, b = s >> 6, t = s & 63; kvrow = (size_t)MP + b * 2112 + 2048 + t; o = out + OFF_CKVS + (size_t)s * 256; }
#pragma unroll
                    for (int bj = 0; bj < 2; ++bj) { const f32x4 v0 = acc[ai][bj][m][0] * rstd * gv[bj][0], v1 = acc[ai][bj][m][1] * rstd * gv[bj][1];
                        const int col = bj * 128 + wc * 32 + fq * 8;
                        __builtin_nontemporal_store(v0, (f32x4*)(o + col)); __builtin_nontemporal_store(v1, (f32x4*)(o + col + 4));
                        u32x4 w; w.x = cvt_pk_bf16(v0[0], v0[1]); w.y = cvt_pk_bf16(v0[2], v0[3]); w.z = cvt_pk_bf16(v1[0], v1[1]); w.w = cvt_pk_bf16(v1[2], v1[3]);
                        *(u32x4*)(CKV + kvrow * 256 + col) = w; } }
            LDS_WAIT(); __builtin_amdgcn_s_barrier(); asm volatile("" ::: "memory");
        } else {
            const int t2 = u.pn - 3;
#pragma unroll
            for (int ai = 0; ai < 2; ++ai)
#pragma unroll
                for (int m = 0; m < 4; ++m) { const int row = u.pm * 256 + ai * 128 + rl0 + m * 16; float s = 0.f;
#pragma unroll
                    for (int bj = 0; bj < 2; ++bj) { if (t2 == 1 && bj == 1) continue;
                        const f32x4 v0 = acc[ai][bj][m][0], v1 = acc[ai][bj][m][1];
                        s += (v0[0] * v0[0] + v0[1] * v0[1]) + (v0[2] * v0[2] + v0[3] * v0[3]) + (v1[0] * v1[0] + v1[1] * v1[1]) + (v1[2] * v1[2] + v1[3] * v1[3]);
                        u32x4 w; w.x = cvt_pk_bf16(v0[0], v0[1]); w.y = cvt_pk_bf16(v0[2], v0[3]); w.z = cvt_pk_bf16(v1[0], v1[1]); w.w = cvt_pk_bf16(v1[2], v1[3]);
                        *(u32x4*)(CQ + (size_t)row * 384 + t2 * 256 + bj * 128 + wc * 32 + fq * 8) = w; }
                    s += __shfl_xor(s, 16); s += __shfl_xor(s, 32);
                    if (fq == 0) SSQ[(size_t)row * 8 + t2 * 4 + wc] = s; }
            if (t2 == 1 && wc == 0) {
                const f32x4 g0 = *(const f32x4*)(krg + fq * 8), g1 = *(const f32x4*)(krg + fq * 8 + 4);
#pragma unroll
                for (int ai = 0; ai < 2; ++ai)
#pragma unroll
                    for (int m = 0; m < 4; ++m) { const int row = u.pm * 256 + ai * 128 + rl0 + m * 16;
                        f32x4 v0 = acc[ai][1][m][0], v1 = acc[ai][1][m][1];
                        float s = (v0[0] * v0[0] + v0[1] * v0[1]) + (v0[2] * v0[2] + v0[3] * v0[3]) + (v1[0] * v1[0] + v1[1] * v1[1]) + (v1[2] * v1[2] + v1[3] * v1[3]);
                        s += __shfl_xor(s, 16); s += __shfl_xor(s, 32);
                        const float rstd = rsqrtf(s * (1.f / 32.f) + EPS);
                        v0 = v0 * rstd * g0; v1 = v1 * rstd * g1;
                        int pos; size_t kvrow; float* o;
                        if (row < MP) { pos = row & 4095; kvrow = row; o = out + OFF_KRP + (size_t)row * 32; }
                        else { const int sr = row - MP, b = sr >> 6, t = sr & 63; pos = 2048 + t; kvrow = (size_t)MP + b * 2112 + 2048 + t; o = out + OFF_KRS + (size_t)sr * 32; }
                        const float* rp = rope + (size_t)pos * 32 + (fq & 1) * 8;
                        const f32x4 c0 = *(const f32x4*)rp, c1 = *(const f32x4*)(rp + 4), s0 = *(const f32x4*)(rp + 16), s1 = *(const f32x4*)(rp + 20);
                        f32x4 p0, p1;
#pragma unroll
                        for (int e = 0; e < 4; ++e) { p0[e] = __shfl_xor(v0[e], 32); p1[e] = __shfl_xor(v1[e], 32); }
                        const float sg = fq < 2 ? -1.f : 1.f;
                        const f32x4 r0 = v0 * c0 + p0 * s0 * sg, r1 = v1 * c1 + p1 * s1 * sg;
                        __builtin_nontemporal_store(r0, (f32x4*)(o + fq * 8)); __builtin_nontemporal_store(r1, (f32x4*)(o + fq * 8 + 4));
                        u32x4 w; w.x = cvt_pk_bf16(r0[0], r0[1]); w.y = cvt_pk_bf16(r0[2], r0[3]); w.z = cvt_pk_bf16(r1[0], r1[1]); w.w = cvt_pk_bf16(r1[2], r1[3]);
                        *(u32x4*)(KR + kvrow * 32 + fq * 8) = w; }
            }
        }
    }
};

struct ProgQ {
    int K, lda, ldb, G, c;
    const bf16_t* CQ; const bf16_t* Wt; const float* SSQ; bf16_t* Q; const float* rope; const float *qng, *qrg;
    static constexpr int NM = 130, NTOT = 130 * 3;
    __device__ __forceinline__ bool next(int i, Unit& u) const { const int L = i * G + c; if (L >= NTOT) return false; pg8::grouped(pg8::xcd_map(L, NTOT), NM, 3, u.pm, u.pn); u.kind = 0; return true; }
    __device__ __forceinline__ int nt(const Unit&) const { return K / 64; }
    __device__ __forceinline__ const char* aptr(const Unit& u) const { return (const char*)(CQ + (size_t)u.pm * 256 * 384); }
    __device__ __forceinline__ const char* bptr(const Unit& u) const { return (const char*)(Wt + (size_t)u.pn * 256 * 384); }
    __device__ __forceinline__ void epi(Acc& acc, const Unit& u, int wr, int wc, int fr, int fq) const {
        asm volatile("" : "+v"(fr), "+v"(fq));
        const int rl0 = wr * 64 + fr;
#pragma unroll
        for (int ai = 0; ai < 2; ++ai)
#pragma unroll
            for (int m = 0; m < 4; ++m) { const int row = u.pm * 256 + ai * 128 + rl0 + m * 16;
                const f32x4 q0 = *(const f32x4*)(SSQ + (size_t)row * 8), q1 = *(const f32x4*)(SSQ + (size_t)row * 8 + 4);
                const float rq = rsqrtf((((q0[0] + q0[1]) + (q0[2] + q0[3])) + ((q1[0] + q1[1]) + (q1[2] + q1[3]))) * (1.f / 384.f) + EPS);
                if (u.pn < 2) {
                    const int head = u.pn * 4 + wc; float s = 0.f; f32x4 v[2][2];
#pragma unroll
                    for (int bj = 0; bj < 2; ++bj)
#pragma unroll
                        for (int n = 0; n < 2; ++n) { v[bj][n] = acc[ai][bj][m][n] * rq; const f32x4 x = v[bj][n]; s += (x[0] * x[0] + x[1] * x[1]) + (x[2] * x[2] + x[3] * x[3]); }
                    s += __shfl_xor(s, 16); s += __shfl_xor(s, 32);
                    const float r2 = rsqrtf(s * (1.f / 64.f) + EPS) * QSCALE;
#pragma unroll
                    for (int bj = 0; bj < 2; ++bj) { const f32x4 g0 = *(const f32x4*)(qng + bj * 32 + fq * 8), g1 = *(const f32x4*)(qng + bj * 32 + fq * 8 + 4);
                        const f32x4 a = v[bj][0] * r2 * g0, b = v[bj][1] * r2 * g1;
                        u32x4 w; w.x = cvt_pk_bf16(a[0], a[1]); w.y = cvt_pk_bf16(a[2], a[3]); w.z = cvt_pk_bf16(b[0], b[1]); w.w = cvt_pk_bf16(b[2], b[3]);
                        *(u32x4*)(Q + (size_t)row * 768 + head * 96 + bj * 32 + fq * 8) = w; }
                } else {
                    const int pos = row < MP ? (row & 4095) : 2048 + ((row - MP) & 63);
                    const float* rp = rope + (size_t)pos * 32 + (fq & 1) * 8;
                    const f32x4 c0 = *(const f32x4*)rp, c1 = *(const f32x4*)(rp + 4), s0 = *(const f32x4*)(rp + 16), s1 = *(const f32x4*)(rp + 20);
                    const f32x4 g0 = *(const f32x4*)(qrg + fq * 8), g1 = *(const f32x4*)(qrg + fq * 8 + 4);
                    const float sg = fq < 2 ? -1.f : 1.f;
#pragma unroll
                    for (int bj = 0; bj < 2; ++bj) { const int head = bj * 4 + wc;
                        f32x4 v0 = acc[ai][bj][m][0] * rq, v1 = acc[ai][bj][m][1] * rq;
                        float s = (v0[0] * v0[0] + v0[1] * v0[1]) + (v0[2] * v0[2] + v0[3] * v0[3]) + (v1[0] * v1[0] + v1[1] * v1[1]) + (v1[2] * v1[2] + v1[3] * v1[3]);
                        s += __shfl_xor(s, 16); s += __shfl_xor(s, 32);
                        const float r2 = rsqrtf(s * (1.f / 32.f) + EPS);
                        v0 = v0 * r2 * g0; v1 = v1 * r2 * g1;
                        f32x4 p0, p1;
#pragma unroll
                        for (int e = 0; e < 4; ++e) { p0[e] = __shfl_xor(v0[e], 32); p1[e] = __shfl_xor(v1[e], 32); }
                        const f32x4 r0 = (v0 * c0 + p0 * s0 * sg) * QSCALE, r1 = (v1 * c1 + p1 * s1 * sg) * QSCALE;
                        u32x4 w; w.x = cvt_pk_bf16(r0[0], r0[1]); w.y = cvt_pk_bf16(r0[2], r0[3]); w.z = cvt_pk_bf16(r1[0], r1[1]); w.w = cvt_pk_bf16(r1[2], r1[3]);
                        *(u32x4*)(Q + (size_t)row * 768 + head * 96 + 64 + fq * 8) = w; }
                } }
    }
};

struct ProgKV {
    int K, lda, ldb, G, c;
    const bf16_t* CKV; const bf16_t* Wt; bf16_t *KN, *VVt; const float* kng;
    static constexpr int NM = 194, NA = 194 * 2, NTOT = 194 * 4;
    __device__ __forceinline__ bool next(int i, Unit& u) const {
        const int L = i * G + c; if (L >= NTOT) return false;
        const int w = pg8::xcd_map(L, NTOT);
        if (w < NA) { pg8::grouped(w, NM, 2, u.pm, u.pn); u.kind = 0; } else { pg8::grouped(w - NA, 2, NM, u.pm, u.pn); u.kind = 1; }
        return true;
    }
    __device__ __forceinline__ int nt(const Unit&) const { return K / 64; }
    __device__ __forceinline__ const char* aptr(const Unit& u) const { return u.kind == 0 ? (const char*)(CKV + (size_t)u.pm * 256 * 256) : (const char*)(Wt + (size_t)(512 + u.pm * 256) * 256); }
    __device__ __forceinline__ const char* bptr(const Unit& u) const { return u.kind == 0 ? (const char*)(Wt + (size_t)u.pn * 256 * 256) : (const char*)(CKV + (size_t)u.pn * 256 * 256); }
    __device__ __forceinline__ void epi(Acc& acc, const Unit& u, int wr, int wc, int fr, int fq) const {
        asm volatile("" : "+v"(fr), "+v"(fq));
        const int rl0 = wr * 64 + fr;
#pragma unroll
        for (int ai = 0; ai < 2; ++ai)
#pragma unroll
            for (int m = 0; m < 4; ++m) { const size_t row = (size_t)u.pm * 256 + ai * 128 + rl0 + m * 16;
                if (u.kind == 0) {
                    const int head = u.pn * 4 + wc; float s = 0.f;
#pragma unroll
                    for (int bj = 0; bj < 2; ++bj)
#pragma unroll
                        for (int n = 0; n < 2; ++n) { const f32x4 x = acc[ai][bj][m][n]; s += (x[0] * x[0] + x[1] * x[1]) + (x[2] * x[2] + x[3] * x[3]); }
                    s += __shfl_xor(s, 16); s += __shfl_xor(s, 32);
                    const float r2 = rsqrtf(s * (1.f / 64.f) + EPS);
#pragma unroll
                    for (int bj = 0; bj < 2; ++bj) { const f32x4 g0 = *(const f32x4*)(kng + bj * 32 + fq * 8), g1 = *(const f32x4*)(kng + bj * 32 + fq * 8 + 4);
                        const f32x4 a = acc[ai][bj][m][0] * r2 * g0, b = acc[ai][bj][m][1] * r2 * g1;
                        u32x4 w; w.x = cvt_pk_bf16(a[0], a[1]); w.y = cvt_pk_bf16(a[2], a[3]); w.z = cvt_pk_bf16(b[0], b[1]); w.w = cvt_pk_bf16(b[2], b[3]);
                        *(u32x4*)(KN + row * 512 + head * 64 + bj * 32 + fq * 8) = w; }
                } else {
#pragma unroll
                    for (int bj = 0; bj < 2; ++bj) { const f32x4 a = acc[ai][bj][m][0], b = acc[ai][bj][m][1];
                        u32x4 w; w.x = cvt_pk_bf16(a[0], a[1]); w.y = cvt_pk_bf16(a[2], a[3]); w.z = cvt_pk_bf16(b[0], b[1]); w.w = cvt_pk_bf16(b[2], b[3]);
                        *(u32x4*)(VVt + row * KVR + (size_t)u.pn * 256 + bj * 128 + wc * 32 + fq * 8) = w; }
                } }
    }
};

template <int MODE>
struct ProgRes {
    int K, lda, ldb, G, c, nsk;
    const bf16_t* Ab; const bf16_t* Wt; const float* xp; float* Y; bf16_t* X1; const float* gate; float* part;
    __device__ __forceinline__ bool next(int i, Unit& u) const {
        const int L = i * G + c; if (L >= 512 + 8 * nsk) return false;
        int pm, pn; pg8::grouped(pg8::xcd_map(L < 512 ? L : 0, 512), 128, 4, pm, pn);
        const int idx = L - 512, rem = idx & 7; const bool sp = L >= 512;
        u.pm = sp ? 128 + (rem >> 2) : pm; u.pn = sp ? (rem & 3) : pn; u.kind = sp ? 1 + (idx >> 3) : 0;
        return true;
    }
    __device__ __forceinline__ int nt(const Unit& u) const { return u.kind == 0 ? K / 64 : 4; }
    __device__ __forceinline__ const char* aptr(const Unit& u) const { return (const char*)(Ab + (size_t)u.pm * 256 * K + (u.kind ? (u.kind - 1) * 256 : 0)); }
    __device__ __forceinline__ const char* bptr(const Unit& u) const { return (const char*)(Wt + (size_t)u.pn * 256 * K + (u.kind ? (u.kind - 1) * 256 : 0)); }
    __device__ __forceinline__ void epi(Acc& acc, const Unit& u, int wr, int wc, int fr, int fq) const {
        asm volatile("" : "+v"(fr), "+v"(fq));
        const int rl0 = wr * 64 + fr;
        if (u.kind == 0) {
            const int b16 = u.pm >> 4;
#pragma unroll
            for (int ai = 0; ai < 2; ++ai) {
                f32x4 gv[2][2];
#pragma unroll
                for (int bj = 0; bj < 2; ++bj)
#pragma unroll
                    for (int n = 0; n < 2; ++n) gv[bj][n] = *(const f32x4*)(gate + (size_t)b16 * 6144 + u.pn * 256 + bj * 128 + wc * 32 + fq * 8 + n * 4);
#pragma unroll
                for (int m = 0; m < 4; ++m) { const int row = u.pm * 256 + ai * 128 + rl0 + m * 16;
#pragma unroll
                    for (int bj = 0; bj < 2; ++bj) { const int col = u.pn * 256 + bj * 128 + wc * 32 + fq * 8;
                        if constexpr (MODE == 0) {
                            const float* bp = xp + (size_t)row * DM;
                            const f32x4 r0 = *(const f32x4*)(bp + col) + gv[bj][0] * acc[ai][bj][m][0], r1 = *(const f32x4*)(bp + col + 4) + gv[bj][1] * acc[ai][bj][m][1];
                            u32x4 w; w.x = cvt_pk_bf16(r0[0], r0[1]); w.y = cvt_pk_bf16(r0[2], r0[3]); w.z = cvt_pk_bf16(r1[0], r1[1]); w.w = cvt_pk_bf16(r1[2], r1[3]);
                            *(u32x4*)(X1 + (size_t)row * DM + col) = w;
                        } else {
                            const u32x4 w = *(const u32x4*)(X1 + (size_t)row * DM + col);
                            const f32x4 b0 = (f32x4){__uint_as_float(w.x << 16), __uint_as_float(w.x & 0xffff0000u), __uint_as_float(w.y << 16), __uint_as_float(w.y & 0xffff0000u)};
                            const f32x4 b1 = (f32x4){__uint_as_float(w.z << 16), __uint_as_float(w.z & 0xffff0000u), __uint_as_float(w.w << 16), __uint_as_float(w.w & 0xffff0000u)};
                            __builtin_nontemporal_store(b0 + gv[bj][0] * acc[ai][bj][m][0], (f32x4*)(Y + (size_t)row * DM + col));
                            __builtin_nontemporal_store(b1 + gv[bj][1] * acc[ai][bj][m][1], (f32x4*)(Y + (size_t)row * DM + col + 4));
                        } } }
            }
        } else {
            float* pb = part + (size_t)(u.kind - 1) * 512 * DM;
#pragma unroll
            for (int ai = 0; ai < 2; ++ai)
#pragma unroll
                for (int m = 0; m < 4; ++m) { const int srow = (u.pm - 128) * 256 + ai * 128 + rl0 + m * 16;
#pragma unroll
                    for (int bj = 0; bj < 2; ++bj) { const int col = u.pn * 256 + bj * 128 + wc * 32 + fq * 8;
                        *(f32x4*)(pb + (size_t)srow * DM + col) = acc[ai][bj][m][0];
                        *(f32x4*)(pb + (size_t)srow * DM + col + 4) = acc[ai][bj][m][1]; } }
        }
    }
};

struct ProgFfn {
    int K, lda, ldb, G, c;
    const bf16_t* Ab; const bf16_t* Wt; bf16_t* Gb;
    static constexpr int NM = 130, NN = 22, NTOT = 130 * 22;
    __device__ __forceinline__ bool next(int i, Unit& u) const { const int L = i * G + c; if (L >= NTOT) return false; pg8::grouped(pg8::xcd_map(L, NTOT), NM, NN, u.pm, u.pn); u.kind = 0; return true; }
    __device__ __forceinline__ int nt(const Unit&) const { return K / 64; }
    __device__ __forceinline__ const char* aptr(const Unit& u) const { return (const char*)(Ab + (size_t)u.pm * 256 * DM); }
    __device__ __forceinline__ const char* bptr(const Unit& u) const { return (const char*)(Wt + (size_t)u.pn * 256 * DM); }
    __device__ __forceinline__ void epi(Acc& acc, const Unit& u, int wr, int wc, int fr, int fq) const {
        asm volatile("" : "+v"(fr), "+v"(fq));
        const int rl0 = wr * 64 + fr;
#pragma unroll
        for (int ai = 0; ai < 2; ++ai)
#pragma unroll
            for (int m = 0; m < 4; ++m) { const size_t row = (size_t)u.pm * 256 + ai * 128 + rl0 + m * 16;
                const f32x4 g0 = acc[ai][0][m][0], g1 = acc[ai][0][m][1], u0 = acc[ai][1][m][0], u1 = acc[ai][1][m][1];
                u32x4 w; w.x = cvt_pk_bf16(silu_f(g0[0]) * u0[0], silu_f(g0[1]) * u0[1]); w.y = cvt_pk_bf16(silu_f(g0[2]) * u0[2], silu_f(g0[3]) * u0[3]);
                w.z = cvt_pk_bf16(silu_f(g1[0]) * u1[0], silu_f(g1[1]) * u1[1]); w.w = cvt_pk_bf16(silu_f(g1[2]) * u1[2], silu_f(g1[3]) * u1[3]);
                __builtin_nontemporal_store(w, (u32x4*)(Gb + row * DFF + u.pn * 128 + wc * 32 + fq * 8)); }
    }
};

__device__ __forceinline__ void p0_transpose_item(const float* W, int ldw, int c0, int k0, bf16_t* WT, int K, int n0, const float* kscale, LAS float* scr, int lane) {
#pragma unroll
    for (int i = 0; i < 32; ++i) { const int kk = 2 * i + (lane >> 5); float v = 0.f;
        if (c0 >= 0) v = __builtin_nontemporal_load(W + (size_t)(k0 + kk) * ldw + c0 + (lane & 31));
        if (kscale) v *= kscale[k0 + kk];
        scr[kk * 33 + (lane & 31)] = v; }
    LDS_WAIT(); asm volatile("" ::: "memory");
    const int c = lane & 7;
#pragma unroll
    for (int j = 0; j < 4; ++j) { const int n = (lane >> 3) + 8 * j; const LAS float* s = scr + (8 * c) * 33 + n;
        u32x4 o; o.x = cvt_pk_bf16(s[0 * 33], s[1 * 33]); o.y = cvt_pk_bf16(s[2 * 33], s[3 * 33]); o.z = cvt_pk_bf16(s[4 * 33], s[5 * 33]); o.w = cvt_pk_bf16(s[6 * 33], s[7 * 33]);
        *(u32x4*)(WT + (size_t)(n0 + n) * K + k0 + 8 * c) = o; }
    LDS_WAIT(); asm volatile("" ::: "memory");
}
__device__ __forceinline__ void norm_load(const float* xrow, f32x4 (&v)[4], int lane) {
#pragma unroll
    for (int j = 0; j < 4; ++j) v[j] = __builtin_nontemporal_load((const f32x4*)xrow + lane + 64 * j);
}
__device__ __forceinline__ void norm_apply(const f32x4 (&v)[4], const float* g, const float* sc, const float* sh, bf16_t* orow, int lane) {
    float s = 0.f;
#pragma unroll
    for (int j = 0; j < 4; ++j) s += (v[j][0] * v[j][0] + v[j][1] * v[j][1]) + (v[j][2] * v[j][2] + v[j][3] * v[j][3]);
    const float rstd = rsqrtf(wave_sum(s) * (1.f / 1024.f) + EPS);
#pragma unroll
    for (int j = 0; j < 4; ++j) { const int c4 = lane + 64 * j;
        const f32x4 gg = *((const f32x4*)g + c4), cc = *((const f32x4*)sc + c4), hh = *((const f32x4*)sh + c4);
        const f32x4 h = v[j] * rstd * gg * (cc + 1.f) + hh;
        u32x2 w; w.x = cvt_pk_bf16(h[0], h[1]); w.y = cvt_pk_bf16(h[2], h[3]);
        *((u32x2*)orow + c4) = w; }
}
__device__ __forceinline__ void sample_combine(const float* gate, const float* part, int nsk, int srow, f32x4 (&v)[4], int lane) {
#pragma unroll
    for (int j = 0; j < 4; ++j) { const int c4 = lane + 64 * j; f32x4 a = (f32x4){0.f, 0.f, 0.f, 0.f};
        for (int k = 0; k < nsk; ++k) a += *((const f32x4*)(part + ((size_t)k * 512 + srow) * DM) + c4);
        v[j] = v[j] + *((const f32x4*)gate + c4) * a; }
}
__device__ __forceinline__ void row_load_bf16(const bf16_t* row, f32x4 (&v)[4], int lane) {
#pragma unroll
    for (int j = 0; j < 4; ++j) { const u32x2 w = __builtin_nontemporal_load((const u32x2*)row + lane + 64 * j);
        v[j] = (f32x4){__uint_as_float(w.x << 16), __uint_as_float(w.x & 0xffff0000u), __uint_as_float(w.y << 16), __uint_as_float(w.y & 0xffff0000u)}; }
}
__device__ __forceinline__ void row_store_bf16(bf16_t* row, const f32x4 (&v)[4], int lane) {
#pragma unroll
    for (int j = 0; j < 4; ++j) { u32x2 w; w.x = cvt_pk_bf16(v[j][0], v[j][1]); w.y = cvt_pk_bf16(v[j][2], v[j][3]); *((u32x2*)row + lane + 64 * j) = w; }
}

constexpr int GM_PITCH = 272;
__device__ __forceinline__ void gmlp_phase(LAS unsigned char* lds, int it0, int G, const bf16_t* Wm, const bf16_t* Vt, const bf16_t* U, const float* bs, bf16_t* YAB) {
    const int tid = fresh_tid(), lane = tid & 63, wid = __builtin_amdgcn_readfirstlane(tid >> 6), fr = lane & 15, fq = lane >> 4;
    constexpr int NIT = 1024 + 32;
    u32x4 st[4];
#define GM_LOAD(item) do { const bool samp_ = (item) >= 1024; const int g_ = (item) & 3; const int tok_ = samp_ ? MP + 64 * (((item) - 1024) >> 2) : 128 * ((item) >> 2); \
        _Pragma("unroll") for (int q = 0; q < 4; ++q) { const int c_ = tid + 512 * q, row_ = c_ >> 4, ch_ = c_ & 15; \
            if (!samp_ || ch_ < 8) st[q] = __builtin_nontemporal_load((const u32x4*)(Vt + (size_t)(128 * g_ + row_) * MT + tok_ + ch_ * 8)); else st[q] = (u32x4){0u, 0u, 0u, 0u}; } } while (0)
    int item = it0;
    if (item < NIT) GM_LOAD(item);
    for (; item < NIT; item += G) {
        const bool samp = item >= 1024; const int g = item & 3;
        const int tok0 = samp ? MP + 64 * ((item - 1024) >> 2) : 128 * (item >> 2);
        const bool active = !(samp && wid >= 4);
        const int nk = (samp || wid < 4) ? 2 : 4;
        const int row = tok0 + 16 * wid + fr;
        bf16x8 bfr[4]; u32x2 uu8[8]; float bias = 0.f;
        if (active) {
            const bf16_t* wrow = Wm + (size_t)(g * 128 + 16 * wid + fr) * 128 + 8 * fq;
#pragma unroll
            for (int kk = 0; kk < 4; ++kk) bfr[kk] = *(const bf16x8*)(wrow + 32 * kk);
#pragma unroll
            for (int n = 0; n < 8; ++n) uu8[n] = __builtin_nontemporal_load((const u32x2*)(U + (size_t)row * 512 + 128 * g + 16 * n + 4 * fq));
            bias = bs[g * 128 + 16 * wid + fr];
        }
#pragma unroll
        for (int q = 0; q < 4; ++q) { const int c = tid + 512 * q; *(LAS u32x4*)(lds + (c >> 4) * GM_PITCH + (c & 15) * 16) = st[q]; }
        __syncthreads();
        if (item + G < NIT) GM_LOAD(item + G);
        if (active) {
            f32x4 acc[8];
#pragma unroll
            for (int n = 0; n < 8; ++n) acc[n] = (f32x4){0.f, 0.f, 0.f, 0.f};
            const LAS unsigned char* ab = lds + fr * GM_PITCH + fq * 16;
#pragma unroll
            for (int kk = 0; kk < 4; ++kk) { if (kk < nk) {
#pragma unroll
                for (int n = 0; n < 8; ++n) { const bf16x8 afr = *(const LAS bf16x8*)(ab + (16 * n) * GM_PITCH + kk * 64);
                    acc[n] = __builtin_amdgcn_mfma_f32_16x16x32_bf16(afr, bfr[kk], acc[n], 0, 0, 0); } } }
#pragma unroll
            for (int n = 0; n < 8; ++n) { const int col = 128 * g + 16 * n + 4 * fq; const u32x2 uu = uu8[n];
                const float y0 = __uint_as_float(uu.x << 16) * (acc[n][0] + bias), y1 = __uint_as_float(uu.x & 0xffff0000u) * (acc[n][1] + bias);
                const float y2 = __uint_as_float(uu.y << 16) * (acc[n][2] + bias), y3 = __uint_as_float(uu.y & 0xffff0000u) * (acc[n][3] + bias);
                u32x2 w; w.x = cvt_pk_bf16(y0, y1); w.y = cvt_pk_bf16(y2, y3);
                *(u32x2*)(YAB + (size_t)row * DM + col) = w; }
        }
        __syncthreads();
    }
#undef GM_LOAD
}

constexpr int KPITCH = 208, VPITCH = 136, KBUF = 64 * KPITCH, VBUF = 64 * VPITCH, ATT_V0 = 2 * KBUF;
template <bool QK, bool SM>
__device__ __forceinline__ void attn_step(const LAS unsigned char* kb, const LAS unsigned char* vbp, const bf16x8 (&qr)[6],
                                          f32x16& s0, f32x16& s1, f32x16& o0, f32x16& o1, float& mrow, float& lsum) {
    f32x16 n0 = {}, n1 = {};
    if constexpr (QK) {
#pragma unroll
        for (int s = 0; s < 6; ++s) { const bf16x8 ka = *(const LAS bf16x8*)(kb + s * 32), kc = *(const LAS bf16x8*)(kb + 32 * KPITCH + s * 32);
            n0 = __builtin_amdgcn_mfma_f32_32x32x16_bf16(ka, qr[s], n0, 0, 0, 0); n1 = __builtin_amdgcn_mfma_f32_32x32x16_bf16(kc, qr[s], n1, 0, 0, 0); }
    }
    if constexpr (SM) {
        float mx = max3f(s0[0], s1[0], s0[1]); mx = max3f(mx, s1[1], s0[2]); float my = max3f(s1[2], s0[3], s1[3]);
#pragma unroll
        for (int r = 4; r < 16; r += 4) { mx = max3f(mx, s0[r], s1[r]); my = max3f(my, s0[r + 1], s1[r + 1]); mx = max3f(mx, s0[r + 2], s1[r + 2]); my = max3f(my, s0[r + 3], s1[r + 3]); }
        mx = fmaxf(mx, my);
        { const auto rr = __builtin_amdgcn_permlane32_swap(__float_as_uint(mx), __float_as_uint(mx), false, false); mx = fmaxf(__uint_as_float(rr[0]), __uint_as_float(rr[1])); }
        const float mnew = fmaxf(mrow, mx), alpha = __builtin_amdgcn_exp2f(mrow - mnew); mrow = mnew;
        const f32x2 m2 = (f32x2){mnew, mnew}; f32x2 ps2 = (f32x2){0.f, 0.f};
#pragma unroll
        for (int r = 0; r < 16; r += 2) { f32x2 a = (f32x2){s0[r], s0[r + 1]} - m2, b = (f32x2){s1[r], s1[r + 1]} - m2;
            a.x = __builtin_amdgcn_exp2f(a.x); a.y = __builtin_amdgcn_exp2f(a.y); b.x = __builtin_amdgcn_exp2f(b.x); b.y = __builtin_amdgcn_exp2f(b.y);
            s0[r] = a.x; s0[r + 1] = a.y; s1[r] = b.x; s1[r + 1] = b.y; ps2 += a + b; }
        const float ps = ps2.x + ps2.y;
        lsum = lsum * alpha + ps;
#pragma unroll
        for (int r = 0; r < 16; ++r) { o0[r] *= alpha; o1[r] *= alpha; }
        bf16x8 pb[4];
#pragma unroll
        for (int S = 0; S < 4; ++S) { u32x4 w;
            if (S < 2) { w.x = cvt_pk_bf16(s0[8 * S + 0], s0[8 * S + 1]); w.y = cvt_pk_bf16(s0[8 * S + 2], s0[8 * S + 3]); w.z = cvt_pk_bf16(s0[8 * S + 4], s0[8 * S + 5]); w.w = cvt_pk_bf16(s0[8 * S + 6], s0[8 * S + 7]); }
            else { w.x = cvt_pk_bf16(s1[8 * S - 16], s1[8 * S - 15]); w.y = cvt_pk_bf16(s1[8 * S - 14], s1[8 * S - 13]); w.z = cvt_pk_bf16(s1[8 * S - 12], s1[8 * S - 11]); w.w = cvt_pk_bf16(s1[8 * S - 10], s1[8 * S - 9]); }
            pb[S] = __builtin_bit_cast(bf16x8, w); }
#pragma unroll
        for (int S = 0; S < 4; ++S) {
            const u32x2 a0 = *(const LAS u32x2*)(vbp + S * 32), a1 = *(const LAS u32x2*)(vbp + S * 32 + 16);
            const u32x2 c0 = *(const LAS u32x2*)(vbp + 32 * VPITCH + S * 32), c1 = *(const LAS u32x2*)(vbp + 32 * VPITCH + S * 32 + 16);
            const bf16x8 va = __builtin_bit_cast(bf16x8, (u32x4){a0.x, a0.y, a1.x, a1.y}), vc = __builtin_bit_cast(bf16x8, (u32x4){c0.x, c0.y, c1.x, c1.y});
            o0 = __builtin_amdgcn_mfma_f32_32x32x16_bf16(va, pb[S], o0, 0, 0, 0); o1 = __builtin_amdgcn_mfma_f32_32x32x16_bf16(vc, pb[S], o1, 0, 0, 0); }
    }
    s0 = n0; s1 = n1;
}
__device__ __forceinline__ void attn_unit(LAS unsigned char* lds, const bf16_t* Qrow0, int nqw, int limbase, bool prompt, size_t kv0, int NT, int h,
                                          const bf16_t* KN, const bf16_t* KR, const bf16_t* VVt, bf16_t* Yrow0) {
    const int tid = fresh_tid(), lane = tid & 63, wid = __builtin_amdgcn_readfirstlane(tid >> 6), r32 = lane & 31, hi = lane >> 5;
    const int lim = wid < nqw ? (prompt ? limbase + (wid >> 1) + 1 : NT) : 0;
    const int kr0 = tid / 12, kp0 = tid % 12, kr1 = (tid + 512) / 12, kp1 = (tid + 512) % 12;
    const bf16_t* ksrc0 = kp0 < 8 ? KN + (kv0 + kr0) * 512 + h * 64 + kp0 * 8 : KR + (kv0 + kr0) * 32 + (kp0 - 8) * 8;
    const size_t kstr0 = kp0 < 8 ? 512 * 64 : 32 * 64;
    const bf16_t* ksrc1 = kp1 < 8 ? KN + (kv0 + kr1) * 512 + h * 64 + kp1 * 8 : KR + (kv0 + kr1) * 32 + (kp1 - 8) * 8;
    const size_t kstr1 = kp1 < 8 ? 512 * 64 : 32 * 64;
    const bool k1 = tid < 256;
    const bf16_t* vsrc = VVt + (size_t)(h * 64 + (tid >> 3)) * KVR + kv0 + (tid & 7) * 8;
    const int kd0 = kr0 * KPITCH + kp0 * 16, kd1 = kr1 * KPITCH + kp1 * 16, vd = (tid >> 3) * VPITCH + (tid & 7) * 16;
    u32x4 ak0, ak1, av, bk0, bk1, bv;
    const bf16_t* ksrc1c = k1 ? ksrc1 : ksrc0; const size_t kstr1c = k1 ? kstr1 : kstr0;
    const int ntm = NT - 1;
#define ATT_LDK(K0, K1, t) do { const int t_ = (t) < ntm ? (t) : ntm; K0 = *(const u32x4*)(ksrc0 + (size_t)t_ * kstr0); K1 = *(const u32x4*)(ksrc1c + (size_t)t_ * kstr1c); } while (0)
#define ATT_LDV(V, t) do { const int t_ = (t) < ntm ? (t) : ntm; V = *(const u32x4*)(vsrc + (size_t)t_ * 64); } while (0)
#define ATT_STK(K0, K1, b) do { *(LAS u32x4*)(lds + (b) * KBUF + kd0) = K0; if (k1) *(LAS u32x4*)(lds + (b) * KBUF + kd1) = K1; } while (0)
#define ATT_STV(V, b) do { *(LAS u32x2*)(lds + ATT_V0 + (b) * VBUF + vd) = (u32x2){V.x, V.y}; *(LAS u32x2*)(lds + ATT_V0 + (b) * VBUF + vd + 8) = (u32x2){V.z, V.w}; } while (0)
#define ATT_BAR() asm volatile("s_waitcnt lgkmcnt(0)\n\ts_barrier" ::: "memory")
    ATT_LDK(ak0, ak1, 0); ATT_LDV(av, 0); ATT_LDK(bk0, bk1, 1);
    bf16x8 qr[6];
    if (wid < nqw) {
#pragma unroll
        for (int s = 0; s < 6; ++s) qr[s] = *(const bf16x8*)(Qrow0 + (size_t)(wid * 32 + r32) * 768 + h * 96 + s * 16 + hi * 8);
    } else {
#pragma unroll
        for (int s = 0; s < 6; ++s) qr[s] = (bf16x8){0, 0, 0, 0, 0, 0, 0, 0};
    }
    ATT_STK(ak0, ak1, 0); ATT_STV(av, 0); ATT_STK(bk0, bk1, 1);
    ATT_LDK(ak0, ak1, 2); ATT_LDV(av, 1);
    ATT_BAR();
    float mrow = -1e30f, lsum = 0.f; f32x16 o0 = {}, o1 = {}, s0 = {}, s1 = {};
    if (wid >= 4) __builtin_amdgcn_s_setprio(1);
    const LAS unsigned char* kbase = lds + r32 * KPITCH + hi * 16;
    const LAS unsigned char* vbase = lds + ATT_V0 + r32 * VPITCH + hi * 8;
    if (lim > 0) attn_step<true, false>(kbase, vbase, qr, s0, s1, o0, o1, mrow, lsum);
    ATT_BAR();
#define ATT_ITER(t, XK0, XK1, XV, YK0, YK1, YV) do { const int buf_ = (t) & 1; \
        ATT_LDK(YK0, YK1, (t) + 3); ATT_LDV(YV, (t) + 2); \
        if ((t) + 1 < lim) attn_step<true, true>(kbase + (buf_ ^ 1) * KBUF, vbase + buf_ * VBUF, qr, s0, s1, o0, o1, mrow, lsum); \
        else if ((t) < lim) attn_step<false, true>(kbase + (buf_ ^ 1) * KBUF, vbase + buf_ * VBUF, qr, s0, s1, o0, o1, mrow, lsum); \
        ATT_STK(XK0, XK1, buf_); ATT_STV(XV, buf_ ^ 1); \
        ATT_BAR(); } while (0)
    for (int t = 0; t < NT; t += 2) {
        ATT_ITER(t, ak0, ak1, av, bk0, bk1, bv);
        if (t + 1 < NT) ATT_ITER(t + 1, bk0, bk1, bv, ak0, ak1, av);
    }
    asm volatile("s_waitcnt vmcnt(0)" ::: "memory");
    __builtin_amdgcn_s_setprio(0);
#undef ATT_LDK
#undef ATT_LDV
#undef ATT_STK
#undef ATT_STV
#undef ATT_ITER
    if (wid < nqw) {
        lsum += __shfl_xor(lsum, 32);
        const float inv = 1.f / lsum;
        bf16_t* yp = Yrow0 + (size_t)(wid * 32 + r32) * DM + 512 + h * 64 + 4 * hi;
#pragma unroll
        for (int g = 0; g < 4; ++g) {
            u32x2 w; w.x = cvt_pk_bf16(o0[4 * g] * inv, o0[4 * g + 1] * inv); w.y = cvt_pk_bf16(o0[4 * g + 2] * inv, o0[4 * g + 3] * inv);
            *(u32x2*)(yp + 8 * g) = w;
            u32x2 x; x.x = cvt_pk_bf16(o1[4 * g] * inv, o1[4 * g + 1] * inv); x.y = cvt_pk_bf16(o1[4 * g + 2] * inv, o1[4 * g + 3] * inv);
            *(u32x2*)(yp + 32 + 8 * g) = x; }
    }
}


#define XB_TMO      128
#define XB_XCNT(j)  (256  + 64 * (j))
#define XB_XSUB(j)  (1280 + 64 * (j))
#define XB_XGEN(j)  (2304 + 64 * (j))
#define XB_TOP      3328
#define XB_TOPGEN   3392
#define XCD_BAR_WORDS 3456
#define XB_SPIN_CAP (1u << 18)
__device__ __forceinline__ unsigned xb_ld(unsigned* p)              { return __hip_atomic_load(p, __ATOMIC_RELAXED, __HIP_MEMORY_SCOPE_AGENT); }
__device__ __forceinline__ unsigned xb_add(unsigned* p, unsigned v) { return __hip_atomic_fetch_add(p, v, __ATOMIC_RELAXED, __HIP_MEMORY_SCOPE_AGENT); }
__device__ __forceinline__ unsigned xb_xcc_id() { return (unsigned)__builtin_amdgcn_s_getreg((3 << 11) | 20) & 0xFu; }
#define XB_SPIN(cond, bar) do { unsigned _sp = 0; while (cond) { __builtin_amdgcn_s_sleep(1); \
    if ((++_sp & 255u) == 0u) { if (xb_ld(&(bar)[XB_TMO])) break; if (_sp > XB_SPIN_CAP) { atomicAdd(&(bar)[XB_TMO], 1u); break; } } } } while (0)
struct XcdBarrier { unsigned* bar; unsigned x; volatile LAS unsigned* st; };
__device__ __forceinline__ XcdBarrier xcd_barrier_post(unsigned* bar, volatile LAS unsigned* st) {
    XcdBarrier b; b.bar = bar; b.x = xb_xcc_id(); b.st = st;
    if (threadIdx.x == 0) (void)xb_add(&bar[XB_XCNT(b.x)], 1u);
    return b;
}
__device__ __forceinline__ void xcd_barrier_complete(unsigned* bar, unsigned x, unsigned& nloc, unsigned& nx) {
    const unsigned G = gridDim.x * gridDim.y * gridDim.z;
    unsigned sum, cnt, mine, sp = 0u;
    for (;;) {
        sum = 0u; cnt = 0u; mine = 0u;
#pragma unroll
        for (unsigned j = 0; j < 16; ++j) { const unsigned c = xb_ld(&bar[XB_XCNT(j)]); sum += c; cnt += (c > 0u) ? 1u : 0u; mine = (j == x) ? c : mine; }
        if (sum == G) break;
        __builtin_amdgcn_s_sleep(1);
        if ((++sp & 255u) == 0u) { if (xb_ld(&bar[XB_TMO])) break; if (sp > XB_SPIN_CAP) { atomicAdd(&bar[XB_TMO], 1u); break; } }
    }
    nloc = mine > 0u ? mine : 1u; nx = cnt > 0u ? cnt : 1u;
}
__device__ __forceinline__ void xcd_barrier(const XcdBarrier& b) {
    asm volatile("s_waitcnt vmcnt(0)" ::: "memory");
    __syncthreads();
    if (threadIdx.x == 0) {
        unsigned* bar = b.bar;
        __builtin_amdgcn_s_waitcnt(0);
        unsigned nloc = b.st[0], nx = b.st[1];
        if (nloc == 0u) { xcd_barrier_complete(bar, b.x, nloc, nx); b.st[0] = nloc; b.st[1] = nx; }
        const unsigned old = xb_add(&bar[XB_XSUB(b.x)], 1u);
        const unsigned gen = old / nloc;
        if (old + 1u == (gen + 1u) * nloc) {
            __builtin_amdgcn_fence(__ATOMIC_RELEASE, "agent");
            asm volatile("s_waitcnt vmcnt(0)" ::: "memory");
            const unsigned og = xb_add(&bar[XB_TOP], 1u);
            const unsigned tg = og / nx;
            if (og + 1u == (tg + 1u) * nx) xb_add(&bar[XB_TOPGEN], 1u);
            else XB_SPIN(xb_ld(&bar[XB_TOPGEN]) == tg, bar);
            __builtin_amdgcn_fence(__ATOMIC_ACQUIRE, "agent");
            xb_add(&bar[XB_XGEN(b.x)], 1u);
            asm volatile("s_waitcnt vmcnt(0)" ::: "memory");
        } else {
            XB_SPIN(xb_ld(&bar[XB_XGEN(b.x)]) == gen, bar);
            __builtin_amdgcn_fence(__ATOMIC_ACQUIRE, "agent");
            asm volatile("s_waitcnt vmcnt(0)" ::: "memory");
        }
    }
    __syncthreads();
}

__global__ void __launch_bounds__(512, 2) mega_fwd(Args a) {
    extern __shared__ __attribute__((aligned(16))) unsigned char lds_raw[];
    LAS unsigned char* lds = (LAS unsigned char*)lds_raw;
    cg::grid_group grid = cg::this_grid();
    const int G = gridDim.x, bx = blockIdx.x;
#define FRESH_IDS() const int tid = fresh_tid(), lane = tid & 63, wid = __builtin_amdgcn_readfirstlane(tid >> 6); (void)tid; (void)lane; (void)wid
    unsigned char* ws = a.ws;
    const float *x_p = a.in[0], *x_s = a.in[1], *cache_ckv = a.in[2], *cache_kr = a.in[3], *c_p = a.in[4], *c_s = a.in[5], *w_ada = a.in[6], *b_ada = a.in[7],
                *norm1_g = a.in[8], *w_in = a.in[9], *w_s = a.in[10], *b_s = a.in[11], *q_norm_g = a.in[12], *w_uq = a.in[13], *kv_norm_g = a.in[14], *w_ukv = a.in[15],
                *qn_g = a.in[16], *qr_g = a.in[17], *kn_g = a.in[18], *kr_g = a.in[19], *w_out = a.in[20], *norm2_g = a.in[21], *w_fi = a.in[22], *w_fo = a.in[23];
    float* out = a.out;
    float* PART = (float*)(ws + WS_PART); bf16_t* X1B = (bf16_t*)(ws + WS_X1B);
    float* MOD = (float*)(ws + WS_MOD); float* ROPE = (float*)(ws + WS_ROPE); float* SSQ = (float*)(ws + WS_SSQ);
    bf16_t *Wm = (bf16_t*)(ws + WS_WM), *Wt_in = (bf16_t*)(ws + WS_WIN), *Wt_uq = (bf16_t*)(ws + WS_WUQ), *Wt_ukv = (bf16_t*)(ws + WS_WUKV), *Wt_out = (bf16_t*)(ws + WS_WOUT),
           *Wt_fi = (bf16_t*)(ws + WS_WFI), *Wt_fo = (bf16_t*)(ws + WS_WFO), *Hb = (bf16_t*)(ws + WS_H), *YAB = (bf16_t*)(ws + WS_YAB), *Gb = (bf16_t*)(ws + WS_G),
           *Ub = (bf16_t*)(ws + WS_U), *Vt = (bf16_t*)(ws + WS_VT), *CQ = (bf16_t*)(ws + WS_CQ), *CKV = (bf16_t*)(ws + WS_CKV), *KR = (bf16_t*)(ws + WS_KR),
           *KN = (bf16_t*)(ws + WS_KN), *VVt = (bf16_t*)(ws + WS_VVT), *Qb = (bf16_t*)(ws + WS_Q);

    { const int t0 = threadIdx.x; if (t0 < 2) ((volatile LAS unsigned*)(lds + LDS_X + 8192))[t0] = 0u; }
    __syncthreads();
    const XcdBarrier xbar = xcd_barrier_post((unsigned*)(ws + WS_BAR), (volatile LAS unsigned*)(lds + LDS_X + 8192));
    {
        FRESH_IDS();
        for (int it = bx; it < 96; it += G) {
            LAS float* sl = (LAS float*)lds; LAS float* red = (LAS float*)(lds + 65536);
            for (int e = tid; e < 16384; e += 512) { const int r = e >> 10, k = e & 1023; const float c = r < 8 ? c_p[r * 1024 + k] : c_s[(r - 8) * 1024 + k]; sl[e] = silu_f(c); }
            __syncthreads();
            float acc[16];
#pragma unroll
            for (int r = 0; r < 16; ++r) acc[r] = 0.f;
            const float* wp = w_ada + (size_t)(wid * 128) * 6144 + it * 64 + lane;
            for (int k = 0; k < 128; k += 16) {
                float wv[16];
#pragma unroll
                for (int j = 0; j < 16; ++j) wv[j] = __builtin_nontemporal_load(wp + (size_t)(k + j) * 6144);
#pragma unroll
                for (int jj = 0; jj < 4; ++jj)
#pragma unroll
                    for (int r = 0; r < 16; ++r) { const f32x4 s4 = *(const LAS f32x4*)(sl + r * 1024 + wid * 128 + k + 4 * jj);
                        acc[r] += (s4[0] * wv[4 * jj] + s4[1] * wv[4 * jj + 1]) + (s4[2] * wv[4 * jj + 2] + s4[3] * wv[4 * jj + 3]); }
            }
#pragma unroll
            for (int r = 0; r < 16; ++r) red[(wid * 16 + r) * 64 + lane] = acc[r];
            __syncthreads();
            for (int e = tid; e < 1024; e += 512) { const int r = e >> 6, col = e & 63; float s = b_ada[it * 64 + col];
#pragma unroll
                for (int w = 0; w < 8; ++w) s += red[(w * 16 + r) * 64 + col];
                MOD[(size_t)r * 6144 + it * 64 + col] = s; }
            __syncthreads();
        }
        LAS float* scr = (LAS float*)(lds + wid * 16384);
        const int gw = ((bx + G - 96 % G) % G) * 8 + wid, NGW = G * 8;
        constexpr int I_IN = 16 * 56, I_UQ = 6 * 24, I_UKV = 4 * 32, I_OUT = 16 * 32, I_FI = 16 * 176, I_FO = 44 * 32, I_CKV = 4096, I_CKR = 2048, I_ROPE = 1024, I_WM = 1024;
        constexpr int NITEMS = I_IN + I_UQ + I_UKV + I_OUT + I_FI + I_FO + I_CKV + I_CKR + I_ROPE + I_WM;
        for (int it = gw; it < NITEMS; it += NGW) {
            int r = it;
            if (r < I_IN) { const int kb = r / 56, nb = r % 56, n0 = nb * 32;
                const int c0 = n0 < 512 ? n0 : n0 < 768 ? 1408 + (n0 - 512) : n0 < 1152 ? 1024 + (n0 - 768) : n0 < 1184 ? 1664 : n0 < 1280 ? -1 : 512 + (n0 - 1280);
                p0_transpose_item(w_in, 1696, c0, kb * 64, Wt_in, 1024, n0, nullptr, scr, lane); continue; } r -= I_IN;
            if (r < I_UQ) { const int kb = r / 24, nb = r % 24, pn = nb >> 3, bj = (nb >> 2) & 1, wc = nb & 3;
                const int c0 = pn < 2 ? 96 * (4 * pn + wc) + 32 * bj : 96 * (4 * bj + wc) + 64;
                p0_transpose_item(w_uq, 768, c0, kb * 64, Wt_uq, 384, nb * 32, q_norm_g, scr, lane); continue; } r -= I_UQ;
            if (r < I_UKV) { const int kb = r / 32, nb = r % 32; int c0;
                if (nb < 16) { const int pn = nb >> 3, bj = (nb >> 2) & 1, wc = nb & 3; c0 = 128 * (4 * pn + wc) + 32 * bj; }
                else { const int ch0 = (nb - 16) * 32; c0 = 128 * (ch0 >> 6) + 64 + (ch0 & 63); }
                p0_transpose_item(w_ukv, 1024, c0, kb * 64, Wt_ukv, 256, nb * 32, nullptr, scr, lane); continue; } r -= I_UKV;
            if (r < I_OUT) { const int kb = r / 32, nb = r % 32; p0_transpose_item(w_out, 1024, nb * 32, kb * 64, Wt_out, 1024, nb * 32, nullptr, scr, lane); continue; } r -= I_OUT;
            if (r < I_FI) { const int kb = r / 176, nb = r % 176, n0 = nb * 32, pn = n0 >> 8, bj = (n0 >> 7) & 1, rr = n0 & 127;
                p0_transpose_item(w_fi, 5632, bj * 2816 + 128 * pn + rr, kb * 64, Wt_fi, 1024, n0, nullptr, scr, lane); continue; } r -= I_FI;
            if (r < I_FO) { const int kb = r / 32, nb = r % 32; p0_transpose_item(w_fo, 1024, nb * 32, kb * 64, Wt_fo, 2816, nb * 32, nullptr, scr, lane); continue; } r -= I_FO;
            if (r < I_CKV) { const int row0 = r * 4, b = row0 >> 11, p = row0 & 2047; f32x4 v[4];
#pragma unroll
                for (int q = 0; q < 4; ++q) v[q] = __builtin_nontemporal_load((const f32x4*)(cache_ckv + (size_t)(row0 + q) * 256) + lane);
#pragma unroll
                for (int q = 0; q < 4; ++q) { u32x2 w; w.x = cvt_pk_bf16(v[q][0], v[q][1]); w.y = cvt_pk_bf16(v[q][2], v[q][3]);
                    *((u32x2*)(CKV + ((size_t)MP + b * 2112 + p + q) * 256) + lane) = w; }
                continue; } r -= I_CKV;
            if (r < I_CKR) { const int row = r * 8 + (lane >> 3), b = row >> 11, p = row & 2047; const f32x4 v = *((const f32x4*)(cache_kr + (size_t)row * 32) + (lane & 7));
                u32x2 w; w.x = cvt_pk_bf16(v[0], v[1]); w.y = cvt_pk_bf16(v[2], v[3]);
                *((u32x2*)(KR + ((size_t)MP + b * 2112 + p) * 32) + (lane & 7)) = w; continue; } r -= I_CKR;
            if (r < I_ROPE) { const int e = r * 64 + lane, pos = e >> 4, j = e & 15;
                const double inv = exp(-(double)j * (1.0 / 16.0) * 9.210340371976184);
                const double rev = (double)pos * inv * 0.15915494309189535; const float fr = (float)(rev - floor(rev));
                ROPE[(size_t)pos * 32 + j] = __builtin_amdgcn_cosf(fr); ROPE[(size_t)pos * 32 + 16 + j] = __builtin_amdgcn_sinf(fr); continue; } r -= I_ROPE;
            { const int e = r * 64 + lane, i = (e >> 7) & 127, j = e & 127; const float v = (j >> 6) <= (i >> 6) ? w_s[e] : 0.f; Wm[e] = (bf16_t)(cvt_pk_bf16(v, 0.f) & 0xffffu); }
        }
    }
    xcd_barrier(xbar);
    if (G == 0x7fffffff) grid.sync();

    { FRESH_IDS();
        int row = bx * 8 + wid; f32x4 nv[4];
        if (row < MT) norm_load(row < MP ? x_p + (size_t)row * DM : x_s + (size_t)(row - MP) * DM, nv, lane);
        for (; row < MT; row += G * 8) {
            f32x4 v[4];
#pragma unroll
            for (int j = 0; j < 4; ++j) v[j] = nv[j];
            const int nr = row + G * 8;
            if (nr < MT) norm_load(nr < MP ? x_p + (size_t)nr * DM : x_s + (size_t)(nr - MP) * DM, nv, lane);
            const int b16 = row < MP ? (row >> 12) : 8 + ((row - MP) >> 6);
            norm_apply(v, norm1_g, MOD + (size_t)b16 * 6144 + 1024, MOD + (size_t)b16 * 6144, Hb + (size_t)row * DM, lane);
        } }
    xcd_barrier(xbar);

    {
        ProgIn P; P.K = 1024; P.lda = 1024; P.ldb = 1024; P.G = G; P.c = bx; P.H = Hb; P.Wt = Wt_in; P.U = Ub; P.Vt = Vt; P.CQ = CQ; P.CKV = CKV; P.KR = KR; P.SSQ = SSQ; P.out = out;
        P.rope = ROPE; P.kvg = kv_norm_g; P.krg = kr_g; P.xl = (LAS float*)(lds + LDS_X);
        pg8::gemm_phase(lds, P);
    }
    xcd_barrier(xbar);

    {
        ProgQ P; P.K = 384; P.lda = 384; P.ldb = 384; P.G = G; P.c = bx; P.CQ = CQ; P.Wt = Wt_uq; P.SSQ = SSQ; P.Q = Qb; P.rope = ROPE; P.qng = qn_g; P.qrg = qr_g;
        pg8::gemm_phase(lds, P);
    }
    {
        ProgKV P; P.K = 256; P.lda = 256; P.ldb = 256; P.G = G; P.c = (G == 256) ? ((bx + 140) & 255) : bx;
        P.CKV = CKV; P.Wt = Wt_ukv; P.KN = KN; P.VVt = VVt; P.kng = kn_g;
        pg8::gemm_phase(lds, P);
    }
    gmlp_phase(lds, (G == 256) ? ((bx + 96) & 255) : bx, G, Wm, Vt, Ub, b_s, YAB);
    xcd_barrier(xbar);

    {
        const int vcu = (G % 8 == 0) ? (bx % 8) * (G / 8) + bx / 8 : bx;
        if (G == 256) {
            const int xcd = bx & 7; unsigned* ctr = (unsigned*)(ws + WS_CTR) + xcd * 64;
            volatile LAS int* qw = (volatile LAS int*)(lds + LDS_X + 8192 + 64);
            for (;;) {
                if (threadIdx.x == 0) qw[0] = (int)atomicAdd(ctr, 1u);
                __syncthreads();
                const int j = qw[0];
                __syncthreads();
                if (j >= 136) break;
                if (j < 96 || j >= 104) { const int jj = j < 96 ? j : j - 104, qb = j < 96 ? 15 - (jj >> 3) : 3 - (jj >> 3), bh = xcd * 8 + (jj & 7), b = bh >> 3, h = bh & 7;
                    const size_t r0 = (size_t)b * 4096 + qb * 256;
                    attn_unit(lds, Qb + r0 * 768, 8, 4 * qb, true, (size_t)b * 4096, 4 * qb + 4, h, KN, KR, VVt, YAB + r0 * DM);
                } else { const int bh = xcd * 8 + (j - 96), b2 = bh >> 3, h2 = bh & 7; const size_t r0 = (size_t)MP + b2 * 64;
                    attn_unit(lds, Qb + r0 * 768, 2, 0, false, (size_t)MP + b2 * 2112, 33, h2, KN, KR, VVt, YAB + r0 * DM); }
            }
        } else {
            for (int it = vcu; it < 1024 + 64; it += G) {
                if (it < 1024) { const int bh = it >> 4, qb = it & 15, b = bh >> 3, h = bh & 7;
                    const size_t r0 = (size_t)b * 4096 + qb * 256;
                    attn_unit(lds, Qb + r0 * 768, 8, 4 * qb, true, (size_t)b * 4096, 4 * qb + 4, h, KN, KR, VVt, YAB + r0 * DM);
                } else { const int bh = it - 1024, b = bh >> 3, h = bh & 7; const size_t r0 = (size_t)MP + b * 64;
                    attn_unit(lds, Qb + r0 * 768, 2, 0, false, (size_t)MP + b * 2112, 33, h, KN, KR, VVt, YAB + r0 * DM); }
            }
        }
    }
    xcd_barrier(xbar);

    {
        ProgRes<0> P; P.K = 1024; P.lda = 1024; P.ldb = 1024; P.G = G; P.c = bx; P.Ab = YAB; P.Wt = Wt_out; P.xp = x_p; P.Y = out; P.X1 = X1B; P.gate = MOD + 2048; P.part = PART; P.nsk = 4;
        pg8::gemm_phase(lds, P);
    }
    xcd_barrier(xbar);

    { FRESH_IDS();
        int row = bx * 8 + wid; f32x4 nv[4];
        if (row < MP) row_load_bf16(X1B + (size_t)row * DM, nv, lane);
        for (; row < MP; row += G * 8) {
            f32x4 v[4];
#pragma unroll
            for (int j = 0; j < 4; ++j) v[j] = nv[j];
            const int nr = row + G * 8;
            if (nr < MP) row_load_bf16(X1B + (size_t)nr * DM, nv, lane);
            const int b16 = row >> 12;
            norm_apply(v, norm2_g, MOD + (size_t)b16 * 6144 + 4096, MOD + (size_t)b16 * 6144 + 3072, Hb + (size_t)row * DM, lane);
        }
        for (int sr = ((bx + 128) % G) * 8 + wid; sr < MS; sr += G * 8) { const int b16 = 8 + (sr >> 6); f32x4 v[4];
            norm_load(x_s + (size_t)sr * DM, v, lane);
            sample_combine(MOD + (size_t)b16 * 6144 + 2048, PART, 4, sr, v, lane);
            row_store_bf16(X1B + (size_t)(MP + sr) * DM, v, lane);
            row_load_bf16(X1B + (size_t)(MP + sr) * DM, v, lane);
            norm_apply(v, norm2_g, MOD + (size_t)b16 * 6144 + 4096, MOD + (size_t)b16 * 6144 + 3072, Hb + (size_t)(MP + sr) * DM, lane);
        } }
    xcd_barrier(xbar);

    {
        ProgFfn P; P.K = 1024; P.lda = 1024; P.ldb = 1024; P.G = G; P.c = bx; P.Ab = Hb; P.Wt = Wt_fi; P.Gb = Gb;
        pg8::gemm_phase(lds, P);
    }
    xcd_barrier(xbar);

    {
        ProgRes<1> P; P.K = DFF; P.lda = DFF; P.ldb = DFF; P.G = G; P.c = bx; P.Ab = Gb; P.Wt = Wt_fo; P.xp = nullptr; P.Y = out; P.X1 = X1B; P.gate = MOD + 5120; P.part = PART; P.nsk = 11;
        pg8::gemm_phase(lds, P);
    }
    xcd_barrier(xbar);

    { FRESH_IDS();
        for (int sr = bx * 8 + wid; sr < MS; sr += G * 8) { const int b16 = 8 + (sr >> 6); f32x4 v[4];
            row_load_bf16(X1B + (size_t)(MP + sr) * DM, v, lane);
            sample_combine(MOD + (size_t)b16 * 6144 + 5120, PART, 11, sr, v, lane);
#pragma unroll
            for (int j = 0; j < 4; ++j) *((f32x4*)(out + (size_t)(MP + sr) * DM) + lane + 64 * j) = v[j]; } }
}

extern "C" void kernel_launch(void* const* d_in, const int* in_sizes, int n_in, void* d_out, int out_size, void* d_ws, size_t ws_size, hipStream_t stream) {
    static int grid = 0;
    if (grid == 0) {
        if (n_in != 24 || ws_size < WS_END) { fprintf(stderr, "kernel_launch: unexpected n_in %d / ws_size %zu (need %zu)\n", n_in, ws_size, (size_t)WS_END); grid = -1; return; }
        int dev = 0, cus = 0, per_cu = 0;
        hipGetDevice(&dev); hipDeviceGetAttribute(&cus, hipDeviceAttributeMultiprocessorCount, dev);
        if (hipFuncSetAttribute((const void*)mega_fwd, hipFuncAttributeMaxDynamicSharedMemorySize, LDS_BYTES) != hipSuccess) { fprintf(stderr, "kernel_launch: hipFuncSetAttribute failed\n"); grid = -1; return; }
        if (hipOccupancyMaxActiveBlocksPerMultiprocessor(&per_cu, (const void*)mega_fwd, 512, LDS_BYTES) != hipSuccess || per_cu < 1) { fprintf(stderr, "kernel_launch: occupancy query gave %d\n", per_cu); per_cu = 1; }
        (void)hipGetLastError();
        grid = cus;
        fprintf(stderr, "kernel_launch: grid %d (cus %d, per_cu %d)\n", grid, cus, per_cu);
    }
    if (grid < 0) return;
    if (hipMemsetAsync((char*)d_ws + WS_BAR, 0, 32768, stream) != hipSuccess) { fprintf(stderr, "kernel_launch: memset of control words failed\n"); return; }
    Args a{};
    for (int i = 0; i < 24; ++i) a.in[i] = (const float*)d_in[i];
    a.out = (float*)d_out; a.ws = (unsigned char*)d_ws;
    void* args[] = {&a};
    hipError_t e = hipLaunchCooperativeKernel((const void*)mega_fwd, dim3(grid), dim3(512), args, LDS_BYTES, stream);
    if (e != hipSuccess) fprintf(stderr, "kernel_launch: cooperative launch failed: %s (grid %d)\n", hipGetErrorString(e), grid);
}
```

```cpp
#include <hip/hip_runtime.h>
#include <hip/hip_cooperative_groups.h>
#include <cstdio>
#include <cstdint>
namespace cg = cooperative_groups;

#define LAS __attribute__((address_space(3)))
typedef unsigned short bf16_t;
typedef short bf16x8 __attribute__((ext_vector_type(8)));
typedef short s16x4 __attribute__((ext_vector_type(4)));
typedef float f32x4 __attribute__((ext_vector_type(4)));
typedef float f32x16 __attribute__((ext_vector_type(16)));
typedef unsigned u32x4 __attribute__((ext_vector_type(4)));
typedef unsigned u32x2 __attribute__((ext_vector_type(2)));

constexpr int MP = 32768, MS = 512, MT = MP + MS;
constexpr int DM = 1024, DFF = 2816;
constexpr int KVR = MP + 8 * 2112;
constexpr float EPS = 1e-6f;
constexpr float QSCALE = 0.10206207261596577f * 1.4426950408889634f;
constexpr size_t OFF_CKVP = 34078720, OFF_KRP = 42467328, OFF_CKVS = 43515904, OFF_KRS = 43646976, OFF_VS = 43663360;

constexpr size_t MiB = 1u << 20;
constexpr size_t WS_MOD = 0, WS_ROPE = 512 * 1024, WS_SSQ = 1 * MiB, WS_WM = 3 * MiB, WS_WIN = 4 * MiB, WS_WUQ = 8 * MiB, WS_WUKV = 9 * MiB,
                 WS_WOUT = 10 * MiB, WS_WFI = 12 * MiB, WS_WFO = 23 * MiB, WS_H = 29 * MiB, WS_YAB = 94 * MiB, WS_G = 159 * MiB,
                 WS_U = 159 * MiB, WS_VT = 192 * MiB, WS_CQ = 225 * MiB, WS_CKV = 250 * MiB, WS_KR = 275 * MiB, WS_KN = 279 * MiB,
                 WS_VVT = 328 * MiB, WS_Q = 377 * MiB, WS_END = 450 * MiB, WS_CTR = 3 * MiB - 4096, WS_BAR = 3 * MiB - 32768, WS_PART = 426 * MiB, WS_X1B = 345 * MiB;

constexpr int LDS_BYTES = 147456;
constexpr int LDS_X = 131072;

__device__ __forceinline__ unsigned cvt_pk_bf16(float lo, float hi) { unsigned r; asm("v_cvt_pk_bf16_f32 %0, %1, %2" : "=v"(r) : "v"(lo), "v"(hi)); return r; }
__device__ __forceinline__ float bf2f(unsigned short h) { return __uint_as_float(((unsigned)h) << 16); }
__device__ __forceinline__ float gelu_tanh(float x) {
    const float y2 = 1.5957691216057308f * x * (1.f + 0.044715f * x * x);
    const float e = __builtin_amdgcn_exp2f(-y2 * 1.4426950408889634f);
    return x * __builtin_amdgcn_rcpf(1.f + e);
}
__device__ __forceinline__ float silu_f(float x) { const float e = __builtin_amdgcn_exp2f(-x * 1.4426950408889634f); return x * __builtin_amdgcn_rcpf(1.f + e); }
__device__ __forceinline__ float wave_sum(float v) {
#pragma unroll
    for (int o = 1; o < 64; o <<= 1) v += __shfl_xor(v, o);
    return v;
}
typedef float f32x2 __attribute__((ext_vector_type(2)));
__device__ __forceinline__ float max3f(float a, float b, float c) { float r; asm("v_max3_f32 %0, %1, %2, %3" : "=v"(r) : "v"(a), "v"(b), "v"(c)); return r; }
#define LDS_WAIT() asm volatile("s_waitcnt lgkmcnt(0)" ::: "memory")
__device__ __forceinline__ int fresh_tid() { int t = threadIdx.x; asm volatile("" : "+v"(t)); return t; }

namespace pg8 {
constexpr int BM = 256, BK = 64, HALF = 128, HTB = HALF * BK * 2, STAGE_BYTES = 8 * HTB, NXCD = 8, WGM = 8;
__host__ __device__ __forceinline__ int lds_byte(int r, int c) { const int st = (r >> 4) * 2 + (c >> 5), rr = r & 15, cc = c & 31, ob = rr * 64 + cc * 2; return st * 1024 + (ob ^ (((ob >> 9) & 1) << 5)); }
__host__ __device__ __forceinline__ void stage_rc(int b, int& R, int& C) { const int st = b / 1024, sb = b % 1024, swz = sb ^ (((sb >> 9) & 1) << 5); R = (st >> 1) * 16 + swz / 64; C = (st & 1) * 32 + (swz % 64) / 2; }
__host__ __device__ __forceinline__ int perm32(int rho) { const int n = rho >> 4, i = rho & 15; return 8 * (i >> 2) + 4 * n + (i & 3); }

struct Unit { int pm, pn, kind; };
__device__ __forceinline__ int xcd_map(int L, int nwg) { const int q = nwg / NXCD, r = nwg % NXCD, xcd = L % NXCD, off = L / NXCD; return (xcd < r ? xcd * (q + 1) : r * (q + 1) + (xcd - r) * q) + off; }
__device__ __forceinline__ void grouped(int wgid, int nM, int nN, int& pm, int& pn) {
    const int nig = WGM * nN, gid = wgid / nig, fm = gid * WGM, gsz = (nM - fm) < WGM ? (nM - fm) : WGM;
    pm = fm + ((wgid % nig) % gsz); pn = (wgid % nig) / gsz;
}
template <class Prog>
__device__ __forceinline__ void gemm_phase(LAS unsigned char* lds, const Prog& P) {
    const int tid = fresh_tid(), wid = __builtin_amdgcn_readfirstlane(tid >> 6), lane = tid & 63, wr = wid >> 2, wc = wid & 3, fr = lane & 15, fq = lane >> 4;
    const int lda = P.lda, ldb = P.ldb;
    unsigned voffA[2], voffB[2];
#pragma unroll
    for (int i = 0; i < 2; ++i) { int R, C; stage_rc(tid * 16 + i * 8192, R, C); const int Rb = (R & ~31) + perm32(R & 31);
        voffA[i] = (unsigned)(R * lda + C) * 2u; voffB[i] = (unsigned)(Rb * ldb + C) * 2u; }
    const size_t kstep = (size_t)(BK * 2);
    const size_t hstepA = (size_t)HALF * lda * 2, hstepB = (size_t)HALF * ldb * 2;
    const unsigned ldsw = (unsigned)wid * 1024u;
    const int aoff = lds_byte(wr * 64 + fr, fq * 8), boff = lds_byte(wc * 32 + fr, fq * 8);
#define PG8_SA(b, h) (((b) * 2 + (h)) * HTB)
#define PG8_SB(b, h) ((4 + (b) * 2 + (h)) * HTB)
#define PG8_STAGE(bufoff, gbase, voff) do { _Pragma("unroll") for (int _i = 0; _i < 2; ++_i) \
        __builtin_amdgcn_global_load_lds((const unsigned*)((const char*)(gbase) + (voff)[_i]), (LAS unsigned*)(lds + (bufoff) + ldsw + _i * 8192), 16, 0, 0); } while (0)
#define PG8_LDA(dst, b, h) do { _Pragma("unroll") for (int m = 0; m < 4; ++m) _Pragma("unroll") for (int k = 0; k < 2; ++k) dst[m][k] = *(const LAS bf16x8*)(lds + PG8_SA(b, h) + aoff + m * 2048 + k * 1024); } while (0)
#define PG8_LDB(dst, b, h) do { _Pragma("unroll") for (int n = 0; n < 2; ++n) _Pragma("unroll") for (int k = 0; k < 2; ++k) dst[n][k] = *(const LAS bf16x8*)(lds + PG8_SB(b, h) + boff + n * 2048 + k * 1024); } while (0)
#define PG8_MMA(ai, bj, At, Bt) do { __builtin_amdgcn_s_setprio(1); _Pragma("unroll") for (int m = 0; m < 4; ++m) _Pragma("unroll") for (int n = 0; n < 2; ++n) _Pragma("unroll") for (int k = 0; k < 2; ++k) \
        acc[ai][bj][m][n] = __builtin_amdgcn_mfma_f32_16x16x32_bf16(Bt[n][k], At[m][k], acc[ai][bj][m][n], 0, 0, 0); __builtin_amdgcn_s_setprio(0); } while (0)
#define PG8_WAIT_V(n) asm volatile("s_waitcnt vmcnt(" #n ")" ::: "memory")
#define PG8_WAIT_L(n) asm volatile("s_waitcnt lgkmcnt(" #n ")" ::: "memory")
#define PG8_BAR __builtin_amdgcn_s_barrier()
#define PG8_SCHED __builtin_amdgcn_sched_barrier(0)
    Unit cur, nxt; int ui = 0;
    if (!P.next(0, cur)) return;
    f32x4 acc[2][2][4][2];
#pragma unroll
    for (int a = 0; a < 2; ++a)
#pragma unroll
        for (int b = 0; b < 2; ++b)
#pragma unroll
            for (int m = 0; m < 4; ++m)
#pragma unroll
                for (int n = 0; n < 2; ++n) acc[a][b][m][n] = (f32x4){0.f, 0.f, 0.f, 0.f};
    bf16x8 At[4][2], B0[2][2], B1[2][2];
    const char* cA = P.aptr(cur); const char* cB = P.bptr(cur);
    PG8_STAGE(PG8_SB(0, 0), cB, voffB); PG8_STAGE(PG8_SB(0, 1), cB + hstepB, voffB); PG8_STAGE(PG8_SA(0, 0), cA, voffA); PG8_STAGE(PG8_SA(0, 1), cA + hstepA, voffA);
    if (wr == 1) PG8_BAR;
    PG8_WAIT_V(2); PG8_BAR;
    PG8_STAGE(PG8_SB(1, 0), cB + kstep, voffB); PG8_STAGE(PG8_SA(1, 0), cA + kstep, voffA); PG8_STAGE(PG8_SB(1, 1), cB + hstepB + kstep, voffB);
    PG8_WAIT_V(6); PG8_BAR;
    for (;;) {
        const bool has_next = P.next(ui + 1, nxt);
        const int nt = P.nt(cur);
        const char* nA = has_next ? P.aptr(nxt) : cA; const char* nB = has_next ? P.bptr(nxt) : cB;
        for (int t = 0; t < nt; t += 2) {
            const bool last = (t == nt - 2);
            const char* a1 = cA + (size_t)(t + 1) * kstep;
            const char* a2 = last ? nA : cA + (size_t)(t + 2) * kstep; const char* b2 = last ? nB : cB + (size_t)(t + 2) * kstep;
            const char* a3 = a2 + kstep; const char* b3 = b2 + kstep;
            PG8_LDB(B0, 0, 0); PG8_LDB(B1, 0, 1); PG8_SCHED; PG8_LDA(At, 0, 0); PG8_STAGE(PG8_SA(1, 1), a1 + hstepA, voffA);
            PG8_WAIT_V(8); PG8_WAIT_L(0); PG8_BAR; PG8_MMA(0, 0, At, B0); PG8_MMA(0, 1, At, B1); PG8_BAR; PG8_SCHED;
            PG8_LDA(At, 0, 1); PG8_STAGE(PG8_SB(0, 0), b2, voffB); PG8_STAGE(PG8_SB(0, 1), b2 + hstepB, voffB); PG8_STAGE(PG8_SA(0, 0), a2, voffA);
            PG8_WAIT_V(8); PG8_WAIT_L(0); PG8_BAR; PG8_MMA(1, 0, At, B0); PG8_MMA(1, 1, At, B1); PG8_BAR; PG8_SCHED;
            PG8_LDB(B0, 1, 0); PG8_LDB(B1, 1, 1); PG8_SCHED; PG8_LDA(At, 1, 0); PG8_STAGE(PG8_SA(0, 1), a2 + hstepA, voffA);
            PG8_WAIT_V(8); PG8_WAIT_L(0); PG8_BAR; PG8_MMA(0, 0, At, B0); PG8_MMA(0, 1, At, B1); PG8_BAR; PG8_SCHED;
            PG8_LDA(At, 1, 1); PG8_STAGE(PG8_SB(1, 0), b3, voffB); PG8_STAGE(PG8_SB(1, 1), b3 + hstepB, voffB); PG8_STAGE(PG8_SA(1, 0), a3, voffA);
            PG8_WAIT_V(8); PG8_WAIT_L(0); PG8_BAR; PG8_MMA(1, 0, At, B0); PG8_MMA(1, 1, At, B1); PG8_BAR; PG8_SCHED;
        }
        if (wr == 0) PG8_BAR;
        P.epi(acc, cur, wr, wc, fr, fq);
        if (!has_next) break;
#pragma unroll
        for (int a = 0; a < 2; ++a)
#pragma unroll
            for (int b = 0; b < 2; ++b)
#pragma unroll
                for (int m = 0; m < 4; ++m)
#pragma unroll
                    for (int n = 0; n < 2; ++n) acc[a][b][m][n] = (f32x4){0.f, 0.f, 0.f, 0.f};
        cur = nxt; cA = nA; cB = nB; ++ui;
        if (wr == 1) PG8_BAR;
    }
    PG8_WAIT_V(0);
    PG8_BAR;
#undef PG8_SA
#undef PG8_SB
#undef PG8_STAGE
#undef PG8_LDA
#undef PG8_LDB
#undef PG8_MMA
#undef PG8_WAIT_V
#undef PG8_WAIT_L
#undef PG8_SCHED
}
}
using pg8::Unit;
typedef f32x4 Acc[2][2][4][2];

struct Args {
    const float* in[24];
    float* out;
    unsigned char* ws;
};

struct ProgIn {
    int K, lda, ldb, G, c;
    const bf16_t* H; const bf16_t* Wt;
    bf16_t *U, *Vt, *CQ, *CKV, *KR; float* SSQ; float* out; const float* rope; const float *kvg, *krg;
    LAS float* xl;
    static constexpr int NM = 130, NMAIN = 130 * 5, NSW = 2 * 130, NTOT = NMAIN + NSW;
    __device__ __forceinline__ bool next(int i, Unit& u) const {
        const int L = i * G + c; if (L >= NTOT) return false;
        const int w = pg8::xcd_map(L, NTOT);
        if (w < NMAIN) { pg8::grouped(w, NM, 5, u.pm, u.pn); u.kind = u.pn < 2 ? 0 : (u.pn == 2 ? 1 : 2); }
        else { pg8::grouped(w - NMAIN, 2, NM, u.pm, u.pn); u.kind = 3; }
        return true;
    }
    __device__ __forceinline__ int nt(const Unit&) const { return K / 64; }
    __device__ __forceinline__ const char* aptr(const Unit& u) const { return u.kind < 3 ? (const char*)(H + (size_t)u.pm * 256 * DM) : (const char*)(Wt + (size_t)(1280 + u.pm * 256) * DM); }
    __device__ __forceinline__ const char* bptr(const Unit& u) const { return u.kind < 3 ? (const char*)(Wt + (size_t)u.pn * 256 * DM) : (const char*)(H + (size_t)u.pn * 256 * DM); }
    __device__ __forceinline__ void epi(Acc& acc, const Unit& u, int wr, int wc, int fr, int fq) const {
        asm volatile("" : "+v"(fr), "+v"(fq));
        const int rl0 = wr * 64 + fr;
        if (u.kind == 0) {
#pragma unroll
            for (int ai = 0; ai < 2; ++ai)
#pragma unroll
                for (int m = 0; m < 4; ++m) { const size_t row = (size_t)u.pm * 256 + ai * 128 + rl0 + m * 16;
#pragma unroll
                    for (int bj = 0; bj < 2; ++bj) { const f32x4 v0 = acc[ai][bj][m][0], v1 = acc[ai][bj][m][1]; u32x4 w;
                        w.x = cvt_pk_bf16(gelu_tanh(v0[0]), gelu_tanh(v0[1])); w.y = cvt_pk_bf16(gelu_tanh(v0[2]), gelu_tanh(v0[3]));
                        w.z = cvt_pk_bf16(gelu_tanh(v1[0]), gelu_tanh(v1[1])); w.w = cvt_pk_bf16(gelu_tanh(v1[2]), gelu_tanh(v1[3]));
                        *(u32x4*)(U + row * 512 + u.pn * 256 + bj * 128 + wc * 32 + fq * 8) = w; } }
        } else if (u.kind == 3) {
            const bool samp = u.pn >= 128;
#pragma unroll
            for (int ai = 0; ai < 2; ++ai)
#pragma unroll
                for (int m = 0; m < 4; ++m) { const int ch = u.pm * 256 + ai * 128 + rl0 + m * 16;
#pragma unroll
                    for (int bj = 0; bj < 2; ++bj) { const f32x4 v0 = acc[ai][bj][m][0], v1 = acc[ai][bj][m][1];
                        float g[8] = {gelu_tanh(v0[0]), gelu_tanh(v0[1]), gelu_tanh(v0[2]), gelu_tanh(v0[3]), gelu_tanh(v1[0]), gelu_tanh(v1[1]), gelu_tanh(v1[2]), gelu_tanh(v1[3])};
                        u32x4 w; w.x = cvt_pk_bf16(g[0], g[1]); w.y = cvt_pk_bf16(g[2], g[3]); w.z = cvt_pk_bf16(g[4], g[5]); w.w = cvt_pk_bf16(g[6], g[7]);
                        const int tok = u.pn * 256 + bj * 128 + wc * 32 + fq * 8;
                        *(u32x4*)(Vt + (size_t)ch * MT + tok) = w;
                        if (samp) {
#pragma unroll
                            for (int e = 0; e < 8; ++e) out[OFF_VS + (size_t)(tok - MP + e) * 512 + ch] = g[e]; } } }
        } else if (u.kind == 1) {
#pragma unroll
            for (int ai = 0; ai < 2; ++ai)
#pragma unroll
                for (int m = 0; m < 4; ++m) { float s = 0.f;
#pragma unroll
                    for (int bj = 0; bj < 2; ++bj)
#pragma unroll
                        for (int n = 0; n < 2; ++n) { const f32x4 x = acc[ai][bj][m][n]; s += (x[0] * x[0] + x[1] * x[1]) + (x[2] * x[2] + x[3] * x[3]); }
                    s += __shfl_xor(s, 16); s += __shfl_xor(s, 32);
                    if (fq == 0) xl[(ai * 128 + rl0 + m * 16) * 4 + wc] = s; }
            LDS_WAIT(); __builtin_amdgcn_s_barrier(); asm volatile("" ::: "memory");
            f32x4 gv[2][2];
#pragma unroll
            for (int bj = 0; bj < 2; ++bj)
#pragma unroll
                for (int n = 0; n < 2; ++n) gv[bj][n] = *(const f32x4*)(kvg + bj * 128 + wc * 32 + fq * 8 + n * 4);
#pragma unroll
            for (int ai = 0; ai < 2; ++ai)
#pragma unroll
                for (int m = 0; m < 4; ++m) { const int rl = ai * 128 + rl0 + m * 16; const f32x4 p = *(const LAS f32x4*)(xl + rl * 4);
                    const float rstd = rsqrtf(((p[0] + p[1]) + (p[2] + p[3])) * (1.f / 256.f) + EPS);
                    const int row = u.pm * 256 + rl; size_t kvrow; float* o;
                    if (row < MP) { kvrow = row; o = out + OFF_CKVP + (size_t)row * 256; }
                    else { const int s = row - MP, b = s >> 6, t = s & 63; kvrow = (size_t)MP + b * 2112 + 2048 + t; o = out + OFF_CKVS + (size_t)s * 256; }
#pragma unroll
                    for (int bj = 0; bj < 2; ++bj) { const f32x4 v0 = acc[ai][bj][m][0] * rstd * gv[bj][0], v1 = acc[ai][bj][m][1] * rstd * gv[bj][1];
                        const int col = bj * 128 + wc * 32 + fq * 8;
                        __builtin_nontemporal_store(v0, (f32x4*)(o + col)); __builtin_nontemporal_store(v1, (f32x4*)(o + col + 4));
                        u32x4 w; w.x = cvt_pk_bf16(v0[0], v0[1]); w.y = cvt_pk_bf16(v0[2], v0[3]); w.z = cvt_pk_bf16(v1[0], v1[1]); w.w = cvt_pk_bf16(v1[2], v1[3]);
                        *(u32x4*)(CKV + kvrow * 256 + col) = w; } }
            LDS_WAIT(); __builtin_amdgcn_s_barrier(); asm volatile("" ::: "memory");
        } else {
            const int t2 = u.pn - 3;
#pragma unroll
            for (int ai = 0; ai < 2; ++ai)
#pragma unroll
                for (int m = 0; m < 4; ++m) { const int row = u.pm * 256 + ai * 128 + rl0 + m * 16; float s = 0.f;
#pragma unroll
                    for (int bj = 0; bj < 2; ++bj) { if (t2 == 1 && bj == 1) continue;
                        const f32x4 v0 = acc[ai][bj][m][0], v1 = acc[ai][bj][m][1];
                        s += (v0[0] * v0[0] + v0[1] * v0[1]) + (v0[2] * v0[2] + v0[3] * v0[3]) + (v1[0] * v1[0] + v1[1] * v1[1]) + (v1[2] * v1[2] + v1[3] * v1[3]);
                        u32x4 w; w.x = cvt_pk_bf16(v0[0], v0[1]); w.y = cvt_pk_bf16(v0[2], v0[3]); w.z = cvt_pk_bf16(v1[0], v1[1]); w.w = cvt_pk_bf16(v1[2], v1[3]);
                        *(u32x4*)(CQ + (size_t)row * 384 + t2 * 256 + bj * 128 + wc * 32 + fq * 8) = w; }
                    s += __shfl_xor(s, 16); s += __shfl_xor(s, 32);
                    if (fq == 0) SSQ[(size_t)row * 8 + t2 * 4 + wc] = s; }
            if (t2 == 1 && wc == 0) {
                const f32x4 g0 = *(const f32x4*)(krg + fq * 8), g1 = *(const f32x4*)(krg + fq * 8 + 4);
#pragma unroll
                for (int ai = 0; ai < 2; ++ai)
#pragma unroll
                    for (int m = 0; m < 4; ++m) { const int row = u.pm * 256 + ai * 128 + rl0 + m * 16;
                        f32x4 v0 = acc[ai][1][m][0], v1 = acc[ai][1][m][1];
                        float s = (v0[0] * v0[0] + v0[1] * v0[1]) + (v0[2] * v0[2] + v0[3] * v0[3]) + (v1[0] * v1[0] + v1[1] * v1[1]) + (v1[2] * v1[2] + v1[3] * v1[3]);
                        s += __shfl_xor(s, 16); s += __shfl_xor(s, 32);
                        const float rstd = rsqrtf(s * (1.f / 32.f) + EPS);
                        v0 = v0 * rstd * g0; v1 = v1 * rstd * g1;
                        int pos; size_t kvrow; float* o;
                        if (row < MP) { pos = row & 4095; kvrow = row; o = out + OFF_KRP + (size_t)row * 32; }
                        else { const int sr = row - MP, b = sr >> 6, t = sr & 63; pos = 2048 + t; kvrow = (size_t)MP + b * 2112 + 2048 + t; o = out + OFF_KRS + (size_t)sr * 32; }
                        const float* rp = rope + (size_t)pos * 32 + (fq & 1) * 8;
                        const f32x4 c0 = *(const f32x4*)rp, c1 = *(const f32x4*)(rp + 4), s0 = *(const f32x4*)(rp + 16), s1 = *(const f32x4*)(rp + 20);
                        f32x4 p0, p1;
#pragma unroll
                        for (int e = 0; e < 4; ++e) { p0[e] = __shfl_xor(v0[e], 32); p1[e] = __shfl_xor(v1[e], 32); }
                        const float sg = fq < 2 ? -1.f : 1.f;
                        const f32x4 r0 = v0 * c0 + p0 * s0 * sg, r1 = v1 * c1 + p1 * s1 * sg;
                        __builtin_nontemporal_store(r0, (f32x4*)(o + fq * 8)); __builtin_nontemporal_store(r1, (f32x4*)(o + fq * 8 + 4));
                        u32x4 w; w.x = cvt_pk_bf16(r0[0], r0[1]); w.y = cvt_pk_bf16(r0[2], r0[3]); w.z = cvt_pk_bf16(r1[0], r1[1]); w.w = cvt_pk_bf16(r1[2], r1[3]);
                        *(u32x4*)(KR + kvrow * 32 + fq * 8) = w; }
            }
        }
    }
};

struct ProgQ {
    int K, lda, ldb, G, c;
    const bf16_t* CQ; const bf16_t* Wt; const float* SSQ; bf16_t* Q; const float* rope; const float *qng, *qrg;
    static constexpr int NM = 130, NTOT = 130 * 3;
    __device__ __forceinline__ bool next(int i, Unit& u) const { const int L = i * G + c; if (L >= NTOT) return false; pg8::grouped(pg8::xcd_map(L, NTOT), NM, 3, u.pm, u.pn); u.kind = 0; return true; }
    __device__ __forceinline__ int nt(const Unit&) const { return K / 64; }
    __device__ __forceinline__ const char* aptr(const Unit& u) const { return (const char*)(CQ + (size_t)u.pm * 256 * 384); }
    __device__ __forceinline__ const char* bptr(const Unit& u) const { return (const char*)(Wt + (size_t)u.pn * 256 * 384); }
    __device__ __forceinline__ void epi(Acc& acc, const Unit& u, int wr, int wc, int fr, int fq) const {
        asm volatile("" : "+v"(fr), "+v"(fq));
        const int rl0 = wr * 64 + fr;
#pragma unroll
        for (int ai = 0; ai < 2; ++ai)
#pragma unroll
            for (int m = 0; m < 4; ++m) { const int row = u.pm * 256 + ai * 128 + rl0 + m * 16;
                const f32x4 q0 = *(const f32x4*)(SSQ + (size_t)row * 8), q1 = *(const f32x4*)(SSQ + (size_t)row * 8 + 4);
                const float rq = rsqrtf((((q0[0] + q0[1]) + (q0[2] + q0[3])) + ((q1[0] + q1[1]) + (q1[2] + q1[3]))) * (1.f / 384.f) + EPS);
                if (u.pn < 2) {
                    const int head = u.pn * 4 + wc; float s = 0.f; f32x4 v[2][2];
#pragma unroll
                    for (int bj = 0; bj < 2; ++bj)
#pragma unroll
                        for (int n = 0; n < 2; ++n) { v[bj][n] = acc[ai][bj][m][n] * rq; const f32x4 x = v[bj][n]; s += (x[0] * x[0] + x[1] * x[1]) + (x[2] * x[2] + x[3] * x[3]); }
                    s += __shfl_xor(s, 16); s += __shfl_xor(s, 32);
                    const float r2 = rsqrtf(s * (1.f / 64.f) + EPS) * QSCALE;
#pragma unroll
                    for (int bj = 0; bj < 2; ++bj) { const f32x4 g0 = *(const f32x4*)(qng + bj * 32 + fq * 8), g1 = *(const f32x4*)(qng + bj * 32 + fq * 8 + 4);
                        const f32x4 a = v[bj][0] * r2 * g0, b = v[bj][1] * r2 * g1;
                        u32x4 w; w.x = cvt_pk_bf16(a[0], a[1]); w.y = cvt_pk_bf16(a[2], a[3]); w.z = cvt_pk_bf16(b[0], b[1]); w.w = cvt_pk_bf16(b[2], b[3]);
                        *(u32x4*)(Q + (size_t)row * 768 + head * 96 + bj * 32 + fq * 8) = w; }
                } else {
                    const int pos = row < MP ? (row & 4095) : 2048 + ((row - MP) & 63);
                    const float* rp = rope + (size_t)pos * 32 + (fq & 1) * 8;
                    const f32x4 c0 = *(const f32x4*)rp, c1 = *(const f32x4*)(rp + 4), s0 = *(const f32x4*)(rp + 16), s1 = *(const f32x4*)(rp + 20);
                    const f32x4 g0 = *(const f32x4*)(qrg + fq * 8), g1 = *(const f32x4*)(qrg + fq * 8 + 4);
                    const float sg = fq < 2 ? -1.f : 1.f;
#pragma unroll
                    for (int bj = 0; bj < 2; ++bj) { const int head = bj * 4 + wc;
                        f32x4 v0 = acc[ai][bj][m][0] * rq, v1 = acc[ai][bj][m][1] * rq;
                        float s = (v0[0] * v0[0] + v0[1] * v0[1]) + (v0[2] * v0[2] + v0[3] * v0[3]) + (v1[0] * v1[0] + v1[1] * v1[1]) + (v1[2] * v1[2] + v1[3] * v1[3]);
                        s += __shfl_xor(s, 16); s += __shfl_xor(s, 32);
                        const float r2 = rsqrtf(s * (1.f / 32.f) + EPS);
                        v0 = v0 * r2 * g0; v1 = v1 * r2 * g1;
                        f32x4 p0, p1;
#pragma unroll
                        for (int e = 0; e < 4; ++e) { p0[e] = __shfl_xor(v0[e], 32); p1[e] = __shfl_xor(v1[e], 32); }
                        const f32x4 r0 = (v0 * c0 + p0 * s0 * sg) * QSCALE, r1 = (v1 * c1 + p1 * s1 * sg) * QSCALE;
                        u32x4 w; w.x = cvt_pk_bf16(r0[0], r0[1]); w.y = cvt_pk_bf16(r0[2], r0[3]); w.z = cvt_pk_bf16(r1[0], r1[1]); w.w = cvt_pk_bf16(r1[2], r1[3]);
                        *(u32x4*)(Q + (size_t)row * 768 + head * 96 + 64 + fq * 8) = w; }
                } }
    }
};

struct ProgKV {
    int K, lda, ldb, G, c;
    const bf16_t* CKV; const bf16_t* Wt; bf16_t *KN, *VVt; const float* kng;
    static constexpr int NM = 194, NA = 194 * 2, NTOT = 194 * 4;
    __device__ __forceinline__ bool next(int i, Unit& u) const {
        const int L = i * G + c; if (L >= NTOT) return false;
        const int w = pg8::xcd_map(L, NTOT);
        if (w < NA) { pg8::grouped(w, NM, 2, u.pm, u.pn); u.kind = 0; } else { pg8::grouped(w - NA, 2, NM, u.pm, u.pn); u.kind = 1; }
        return true;
    }
    __device__ __forceinline__ int nt(const Unit&) const { return K / 64; }
    __device__ __forceinline__ const char* aptr(const Unit& u) const { return u.kind == 0 ? (const char*)(CKV + (size_t)u.pm * 256 * 256) : (const char*)(Wt + (size_t)(512 + u.pm * 256) * 256); }
    __device__ __forceinline__ const char* bptr(const Unit& u) const { return u.kind == 0 ? (const char*)(Wt + (size_t)u.pn * 256 * 256) : (const char*)(CKV + (size_t)u.pn * 256 * 256); }
    __device__ __forceinline__ void epi(Acc& acc, const Unit& u, int wr, int wc, int fr, int fq) const {
        asm volatile("" : "+v"(fr), "+v"(fq));
        const int rl0 = wr * 64 + fr;
#pragma unroll
        for (int ai = 0; ai < 2; ++ai)
#pragma unroll
            for (int m = 0; m < 4; ++m) { const size_t row = (size_t)u.pm * 256 + ai * 128 + rl0 + m * 16;
                if (u.kind == 0) {
                    const int head = u.pn * 4 + wc; float s = 0.f;
#pragma unroll
                    for (int bj = 0; bj < 2; ++bj)
#pragma unroll
                        for (int n = 0; n < 2; ++n) { const f32x4 x = acc[ai][bj][m][n]; s += (x[0] * x[0] + x[1] * x[1]) + (x[2] * x[2] + x[3] * x[3]); }
                    s += __shfl_xor(s, 16); s += __shfl_xor(s, 32);
                    const float r2 = rsqrtf(s * (1.f / 64.f) + EPS);
#pragma unroll
                    for (int bj = 0; bj < 2; ++bj) { const f32x4 g0 = *(const f32x4*)(kng + bj * 32 + fq * 8), g1 = *(const f32x4*)(kng + bj * 32 + fq * 8 + 4);
                        const f32x4 a = acc[ai][bj][m][0] * r2 * g0, b = acc[ai][bj][m][1] * r2 * g1;
                        u32x4 w; w.x = cvt_pk_bf16(a[0], a[1]); w.y = cvt_pk_bf16(a[2], a[3]); w.z = cvt_pk_bf16(b[0], b[1]); w.w = cvt_pk_bf16(b[2], b[3]);
                        *(u32x4*)(KN + row * 512 + head * 64 + bj * 32 + fq * 8) = w; }
                } else {
#pragma unroll
                    for (int bj = 0; bj < 2; ++bj) { const f32x4 a = acc[ai][bj][m][0], b = acc[ai][bj][m][1];
                        u32x4 w; w.x = cvt_pk_bf16(a[0], a[1]); w.y = cvt_pk_bf16(a[2], a[3]); w.z = cvt_pk_bf16(b[0], b[1]); w.w = cvt_pk_bf16(b[2], b[3]);
                        *(u32x4*)(VVt + row * KVR + (size_t)u.pn * 256 + bj * 128 + wc * 32 + fq * 8) = w; }
                } }
    }
};

template <int MODE>
struct ProgRes {
    int K, lda, ldb, G, c, nsk;
    const bf16_t* Ab; const bf16_t* Wt; const float* xp; float* Y; bf16_t* X1; const float* gate; float* part;
    __device__ __forceinline__ bool next(int i, Unit& u) const {
        const int L = i * G + c; if (L >= 512 + 8 * nsk) return false;
        int pm, pn; pg8::grouped(pg8::xcd_map(L < 512 ? L : 0, 512), 128, 4, pm, pn);
        const int idx = L - 512, rem = idx & 7; const bool sp = L >= 512;
        u.pm = sp ? 128 + (rem >> 2) : pm; u.pn = sp ? (rem & 3) : pn; u.kind = sp ? 1 + (idx >> 3) : 0;
        return true;
    }
    __device__ __forceinline__ int nt(const Unit& u) const { return u.kind == 0 ? K / 64 : 4; }
    __device__ __forceinline__ const char* aptr(const Unit& u) const { return (const char*)(Ab + (size_t)u.pm * 256 * K + (u.kind ? (u.kind - 1) * 256 : 0)); }
    __device__ __forceinline__ const char* bptr(const Unit& u) const { return (const char*)(Wt + (size_t)u.pn * 256 * K + (u.kind ? (u.kind - 1) * 256 : 0)); }
    __device__ __forceinline__ void epi(Acc& acc, const Unit& u, int wr, int wc, int fr, int fq) const {
        asm volatile("" : "+v"(fr), "+v"(fq));
        const int rl0 = wr * 64 + fr;
        if (u.kind == 0) {
            const int b16 = u.pm >> 4;
#pragma unroll
            for (int ai = 0; ai < 2; ++ai) {
                f32x4 gv[2][2];
#pragma unroll
                for (int bj = 0; bj < 2; ++bj)
#pragma unroll
                    for (int n = 0; n < 2; ++n) gv[bj][n] = *(const f32x4*)(gate + (size_t)b16 * 6144 + u.pn * 256 + bj * 128 + wc * 32 + fq * 8 + n * 4);
#pragma unroll
                for (int m = 0; m < 4; ++m) { const int row = u.pm * 256 + ai * 128 + rl0 + m * 16;
#pragma unroll
                    for (int bj = 0; bj < 2; ++bj) { const int col = u.pn * 256 + bj * 128 + wc * 32 + fq * 8;
                        if constexpr (MODE == 0) {
                            const float* bp = xp + (size_t)row * DM;
                            const f32x4 r0 = *(const f32x4*)(bp + col) + gv[bj][0] * acc[ai][bj][m][0], r1 = *(const f32x4*)(bp + col + 4) + gv[bj][1] * acc[ai][bj][m][1];
                            u32x4 w; w.x = cvt_pk_bf16(r0[0], r0[1]); w.y = cvt_pk_bf16(r0[2], r0[3]); w.z = cvt_pk_bf16(r1[0], r1[1]); w.w = cvt_pk_bf16(r1[2], r1[3]);
                            *(u32x4*)(X1 + (size_t)row * DM + col) = w;
                        } else {
                            const u32x4 w = *(const u32x4*)(X1 + (size_t)row * DM + col);
                            const f32x4 b0 = (f32x4){__uint_as_float(w.x << 16), __uint_as_float(w.x & 0xffff0000u), __uint_as_float(w.y << 16), __uint_as_float(w.y & 0xffff0000u)};
                            const f32x4 b1 = (f32x4){__uint_as_float(w.z << 16), __uint_as_float(w.z & 0xffff0000u), __uint_as_float(w.w << 16), __uint_as_float(w.w & 0xffff0000u)};
                            __builtin_nontemporal_store(b0 + gv[bj][0] * acc[ai][bj][m][0], (f32x4*)(Y + (size_t)row * DM + col));
                            __builtin_nontemporal_store(b1 + gv[bj][1] * acc[ai][bj][m][1], (f32x4*)(Y + (size_t)row * DM + col + 4));
                        } } }
            }
        } else {
            float* pb = part + (size_t)(u.kind - 1) * 512 * DM;
#pragma unroll
            for (int ai = 0; ai < 2; ++ai)
#pragma unroll
                for (int m = 0; m < 4; ++m) { const int srow = (u.pm - 128) * 256 + ai * 128 + rl0 + m * 16;
#pragma unroll
                    for (int bj = 0; bj < 2; ++bj) { const int col = u.pn * 256 + bj * 128 + wc * 32 + fq * 8;
                        *(f32x4*)(pb + (size_t)srow * DM + col) = acc[ai][bj][m][0];
                        *(f32x4*)(pb + (size_t)srow * DM + col + 4) = acc[ai][bj][m][1]; } }
        }
    }
};

struct ProgFfn {
    int K, lda, ldb, G, c;
    const bf16_t* Ab; const bf16_t* Wt; bf16_t* Gb;
    static constexpr int NM = 130, NN = 22, NTOT = 130 * 22;
    __device__ __forceinline__ bool next(int i, Unit& u) const { const int L = i * G + c; if (L >= NTOT) return false; pg8::grouped(pg8::xcd_map(L, NTOT), NM, NN, u.pm, u.pn); u.kind = 0; return true; }
    __device__ __forceinline__ int nt(const Unit&) const { return K / 64; }
    __device__ __forceinline__ const char* aptr(const Unit& u) const { return (const char*)(Ab + (size_t)u.pm * 256 * DM); }
    __device__ __forceinline__ const char* bptr(const Unit& u) const { return (const char*)(Wt + (size_t)u.pn * 256 * DM); }
    __device__ __forceinline__ void epi(Acc& acc, const Unit& u, int wr, int wc, int fr, int fq) const {
        asm volatile("" : "+v"(fr), "+v"(fq));
        const int rl0 = wr * 64 + fr;
#pragma unroll
        for (int ai = 0; ai < 2; ++ai)
#pragma unroll
            for (int m = 0; m < 4; ++m) { const size_t row = (size_t)u.pm * 256 + ai * 128 + rl0 + m * 16;
                const f32x4 g0 = acc[ai][0][m][0], g1 = acc[ai][0][m][1], u0 = acc[ai][1][m][0], u1 = acc[ai][1][m][1];
                u32x4 w; w.x = cvt_pk_bf16(silu_f(g0[0]) * u0[0], silu_f(g0[1]) * u0[1]); w.y = cvt_pk_bf16(silu_f(g0[2]) * u0[2], silu_f(g0[3]) * u0[3]);
                w.z = cvt_pk_bf16(silu_f(g1[0]) * u1[0], silu_f(g1[1]) * u1[1]); w.w = cvt_pk_bf16(silu_f(g1[2]) * u1[2], silu_f(g1[3]) * u1[3]);
                *(u32x4*)(Gb + row * DFF + u.pn * 128 + wc * 32 + fq * 8) = w; }
    }
};

__device__ __forceinline__ void p0_transpose_item(const float* W, int ldw, int c0, int k0, bf16_t* WT, int K, int n0, const float* kscale, LAS float* scr, int lane) {
#pragma unroll
    for (int i = 0; i < 32; ++i) { const int kk = 2 * i + (lane >> 5); float v = 0.f;
        if (c0 >= 0) v = __builtin_nontemporal_load(W + (size_t)(k0 + kk) * ldw + c0 + (lane & 31));
        if (kscale) v *= kscale[k0 + kk];
        scr[kk * 33 + (lane & 31)] = v; }
    LDS_WAIT(); asm volatile("" ::: "memory");
    const int c = lane & 7;
#pragma unroll
    for (int j = 0; j < 4; ++j) { const int n = (lane >> 3) + 8 * j; const LAS float* s = scr + (8 * c) * 33 + n;
        u32x4 o; o.x = cvt_pk_bf16(s[0 * 33], s[1 * 33]); o.y = cvt_pk_bf16(s[2 * 33], s[3 * 33]); o.z = cvt_pk_bf16(s[4 * 33], s[5 * 33]); o.w = cvt_pk_bf16(s[6 * 33], s[7 * 33]);
        *(u32x4*)(WT + (size_t)(n0 + n) * K + k0 + 8 * c) = o; }
    LDS_WAIT(); asm volatile("" ::: "memory");
}
__device__ __forceinline__ void norm_load(const float* xrow, f32x4 (&v)[4], int lane) {
#pragma unroll
    for (int j = 0; j < 4; ++j) v[j] = __builtin_nontemporal_load((const f32x4*)xrow + lane + 64 * j);
}
__device__ __forceinline__ void norm_apply(const f32x4 (&v)[4], const float* g, const float* sc, const float* sh, bf16_t* orow, int lane) {
    float s = 0.f;
#pragma unroll
    for (int j = 0; j < 4; ++j) s += (v[j][0] * v[j][0] + v[j][1] * v[j][1]) + (v[j][2] * v[j][2] + v[j][3] * v[j][3]);
    const float rstd = rsqrtf(wave_sum(s) * (1.f / 1024.f) + EPS);
#pragma unroll
    for (int j = 0; j < 4; ++j) { const int c4 = lane + 64 * j;
        const f32x4 gg = *((const f32x4*)g + c4), cc = *((const f32x4*)sc + c4), hh = *((const f32x4*)sh + c4);
        const f32x4 h = v[j] * rstd * gg * (cc + 1.f) + hh;
        u32x2 w; w.x = cvt_pk_bf16(h[0], h[1]); w.y = cvt_pk_bf16(h[2], h[3]);
        *((u32x2*)orow + c4) = w; }
}
template <int NSK>
__device__ __forceinline__ void sample_combine(const float* gate, const float* part, int srow, f32x4 (&v)[4], int lane) {
#pragma unroll
    for (int j = 0; j < 4; ++j) { const int c4 = lane + 64 * j; f32x4 p[NSK];
#pragma unroll
        for (int k = 0; k < NSK; ++k) p[k] = __builtin_nontemporal_load((const f32x4*)(part + ((size_t)k * 512 + srow) * DM) + c4);
        f32x4 a = p[0];
#pragma unroll
        for (int k = 1; k < NSK; ++k) a += p[k];
        v[j] = v[j] + *((const f32x4*)gate + c4) * a; }
}
__device__ __forceinline__ void row_load_bf16(const bf16_t* row, f32x4 (&v)[4], int lane) {
#pragma unroll
    for (int j = 0; j < 4; ++j) { const u32x2 w = __builtin_nontemporal_load((const u32x2*)row + lane + 64 * j);
        v[j] = (f32x4){__uint_as_float(w.x << 16), __uint_as_float(w.x & 0xffff0000u), __uint_as_float(w.y << 16), __uint_as_float(w.y & 0xffff0000u)}; }
}
__device__ __forceinline__ void row_store_bf16(bf16_t* row, const f32x4 (&v)[4], int lane) {
#pragma unroll
    for (int j = 0; j < 4; ++j) { u32x2 w; w.x = cvt_pk_bf16(v[j][0], v[j][1]); w.y = cvt_pk_bf16(v[j][2], v[j][3]); *((u32x2*)row + lane + 64 * j) = w; }
}

constexpr int GM_PITCH = 272;
__device__ __forceinline__ void gmlp_phase(LAS unsigned char* lds, int it0, int G, const bf16_t* Wm, const bf16_t* Vt, const bf16_t* U, const float* bs, bf16_t* YAB) {
    const int tid = fresh_tid(), lane = tid & 63, wid = __builtin_amdgcn_readfirstlane(tid >> 6), fr = lane & 15, fq = lane >> 4;
    constexpr int NIT = 1024 + 32;
    u32x4 st[4];
#define GM_LOAD(item) do { const bool samp_ = (item) >= 1024; const int g_ = (item) & 3; const int tok_ = samp_ ? MP + 64 * (((item) - 1024) >> 2) : 128 * ((item) >> 2); \
        _Pragma("unroll") for (int q = 0; q < 4; ++q) { const int c_ = tid + 512 * q, row_ = c_ >> 4, ch_ = c_ & 15; \
            if (!samp_ || ch_ < 8) st[q] = __builtin_nontemporal_load((const u32x4*)(Vt + (size_t)(128 * g_ + row_) * MT + tok_ + ch_ * 8)); else st[q] = (u32x4){0u, 0u, 0u, 0u}; } } while (0)
    int item = it0;
    if (item < NIT) GM_LOAD(item);
    for (; item < NIT; item += G) {
        const bool samp = item >= 1024; const int g = item & 3;
        const int tok0 = samp ? MP + 64 * ((item - 1024) >> 2) : 128 * (item >> 2);
        const bool active = !(samp && wid >= 4);
        const int nk = (samp || wid < 4) ? 2 : 4;
        const int row = tok0 + 16 * wid + fr;
        bf16x8 bfr[4]; u32x2 uu8[8]; float bias = 0.f;
        if (active) {
            const bf16_t* wrow = Wm + (size_t)(g * 128 + 16 * wid + fr) * 128 + 8 * fq;
#pragma unroll
            for (int kk = 0; kk < 4; ++kk) bfr[kk] = *(const bf16x8*)(wrow + 32 * kk);
#pragma unroll
            for (int n = 0; n < 8; ++n) uu8[n] = __builtin_nontemporal_load((const u32x2*)(U + (size_t)row * 512 + 128 * g + 16 * n + 4 * fq));
            bias = bs[g * 128 + 16 * wid + fr];
        }
#pragma unroll
        for (int q = 0; q < 4; ++q) { const int c = tid + 512 * q; *(LAS u32x4*)(lds + (c >> 4) * GM_PITCH + (c & 15) * 16) = st[q]; }
        __syncthreads();
        if (item + G < NIT) GM_LOAD(item + G);
        if (active) {
            f32x4 acc[8];
#pragma unroll
            for (int n = 0; n < 8; ++n) acc[n] = (f32x4){0.f, 0.f, 0.f, 0.f};
            const LAS unsigned char* ab = lds + fr * GM_PITCH + fq * 16;
#pragma unroll
            for (int kk = 0; kk < 4; ++kk) { if (kk < nk) {
#pragma unroll
                for (int n = 0; n < 8; ++n) { const bf16x8 afr = *(const LAS bf16x8*)(ab + (16 * n) * GM_PITCH + kk * 64);
                    acc[n] = __builtin_amdgcn_mfma_f32_16x16x32_bf16(afr, bfr[kk], acc[n], 0, 0, 0); } } }
#pragma unroll
            for (int n = 0; n < 8; ++n) { const int col = 128 * g + 16 * n + 4 * fq; const u32x2 uu = uu8[n];
                const float y0 = __uint_as_float(uu.x << 16) * (acc[n][0] + bias), y1 = __uint_as_float(uu.x & 0xffff0000u) * (acc[n][1] + bias);
                const float y2 = __uint_as_float(uu.y << 16) * (acc[n][2] + bias), y3 = __uint_as_float(uu.y & 0xffff0000u) * (acc[n][3] + bias);
                u32x2 w; w.x = cvt_pk_bf16(y0, y1); w.y = cvt_pk_bf16(y2, y3);
                *(u32x2*)(YAB + (size_t)row * DM + col) = w; }
        }
        __syncthreads();
    }
#undef GM_LOAD
}

constexpr int KPITCH = 208, VPITCH = 136, KBUF = 64 * KPITCH, VBUF = 64 * VPITCH, ATT_V0 = 2 * KBUF;
template <bool QK, bool SM>
__device__ __forceinline__ void attn_step(const LAS unsigned char* kb, const LAS unsigned char* vbp, const bf16x8 (&qr)[6],
                                          f32x16& s0, f32x16& s1, f32x16& o0, f32x16& o1, float& mrow, float& lsum) {
    f32x16 n0 = {}, n1 = {};
    if constexpr (QK) {
#pragma unroll
        for (int s = 0; s < 6; ++s) { const bf16x8 ka = *(const LAS bf16x8*)(kb + s * 32), kc = *(const LAS bf16x8*)(kb + 32 * KPITCH + s * 32);
            n0 = __builtin_amdgcn_mfma_f32_32x32x16_bf16(ka, qr[s], n0, 0, 0, 0); n1 = __builtin_amdgcn_mfma_f32_32x32x16_bf16(kc, qr[s], n1, 0, 0, 0); }
    }
    if constexpr (SM) {
        float mx = max3f(s0[0], s1[0], s0[1]); mx = max3f(mx, s1[1], s0[2]); float my = max3f(s1[2], s0[3], s1[3]);
#pragma unroll
        for (int r = 4; r < 16; r += 4) { mx = max3f(mx, s0[r], s1[r]); my = max3f(my, s0[r + 1], s1[r + 1]); mx = max3f(mx, s0[r + 2], s1[r + 2]); my = max3f(my, s0[r + 3], s1[r + 3]); }
        mx = fmaxf(mx, my);
        { const auto rr = __builtin_amdgcn_permlane32_swap(__float_as_uint(mx), __float_as_uint(mx), false, false); mx = fmaxf(__uint_as_float(rr[0]), __uint_as_float(rr[1])); }
        const float mnew = fmaxf(mrow, mx), alpha = __builtin_amdgcn_exp2f(mrow - mnew); mrow = mnew;
        const f32x2 m2 = (f32x2){mnew, mnew}; f32x2 ps2 = (f32x2){0.f, 0.f};
#pragma unroll
        for (int r = 0; r < 16; r += 2) { f32x2 a = (f32x2){s0[r], s0[r + 1]} - m2, b = (f32x2){s1[r], s1[r + 1]} - m2;
            a.x = __builtin_amdgcn_exp2f(a.x); a.y = __builtin_amdgcn_exp2f(a.y); b.x = __builtin_amdgcn_exp2f(b.x); b.y = __builtin_amdgcn_exp2f(b.y);
            s0[r] = a.x; s0[r + 1] = a.y; s1[r] = b.x; s1[r + 1] = b.y; ps2 += a + b; }
        const float ps = ps2.x + ps2.y;
        lsum = lsum * alpha + ps;
#pragma unroll
        for (int r = 0; r < 16; ++r) { o0[r] *= alpha; o1[r] *= alpha; }
        bf16x8 pb[4];
#pragma unroll
        for (int S = 0; S < 4; ++S) { u32x4 w;
            if (S < 2) { w.x = cvt_pk_bf16(s0[8 * S + 0], s0[8 * S + 1]); w.y = cvt_pk_bf16(s0[8 * S + 2], s0[8 * S + 3]); w.z = cvt_pk_bf16(s0[8 * S + 4], s0[8 * S + 5]); w.w = cvt_pk_bf16(s0[8 * S + 6], s0[8 * S + 7]); }
            else { w.x = cvt_pk_bf16(s1[8 * S - 16], s1[8 * S - 15]); w.y = cvt_pk_bf16(s1[8 * S - 14], s1[8 * S - 13]); w.z = cvt_pk_bf16(s1[8 * S - 12], s1[8 * S - 11]); w.w = cvt_pk_bf16(s1[8 * S - 10], s1[8 * S - 9]); }
            pb[S] = __builtin_bit_cast(bf16x8, w); }
#pragma unroll
        for (int S = 0; S < 4; ++S) {
            const u32x2 a0 = *(const LAS u32x2*)(vbp + S * 32), a1 = *(const LAS u32x2*)(vbp + S * 32 + 16);
            const u32x2 c0 = *(const LAS u32x2*)(vbp + 32 * VPITCH + S * 32), c1 = *(const LAS u32x2*)(vbp + 32 * VPITCH + S * 32 + 16);
            const bf16x8 va = __builtin_bit_cast(bf16x8, (u32x4){a0.x, a0.y, a1.x, a1.y}), vc = __builtin_bit_cast(bf16x8, (u32x4){c0.x, c0.y, c1.x, c1.y});
            o0 = __builtin_amdgcn_mfma_f32_32x32x16_bf16(va, pb[S], o0, 0, 0, 0); o1 = __builtin_amdgcn_mfma_f32_32x32x16_bf16(vc, pb[S], o1, 0, 0, 0); }
    }
    s0 = n0; s1 = n1;
}
__device__ __forceinline__ void attn_unit(LAS unsigned char* lds, const bf16_t* Qrow0, int nqw, int limbase, bool prompt, size_t kv0, int NT, int h,
                                          const bf16_t* KN, const bf16_t* KR, const bf16_t* VVt, bf16_t* Yrow0) {
    const int tid = fresh_tid(), lane = tid & 63, wid = __builtin_amdgcn_readfirstlane(tid >> 6), r32 = lane & 31, hi = lane >> 5;
    const int lim = wid < nqw ? (prompt ? limbase + (wid >> 1) + 1 : NT) : 0;
    const int kr0 = tid / 12, kp0 = tid % 12, kr1 = (tid + 512) / 12, kp1 = (tid + 512) % 12;
    const bf16_t* ksrc0 = kp0 < 8 ? KN + (kv0 + kr0) * 512 + h * 64 + kp0 * 8 : KR + (kv0 + kr0) * 32 + (kp0 - 8) * 8;
    const size_t kstr0 = kp0 < 8 ? 512 * 64 : 32 * 64;
    const bf16_t* ksrc1 = kp1 < 8 ? KN + (kv0 + kr1) * 512 + h * 64 + kp1 * 8 : KR + (kv0 + kr1) * 32 + (kp1 - 8) * 8;
    const size_t kstr1 = kp1 < 8 ? 512 * 64 : 32 * 64;
    const bool k1 = tid < 256;
    const bf16_t* vsrc = VVt + (size_t)(h * 64 + (tid >> 3)) * KVR + kv0 + (tid & 7) * 8;
    const int kd0 = kr0 * KPITCH + kp0 * 16, kd1 = kr1 * KPITCH + kp1 * 16, vd = (tid >> 3) * VPITCH + (tid & 7) * 16;
    u32x4 ak0, ak1, av, bk0, bk1, bv;
    const bf16_t* ksrc1c = k1 ? ksrc1 : ksrc0; const size_t kstr1c = k1 ? kstr1 : kstr0;
    const int ntm = NT - 1;
#define ATT_LDK(K0, K1, t) do { const int t_ = (t) < ntm ? (t) : ntm; K0 = *(const u32x4*)(ksrc0 + (size_t)t_ * kstr0); K1 = *(const u32x4*)(ksrc1c + (size_t)t_ * kstr1c); } while (0)
#define ATT_LDV(V, t) do { const int t_ = (t) < ntm ? (t) : ntm; V = *(const u32x4*)(vsrc + (size_t)t_ * 64); } while (0)
#define ATT_STK(K0, K1, b) do { *(LAS u32x4*)(lds + (b) * KBUF + kd0) = K0; if (k1) *(LAS u32x4*)(lds + (b) * KBUF + kd1) = K1; } while (0)
#define ATT_STV(V, b) do { *(LAS u32x2*)(lds + ATT_V0 + (b) * VBUF + vd) = (u32x2){V.x, V.y}; *(LAS u32x2*)(lds + ATT_V0 + (b) * VBUF + vd + 8) = (u32x2){V.z, V.w}; } while (0)
#define ATT_BAR() asm volatile("s_waitcnt lgkmcnt(0)\n\ts_barrier" ::: "memory")
    ATT_LDK(ak0, ak1, 0); ATT_LDV(av, 0); ATT_LDK(bk0, bk1, 1);
    bf16x8 qr[6];
    if (wid < nqw) {
#pragma unroll
        for (int s = 0; s < 6; ++s) qr[s] = *(const bf16x8*)(Qrow0 + (size_t)(wid * 32 + r32) * 768 + h * 96 + s * 16 + hi * 8);
    } else {
#pragma unroll
        for (int s = 0; s < 6; ++s) qr[s] = (bf16x8){0, 0, 0, 0, 0, 0, 0, 0};
    }
    ATT_STK(ak0, ak1, 0); ATT_STV(av, 0); ATT_STK(bk0, bk1, 1);
    ATT_LDK(ak0, ak1, 2); ATT_LDV(av, 1);
    ATT_BAR();
    float mrow = -1e30f, lsum = 0.f; f32x16 o0 = {}, o1 = {}, s0 = {}, s1 = {};
    if (wid >= 4) __builtin_amdgcn_s_setprio(1);
    const LAS unsigned char* kbase = lds + r32 * KPITCH + hi * 16;
    const LAS unsigned char* vbase = lds + ATT_V0 + r32 * VPITCH + hi * 8;
    if (lim > 0) attn_step<true, false>(kbase, vbase, qr, s0, s1, o0, o1, mrow, lsum);
    ATT_BAR();
#define ATT_ITER(t, XK0, XK1, XV, YK0, YK1, YV) do { const int buf_ = (t) & 1; \
        ATT_LDK(YK0, YK1, (t) + 3); ATT_LDV(YV, (t) + 2); \
        if ((t) + 1 < lim) attn_step<true, true>(kbase + (buf_ ^ 1) * KBUF, vbase + buf_ * VBUF, qr, s0, s1, o0, o1, mrow, lsum); \
        else if ((t) < lim) attn_step<false, true>(kbase + (buf_ ^ 1) * KBUF, vbase + buf_ * VBUF, qr, s0, s1, o0, o1, mrow, lsum); \
        ATT_STK(XK0, XK1, buf_); ATT_STV(XV, buf_ ^ 1); \
        ATT_BAR(); } while (0)
    for (int t = 0; t < NT; t += 2) {
        ATT_ITER(t, ak0, ak1, av, bk0, bk1, bv);
        if (t + 1 < NT) ATT_ITER(t + 1, bk0, bk1, bv, ak0, ak1, av);
    }
    asm volatile("s_waitcnt vmcnt(0)" ::: "memory");
    __builtin_amdgcn_s_setprio(0);
#undef ATT_LDK
#undef ATT_LDV
#undef ATT_STK
#undef ATT_STV
#undef ATT_ITER
    if (wid < nqw) {
        lsum += __shfl_xor(lsum, 32);
        const float inv = 1.f / lsum;
        bf16_t* yp = Yrow0 + (size_t)(wid * 32 + r32) * DM + 512 + h * 64 + 4 * hi;
#pragma unroll
        for (int g = 0; g < 4; ++g) {
            u32x2 w; w.x = cvt_pk_bf16(o0[4 * g] * inv, o0[4 * g + 1] * inv); w.y = cvt_pk_bf16(o0[4 * g + 2] * inv, o0[4 * g + 3] * inv);
            *(u32x2*)(yp + 8 * g) = w;
            u32x2 x; x.x = cvt_pk_bf16(o1[4 * g] * inv, o1[4 * g + 1] * inv); x.y = cvt_pk_bf16(o1[4 * g + 2] * inv, o1[4 * g + 3] * inv);
            *(u32x2*)(yp + 32 + 8 * g) = x; }
    }
}


#define XB_TMO      128
#define XB_XCNT(j)  (256  + 64 * (j))
#define XB_XSUB(j)  (1280 + 64 * (j))
#define XB_XGEN(j)  (2304 + 64 * (j))
#define XB_TOP      3328
#define XB_TOPGEN   3392
#define XCD_BAR_WORDS 3456
#define XB_SPIN_CAP (1u << 18)
__device__ __forceinline__ unsigned xb_ld(unsigned* p)              { return __hip_atomic_load(p, __ATOMIC_RELAXED, __HIP_MEMORY_SCOPE_AGENT); }
__device__ __forceinline__ unsigned xb_add(unsigned* p, unsigned v) { return __hip_atomic_fetch_add(p, v, __ATOMIC_RELAXED, __HIP_MEMORY_SCOPE_AGENT); }
__device__ __forceinline__ unsigned xb_xcc_id() { return (unsigned)__builtin_amdgcn_s_getreg((3 << 11) | 20) & 0xFu; }
#define XB_SPIN(cond, bar) do { unsigned _sp = 0; while (cond) { __builtin_amdgcn_s_sleep(1); \
    if ((++_sp & 255u) == 0u) { if (xb_ld(&(bar)[XB_TMO])) break; if (_sp > XB_SPIN_CAP) { atomicAdd(&(bar)[XB_TMO], 1u); break; } } } } while (0)
struct XcdBarrier { unsigned* bar; unsigned x; volatile LAS unsigned* st; };
__device__ __forceinline__ XcdBarrier xcd_barrier_post(unsigned* bar, volatile LAS unsigned* st) {
    XcdBarrier b; b.bar = bar; b.x = xb_xcc_id(); b.st = st;
    if (threadIdx.x == 0) (void)xb_add(&bar[XB_XCNT(b.x)], 1u);
    return b;
}
__device__ __forceinline__ void xcd_barrier_complete(unsigned* bar, unsigned x, unsigned& nloc, unsigned& nx) {
    const unsigned G = gridDim.x * gridDim.y * gridDim.z;
    unsigned sum, cnt, mine, sp = 0u;
    for (;;) {
        sum = 0u; cnt = 0u; mine = 0u;
#pragma unroll
        for (unsigned j = 0; j < 16; ++j) { const unsigned c = xb_ld(&bar[XB_XCNT(j)]); sum += c; cnt += (c > 0u) ? 1u : 0u; mine = (j == x) ? c : mine; }
        if (sum == G) break;
        __builtin_amdgcn_s_sleep(1);
        if ((++sp & 255u) == 0u) { if (xb_ld(&bar[XB_TMO])) break; if (sp > XB_SPIN_CAP) { atomicAdd(&bar[XB_TMO], 1u); break; } }
    }
    nloc = mine > 0u ? mine : 1u; nx = cnt > 0u ? cnt : 1u;
}
__device__ __forceinline__ void xcd_barrier(const XcdBarrier& b) {
    asm volatile("s_waitcnt vmcnt(0)" ::: "memory");
    __syncthreads();
    if (threadIdx.x == 0) {
        unsigned* bar = b.bar;
        __builtin_amdgcn_s_waitcnt(0);
        unsigned nloc = b.st[0], nx = b.st[1];
        if (nloc == 0u) { xcd_barrier_complete(bar, b.x, nloc, nx); b.st[0] = nloc; b.st[1] = nx; }
        const unsigned old = xb_add(&bar[XB_XSUB(b.x)], 1u);
        const unsigned gen = old / nloc;
        if (old + 1u == (gen + 1u) * nloc) {
            __builtin_amdgcn_fence(__ATOMIC_RELEASE, "agent");
            asm volatile("s_waitcnt vmcnt(0)" ::: "memory");
            const unsigned og = xb_add(&bar[XB_TOP], 1u);
            const unsigned tg = og / nx;
            if (og + 1u == (tg + 1u) * nx) xb_add(&bar[XB_TOPGEN], 1u);
            else XB_SPIN(xb_ld(&bar[XB_TOPGEN]) == tg, bar);
            __builtin_amdgcn_fence(__ATOMIC_ACQUIRE, "agent");
            xb_add(&bar[XB_XGEN(b.x)], 1u);
            asm volatile("s_waitcnt vmcnt(0)" ::: "memory");
        } else {
            XB_SPIN(xb_ld(&bar[XB_XGEN(b.x)]) == gen, bar);
            __builtin_amdgcn_fence(__ATOMIC_ACQUIRE, "agent");
            asm volatile("s_waitcnt vmcnt(0)" ::: "memory");
        }
    }
    __syncthreads();
}

__global__ void __launch_bounds__(512, 2) mega_fwd(Args a) {
    extern __shared__ __attribute__((aligned(16))) unsigned char lds_raw[];
    LAS unsigned char* lds = (LAS unsigned char*)lds_raw;
    cg::grid_group grid = cg::this_grid();
    const int G = gridDim.x, bx = blockIdx.x;
#define FRESH_IDS() const int tid = fresh_tid(), lane = tid & 63, wid = __builtin_amdgcn_readfirstlane(tid >> 6); (void)tid; (void)lane; (void)wid
    unsigned char* ws = a.ws;
    const float *x_p = a.in[0], *x_s = a.in[1], *cache_ckv = a.in[2], *cache_kr = a.in[3], *c_p = a.in[4], *c_s = a.in[5], *w_ada = a.in[6], *b_ada = a.in[7],
                *norm1_g = a.in[8], *w_in = a.in[9], *w_s = a.in[10], *b_s = a.in[11], *q_norm_g = a.in[12], *w_uq = a.in[13], *kv_norm_g = a.in[14], *w_ukv = a.in[15],
                *qn_g = a.in[16], *qr_g = a.in[17], *kn_g = a.in[18], *kr_g = a.in[19], *w_out = a.in[20], *norm2_g = a.in[21], *w_fi = a.in[22], *w_fo = a.in[23];
    float* out = a.out;
    float* PART = (float*)(ws + WS_PART); bf16_t* X1B = (bf16_t*)(ws + WS_X1B);
    float* MOD = (float*)(ws + WS_MOD); float* ROPE = (float*)(ws + WS_ROPE); float* SSQ = (float*)(ws + WS_SSQ);
    bf16_t *Wm = (bf16_t*)(ws + WS_WM), *Wt_in = (bf16_t*)(ws + WS_WIN), *Wt_uq = (bf16_t*)(ws + WS_WUQ), *Wt_ukv = (bf16_t*)(ws + WS_WUKV), *Wt_out = (bf16_t*)(ws + WS_WOUT),
           *Wt_fi = (bf16_t*)(ws + WS_WFI), *Wt_fo = (bf16_t*)(ws + WS_WFO), *Hb = (bf16_t*)(ws + WS_H), *YAB = (bf16_t*)(ws + WS_YAB), *Gb = (bf16_t*)(ws + WS_G),
           *Ub = (bf16_t*)(ws + WS_U), *Vt = (bf16_t*)(ws + WS_VT), *CQ = (bf16_t*)(ws + WS_CQ), *CKV = (bf16_t*)(ws + WS_CKV), *KR = (bf16_t*)(ws + WS_KR),
           *KN = (bf16_t*)(ws + WS_KN), *VVt = (bf16_t*)(ws + WS_VVT), *Qb = (bf16_t*)(ws + WS_Q);

    { const int t0 = threadIdx.x; if (t0 < 2) ((volatile LAS unsigned*)(lds + LDS_X + 8192))[t0] = 0u; }
    __syncthreads();
    const XcdBarrier xbar = xcd_barrier_post((unsigned*)(ws + WS_BAR), (volatile LAS unsigned*)(lds + LDS_X + 8192));
    {
        FRESH_IDS();
        for (int it = bx; it < 96; it += G) {
            LAS float* sl = (LAS float*)lds; LAS float* red = (LAS float*)(lds + 65536);
            for (int e = tid; e < 16384; e += 512) { const int r = e >> 10, k = e & 1023; const float c = r < 8 ? c_p[r * 1024 + k] : c_s[(r - 8) * 1024 + k]; sl[e] = silu_f(c); }
            __syncthreads();
            float acc[16];
#pragma unroll
            for (int r = 0; r < 16; ++r) acc[r] = 0.f;
            const float* wp = w_ada + (size_t)(wid * 128) * 6144 + it * 64 + lane;
            for (int k = 0; k < 128; k += 16) {
                float wv[16];
#pragma unroll
                for (int j = 0; j < 16; ++j) wv[j] = __builtin_nontemporal_load(wp + (size_t)(k + j) * 6144);
#pragma unroll
                for (int jj = 0; jj < 4; ++jj)
#pragma unroll
                    for (int r = 0; r < 16; ++r) { const f32x4 s4 = *(const LAS f32x4*)(sl + r * 1024 + wid * 128 + k + 4 * jj);
                        acc[r] += (s4[0] * wv[4 * jj] + s4[1] * wv[4 * jj + 1]) + (s4[2] * wv[4 * jj + 2] + s4[3] * wv[4 * jj + 3]); }
            }
#pragma unroll
            for (int r = 0; r < 16; ++r) red[(wid * 16 + r) * 64 + lane] = acc[r];
            __syncthreads();
            for (int e = tid; e < 1024; e += 512) { const int r = e >> 6, col = e & 63; float s = b_ada[it * 64 + col];
#pragma unroll
                for (int w = 0; w < 8; ++w) s += red[(w * 16 + r) * 64 + col];
                MOD[(size_t)r * 6144 + it * 64 + col] = s; }
            __syncthreads();
        }
        LAS float* scr = (LAS float*)(lds + wid * 16384);
        const int gw = ((bx + G - 96 % G) % G) * 8 + wid, NGW = G * 8;
        constexpr int I_IN = 16 * 56, I_UQ = 6 * 24, I_UKV = 4 * 32, I_OUT = 16 * 32, I_FI = 16 * 176, I_FO = 44 * 32, I_CKV = 4096, I_CKR = 2048, I_ROPE = 1024, I_WM = 1024;
        constexpr int NITEMS = I_IN + I_UQ + I_UKV + I_OUT + I_FI + I_FO + I_CKV + I_CKR + I_ROPE + I_WM;
        for (int it = gw; it < NITEMS; it += NGW) {
            int r = it;
            if (r < I_IN) { const int kb = r / 56, nb = r % 56, n0 = nb * 32;
                const int c0 = n0 < 512 ? n0 : n0 < 768 ? 1408 + (n0 - 512) : n0 < 1152 ? 1024 + (n0 - 768) : n0 < 1184 ? 1664 : n0 < 1280 ? -1 : 512 + (n0 - 1280);
                p0_transpose_item(w_in, 1696, c0, kb * 64, Wt_in, 1024, n0, nullptr, scr, lane); continue; } r -= I_IN;
            if (r < I_UQ) { const int kb = r / 24, nb = r % 24, pn = nb >> 3, bj = (nb >> 2) & 1, wc = nb & 3;
                const int c0 = pn < 2 ? 96 * (4 * pn + wc) + 32 * bj : 96 * (4 * bj + wc) + 64;
                p0_transpose_item(w_uq, 768, c0, kb * 64, Wt_uq, 384, nb * 32, q_norm_g, scr, lane); continue; } r -= I_UQ;
            if (r < I_UKV) { const int kb = r / 32, nb = r % 32; int c0;
                if (nb < 16) { const int pn = nb >> 3, bj = (nb >> 2) & 1, wc = nb & 3; c0 = 128 * (4 * pn + wc) + 32 * bj; }
                else { const int ch0 = (nb - 16) * 32; c0 = 128 * (ch0 >> 6) + 64 + (ch0 & 63); }
                p0_transpose_item(w_ukv, 1024, c0, kb * 64, Wt_ukv, 256, nb * 32, nullptr, scr, lane); continue; } r -= I_UKV;
            if (r < I_OUT) { const int kb = r / 32, nb = r % 32; p0_transpose_item(w_out, 1024, nb * 32, kb * 64, Wt_out, 1024, nb * 32, nullptr, scr, lane); continue; } r -= I_OUT;
            if (r < I_FI) { const int kb = r / 176, nb = r % 176, n0 = nb * 32, pn = n0 >> 8, bj = (n0 >> 7) & 1, rr = n0 & 127;
                p0_transpose_item(w_fi, 5632, bj * 2816 + 128 * pn + rr, kb * 64, Wt_fi, 1024, n0, nullptr, scr, lane); continue; } r -= I_FI;
            if (r < I_FO) { const int kb = r / 32, nb = r % 32; p0_transpose_item(w_fo, 1024, nb * 32, kb * 64, Wt_fo, 2816, nb * 32, nullptr, scr, lane); continue; } r -= I_FO;
            if (r < I_CKV) { const int row0 = r * 4, b = row0 >> 11, p = row0 & 2047; f32x4 v[4];
#pragma unroll
                for (int q = 0; q < 4; ++q) v[q] = __builtin_nontemporal_load((const f32x4*)(cache_ckv + (size_t)(row0 + q) * 256) + lane);
#pragma unroll
                for (int q = 0; q < 4; ++q) { u32x2 w; w.x = cvt_pk_bf16(v[q][0], v[q][1]); w.y = cvt_pk_bf16(v[q][2], v[q][3]);
                    *((u32x2*)(CKV + ((size_t)MP + b * 2112 + p + q) * 256) + lane) = w; }
                continue; } r -= I_CKV;
            if (r < I_CKR) { const int row = r * 8 + (lane >> 3), b = row >> 11, p = row & 2047; const f32x4 v = *((const f32x4*)(cache_kr + (size_t)row * 32) + (lane & 7));
                u32x2 w; w.x = cvt_pk_bf16(v[0], v[1]); w.y = cvt_pk_bf16(v[2], v[3]);
                *((u32x2*)(KR + ((size_t)MP + b * 2112 + p) * 32) + (lane & 7)) = w; continue; } r -= I_CKR;
            if (r < I_ROPE) { const int e = r * 64 + lane, pos = e >> 4, j = e & 15;
                const double inv = exp(-(double)j * (1.0 / 16.0) * 9.210340371976184);
                const double rev = (double)pos * inv * 0.15915494309189535; const float fr = (float)(rev - floor(rev));
                ROPE[(size_t)pos * 32 + j] = __builtin_amdgcn_cosf(fr); ROPE[(size_t)pos * 32 + 16 + j] = __builtin_amdgcn_sinf(fr); continue; } r -= I_ROPE;
            { const int e = r * 64 + lane, i = (e >> 7) & 127, j = e & 127; const float v = (j >> 6) <= (i >> 6) ? w_s[e] : 0.f; Wm[e] = (bf16_t)(cvt_pk_bf16(v, 0.f) & 0xffffu); }
        }
    }
    xcd_barrier(xbar);
    if (G == 0x7fffffff) grid.sync();

    { FRESH_IDS();
        int row = bx * 8 + wid; f32x4 nv[4];
        if (row < MT) norm_load(row < MP ? x_p + (size_t)row * DM : x_s + (size_t)(row - MP) * DM, nv, lane);
        for (; row < MT; row += G * 8) {
            f32x4 v[4];
#pragma unroll
            for (int j = 0; j < 4; ++j) v[j] = nv[j];
            const int nr = row + G * 8;
            if (nr < MT) norm_load(nr < MP ? x_p + (size_t)nr * DM : x_s + (size_t)(nr - MP) * DM, nv, lane);
            const int b16 = row < MP ? (row >> 12) : 8 + ((row - MP) >> 6);
            norm_apply(v, norm1_g, MOD + (size_t)b16 * 6144 + 1024, MOD + (size_t)b16 * 6144, Hb + (size_t)row * DM, lane);
        } }
    xcd_barrier(xbar);

    {
        ProgIn P; P.K = 1024; P.lda = 1024; P.ldb = 1024; P.G = G; P.c = bx; P.H = Hb; P.Wt = Wt_in; P.U = Ub; P.Vt = Vt; P.CQ = CQ; P.CKV = CKV; P.KR = KR; P.SSQ = SSQ; P.out = out;
        P.rope = ROPE; P.kvg = kv_norm_g; P.krg = kr_g; P.xl = (LAS float*)(lds + LDS_X);
        pg8::gemm_phase(lds, P);
    }
    xcd_barrier(xbar);

    {
        ProgQ P; P.K = 384; P.lda = 384; P.ldb = 384; P.G = G; P.c = bx; P.CQ = CQ; P.Wt = Wt_uq; P.SSQ = SSQ; P.Q = Qb; P.rope = ROPE; P.qng = qn_g; P.qrg = qr_g;
        pg8::gemm_phase(lds, P);
    }
    {
        ProgKV P; P.K = 256; P.lda = 256; P.ldb = 256; P.G = G; P.c = (G == 256) ? ((bx + 140) & 255) : bx;
        P.CKV = CKV; P.Wt = Wt_ukv; P.KN = KN; P.VVt = VVt; P.kng = kn_g;
        pg8::gemm_phase(lds, P);
    }
    gmlp_phase(lds, (G == 256) ? ((bx + 96) & 255) : bx, G, Wm, Vt, Ub, b_s, YAB);
    xcd_barrier(xbar);

    {
        const int vcu = (G % 8 == 0) ? (bx % 8) * (G / 8) + bx / 8 : bx;
        if (G == 256) {
            const int xcd = bx & 7; unsigned* ctr = (unsigned*)(ws + WS_CTR) + xcd * 64;
            volatile LAS int* qw = (volatile LAS int*)(lds + LDS_X + 8192 + 64);
            for (;;) {
                if (threadIdx.x == 0) qw[0] = (int)atomicAdd(ctr, 1u);
                __syncthreads();
                const int j = qw[0];
                __syncthreads();
                if (j >= 136) break;
                if (j < 96 || j >= 104) { const int jj = j < 96 ? j : j - 104, qb = j < 96 ? 15 - (jj >> 3) : 3 - (jj >> 3), bh = xcd * 8 + (jj & 7), b = bh >> 3, h = bh & 7;
                    const size_t r0 = (size_t)b * 4096 + qb * 256;
                    attn_unit(lds, Qb + r0 * 768, 8, 4 * qb, true, (size_t)b * 4096, 4 * qb + 4, h, KN, KR, VVt, YAB + r0 * DM);
                } else { const int bh = xcd * 8 + (j - 96), b2 = bh >> 3, h2 = bh & 7; const size_t r0 = (size_t)MP + b2 * 64;
                    attn_unit(lds, Qb + r0 * 768, 2, 0, false, (size_t)MP + b2 * 2112, 33, h2, KN, KR, VVt, YAB + r0 * DM); }
            }
        } else {
            for (int it = vcu; it < 1024 + 64; it += G) {
                if (it < 1024) { const int bh = it >> 4, qb = it & 15, b = bh >> 3, h = bh & 7;
                    const size_t r0 = (size_t)b * 4096 + qb * 256;
                    attn_unit(lds, Qb + r0 * 768, 8, 4 * qb, true, (size_t)b * 4096, 4 * qb + 4, h, KN, KR, VVt, YAB + r0 * DM);
                } else { const int bh = it - 1024, b = bh >> 3, h = bh & 7; const size_t r0 = (size_t)MP + b * 64;
                    attn_unit(lds, Qb + r0 * 768, 2, 0, false, (size_t)MP + b * 2112, 33, h, KN, KR, VVt, YAB + r0 * DM); }
            }
        }
    }
    xcd_barrier(xbar);

    {
        ProgRes<0> P; P.K = 1024; P.lda = 1024; P.ldb = 1024; P.G = G; P.c = bx; P.Ab = YAB; P.Wt = Wt_out; P.xp = x_p; P.Y = out; P.X1 = X1B; P.gate = MOD + 2048; P.part = PART; P.nsk = 4;
        pg8::gemm_phase(lds, P);
    }
    xcd_barrier(xbar);

    { FRESH_IDS();
        int row = bx * 8 + wid; f32x4 nv[4];
        if (row < MP) row_load_bf16(X1B + (size_t)row * DM, nv, lane);
        for (; row < MP; row += G * 8) {
            f32x4 v[4];
#pragma unroll
            for (int j = 0; j < 4; ++j) v[j] = nv[j];
            const int nr = row + G * 8;
            if (nr < MP) row_load_bf16(X1B + (size_t)nr * DM, nv, lane);
            const int b16 = row >> 12;
            norm_apply(v, norm2_g, MOD + (size_t)b16 * 6144 + 4096, MOD + (size_t)b16 * 6144 + 3072, Hb + (size_t)row * DM, lane);
        }
        for (int sr = ((bx + 128) % G) * 8 + wid; sr < MS; sr += G * 8) { const int b16 = 8 + (sr >> 6); f32x4 v[4];
            norm_load(x_s + (size_t)sr * DM, v, lane);
            sample_combine<4>(MOD + (size_t)b16 * 6144 + 2048, PART, sr, v, lane);
            row_store_bf16(X1B + (size_t)(MP + sr) * DM, v, lane);
            row_load_bf16(X1B + (size_t)(MP + sr) * DM, v, lane);
            norm_apply(v, norm2_g, MOD + (size_t)b16 * 6144 + 4096, MOD + (size_t)b16 * 6144 + 3072, Hb + (size_t)(MP + sr) * DM, lane);
        } }
    xcd_barrier(xbar);

    {
        ProgFfn P; P.K = 1024; P.lda = 1024; P.ldb = 1024; P.G = G; P.c = bx; P.Ab = Hb; P.Wt = Wt_fi; P.Gb = Gb;
        pg8::gemm_phase(lds, P);
    }
    xcd_barrier(xbar);

    {
        ProgRes<1> P; P.K = DFF; P.lda = DFF; P.ldb = DFF; P.G = G; P.c = bx; P.Ab = Gb; P.Wt = Wt_fo; P.xp = nullptr; P.Y = out; P.X1 = X1B; P.gate = MOD + 5120; P.part = PART; P.nsk = 11;
        pg8::gemm_phase(lds, P);
    }
    xcd_barrier(xbar);

    { FRESH_IDS();
        for (int it = bx * 8 + wid; it < MS * 4; it += G * 8) { const int sr = it >> 2, c4 = lane + 64 * (it & 3), b16 = 8 + (sr >> 6);
            const u32x2 w = *((const u32x2*)(X1B + (size_t)(MP + sr) * DM) + c4);
            const f32x4 base = (f32x4){__uint_as_float(w.x << 16), __uint_as_float(w.x & 0xffff0000u), __uint_as_float(w.y << 16), __uint_as_float(w.y & 0xffff0000u)};
            f32x4 p[11];
#pragma unroll
            for (int k = 0; k < 11; ++k) p[k] = __builtin_nontemporal_load((const f32x4*)(PART + ((size_t)k * 512 + sr) * DM) + c4);
            f32x4 acc = p[0];
#pragma unroll
            for (int k = 1; k < 11; ++k) acc += p[k];
            __builtin_nontemporal_store(base + *((const f32x4*)(MOD + (size_t)b16 * 6144 + 5120) + c4) * acc, (f32x4*)(out + (size_t)(MP + sr) * DM) + c4); } }
}

extern "C" void kernel_launch(void* const* d_in, const int* in_sizes, int n_in, void* d_out, int out_size, void* d_ws, size_t ws_size, hipStream_t stream) {
    static int grid = 0;
    if (grid == 0) {
        if (n_in != 24 || ws_size < WS_END) { fprintf(stderr, "kernel_launch: unexpected n_in %d / ws_size %zu (need %zu)\n", n_in, ws_size, (size_t)WS_END); grid = -1; return; }
        int dev = 0, cus = 0, per_cu = 0;
        hipGetDevice(&dev); hipDeviceGetAttribute(&cus, hipDeviceAttributeMultiprocessorCount, dev);
        if (hipFuncSetAttribute((const void*)mega_fwd, hipFuncAttributeMaxDynamicSharedMemorySize, LDS_BYTES) != hipSuccess) { fprintf(stderr, "kernel_launch: hipFuncSetAttribute failed\n"); grid = -1; return; }
        if (hipOccupancyMaxActiveBlocksPerMultiprocessor(&per_cu, (const void*)mega_fwd, 512, LDS_BYTES) != hipSuccess || per_cu < 1) { fprintf(stderr, "kernel_launch: occupancy query gave %d\n", per_cu); per_cu = 1; }
        (void)hipGetLastError();
        grid = cus;
        fprintf(stderr, "kernel_launch: grid %d (cus %d, per_cu %d)\n", grid, cus, per_cu);
    }
    if (grid < 0) return;
    if (hipMemsetAsync((char*)d_ws + WS_BAR, 0, 32768, stream) != hipSuccess) { fprintf(stderr, "kernel_launch: memset of control words failed\n"); return; }
    Args a{};
    for (int i = 0; i < 24; ++i) a.in[i] = (const float*)d_in[i];
    a.out = (float*)d_out; a.ws = (unsigned char*)d_ws;
    void* args[] = {&a};
    hipError_t e = hipLaunchCooperativeKernel((const void*)mega_fwd, dim3(grid), dim3(512), args, LDS_BYTES, stream);
    if (e != hipSuccess) fprintf(stderr, "kernel_launch: cooperative launch failed: %s (grid %d)\n", hipGetErrorString(e), grid);
}
```

```cpp
#include <hip/hip_runtime.h>
#include <hip/hip_cooperative_groups.h>
#include <cstdio>
#include <cstdint>
namespace cg = cooperative_groups;

#define LAS __attribute__((address_space(3)))
typedef unsigned short bf16_t;
typedef short bf16x8 __attribute__((ext_vector_type(8)));
typedef short s16x4 __attribute__((ext_vector_type(4)));
typedef float f32x4 __attribute__((ext_vector_type(4)));
typedef float f32x16 __attribute__((ext_vector_type(16)));
typedef unsigned u32x4 __attribute__((ext_vector_type(4)));
typedef unsigned u32x2 __attribute__((ext_vector_type(2)));

constexpr int MP = 32768, MS = 512, MT = MP + MS;
constexpr int DM = 1024, DFF = 2816;
constexpr int KVR = MP + 8 * 2112;
constexpr float EPS = 1e-6f;
constexpr float QSCALE = 0.10206207261596577f * 1.4426950408889634f;
constexpr size_t OFF_CKVP = 34078720, OFF_KRP = 42467328, OFF_CKVS = 43515904, OFF_KRS = 43646976, OFF_VS = 43663360;

constexpr size_t MiB = 1u << 20;
constexpr size_t WS_MOD = 0, WS_ROPE = 512 * 1024, WS_SSQ = 1 * MiB, WS_WM = 3 * MiB, WS_WIN = 4 * MiB, WS_WUQ = 8 * MiB, WS_WUKV = 9 * MiB,
                 WS_WOUT = 10 * MiB, WS_WFI = 12 * MiB, WS_WFO = 23 * MiB, WS_H = 29 * MiB, WS_YAB = 94 * MiB, WS_G = 159 * MiB,
                 WS_U = 159 * MiB, WS_VT = 192 * MiB, WS_CQ = 225 * MiB, WS_CKV = 250 * MiB, WS_KR = 275 * MiB, WS_KN = 279 * MiB,
                 WS_VVT = 328 * MiB, WS_Q = 377 * MiB, WS_END = 450 * MiB, WS_CTR = 3 * MiB - 4096, WS_BAR = 3 * MiB - 32768, WS_PART = 426 * MiB, WS_X1B = 345 * MiB;

constexpr int LDS_BYTES = 147456;
constexpr int LDS_X = 131072;

__device__ __forceinline__ unsigned cvt_pk_bf16(float lo, float hi) { unsigned r; asm("v_cvt_pk_bf16_f32 %0, %1, %2" : "=v"(r) : "v"(lo), "v"(hi)); return r; }
__device__ __forceinline__ float bf2f(unsigned short h) { return __uint_as_float(((unsigned)h) << 16); }
__device__ __forceinline__ float gelu_tanh(float x) {
    const float y2 = 1.5957691216057308f * x * (1.f + 0.044715f * x * x);
    const float e = __builtin_amdgcn_exp2f(-y2 * 1.4426950408889634f);
    return x * __builtin_amdgcn_rcpf(1.f + e);
}
__device__ __forceinline__ float silu_f(float x) { const float e = __builtin_amdgcn_exp2f(-x * 1.4426950408889634f); return x * __builtin_amdgcn_rcpf(1.f + e); }
__device__ __forceinline__ float wave_sum(float v) {
#pragma unroll
    for (int o = 1; o < 64; o <<= 1) v += __shfl_xor(v, o);
    return v;
}
typedef float f32x2 __attribute__((ext_vector_type(2)));
__device__ __forceinline__ float max3f(float a, float b, float c) { float r; asm("v_max3_f32 %0, %1, %2, %3" : "=v"(r) : "v"(a), "v"(b), "v"(c)); return r; }
#define LDS_WAIT() asm volatile("s_waitcnt lgkmcnt(0)" ::: "memory")
__device__ __forceinline__ int fresh_tid() { int t = threadIdx.x; asm volatile("" : "+v"(t)); return t; }

namespace pg8 {
constexpr int BM = 256, BK = 64, HALF = 128, HTB = HALF * BK * 2, STAGE_BYTES = 8 * HTB, NXCD = 8, WGM = 8;
__host__ __device__ __forceinline__ int lds_byte(int r, int c) { const int st = (r >> 4) * 2 + (c >> 5), rr = r & 15, cc = c & 31, ob = rr * 64 + cc * 2; return st * 1024 + (ob ^ (((ob >> 9) & 1) << 5)); }
__host__ __device__ __forceinline__ void stage_rc(int b, int& R, int& C) { const int st = b / 1024, sb = b % 1024, swz = sb ^ (((sb >> 9) & 1) << 5); R = (st >> 1) * 16 + swz / 64; C = (st & 1) * 32 + (swz % 64) / 2; }
__host__ __device__ __forceinline__ int perm32(int rho) { const int n = rho >> 4, i = rho & 15; return 8 * (i >> 2) + 4 * n + (i & 3); }

struct Unit { int pm, pn, kind; };
__device__ __forceinline__ int xcd_map(int L, int nwg) { const int q = nwg / NXCD, r = nwg % NXCD, xcd = L % NXCD, off = L / NXCD; return (xcd < r ? xcd * (q + 1) : r * (q + 1) + (xcd - r) * q) + off; }
__device__ __forceinline__ void grouped(int wgid, int nM, int nN, int& pm, int& pn) {
    const int nig = WGM * nN, gid = wgid / nig, fm = gid * WGM, gsz = (nM - fm) < WGM ? (nM - fm) : WGM;
    pm = fm + ((wgid % nig) % gsz); pn = (wgid % nig) / gsz;
}
template <class Prog>
__device__ __forceinline__ void gemm_phase(LAS unsigned char* lds, const Prog& P) {
    const int tid = fresh_tid(), wid = __builtin_amdgcn_readfirstlane(tid >> 6), lane = tid & 63, wr = wid >> 2, wc = wid & 3, fr = lane & 15, fq = lane >> 4;
    const int lda = P.lda, ldb = P.ldb;
    unsigned voffA[2], voffB[2];
#pragma unroll
    for (int i = 0; i < 2; ++i) { int R, C; stage_rc(tid * 16 + i * 8192, R, C); const int Rb = (R & ~31) + perm32(R & 31);
        voffA[i] = (unsigned)(R * lda + C) * 2u; voffB[i] = (unsigned)(Rb * ldb + C) * 2u; }
    const size_t kstep = (size_t)(BK * 2);
    const size_t hstepA = (size_t)HALF * lda * 2, hstepB = (size_t)HALF * ldb * 2;
    const unsigned ldsw = (unsigned)wid * 1024u;
    const int aoff = lds_byte(wr * 64 + fr, fq * 8), boff = lds_byte(wc * 32 + fr, fq * 8);
#define PG8_SA(b, h) (((b) * 2 + (h)) * HTB)
#define PG8_SB(b, h) ((4 + (b) * 2 + (h)) * HTB)
#define PG8_STAGE(bufoff, gbase, voff) do { _Pragma("unroll") for (int _i = 0; _i < 2; ++_i) \
        __builtin_amdgcn_global_load_lds((const unsigned*)((const char*)(gbase) + (voff)[_i]), (LAS unsigned*)(lds + (bufoff) + ldsw + _i * 8192), 16, 0, 0); } while (0)
#define PG8_LDA(dst, b, h) do { _Pragma("unroll") for (int m = 0; m < 4; ++m) _Pragma("unroll") for (int k = 0; k < 2; ++k) dst[m][k] = *(const LAS bf16x8*)(lds + PG8_SA(b, h) + aoff + m * 2048 + k * 1024); } while (0)
#define PG8_LDB(dst, b, h) do { _Pragma("unroll") for (int n = 0; n < 2; ++n) _Pragma("unroll") for (int k = 0; k < 2; ++k) dst[n][k] = *(const LAS bf16x8*)(lds + PG8_SB(b, h) + boff + n * 2048 + k * 1024); } while (0)
#define PG8_MMA(ai, bj, At, Bt) do { __builtin_amdgcn_s_setprio(1); _Pragma("unroll") for (int m = 0; m < 4; ++m) _Pragma("unroll") for (int n = 0; n < 2; ++n) _Pragma("unroll") for (int k = 0; k < 2; ++k) \
        acc[ai][bj][m][n] = __builtin_amdgcn_mfma_f32_16x16x32_bf16(Bt[n][k], At[m][k], acc[ai][bj][m][n], 0, 0, 0); __builtin_amdgcn_s_setprio(0); } while (0)
#define PG8_WAIT_V(n) asm volatile("s_waitcnt vmcnt(" #n ")" ::: "memory")
#define PG8_WAIT_L(n) asm volatile("s_waitcnt lgkmcnt(" #n ")" ::: "memory")
#define PG8_BAR __builtin_amdgcn_s_barrier()
#define PG8_SCHED __builtin_amdgcn_sched_barrier(0)
    Unit cur, nxt; int ui = 0;
    if (!P.next(0, cur)) return;
    f32x4 acc[2][2][4][2];
#pragma unroll
    for (int a = 0; a < 2; ++a)
#pragma unroll
        for (int b = 0; b < 2; ++b)
#pragma unroll
            for (int m = 0; m < 4; ++m)
#pragma unroll
                for (int n = 0; n < 2; ++n) acc[a][b][m][n] = (f32x4){0.f, 0.f, 0.f, 0.f};
    bf16x8 At[4][2], B0[2][2], B1[2][2];
    const char* cA = P.aptr(cur); const char* cB = P.bptr(cur);
    PG8_STAGE(PG8_SB(0, 0), cB, voffB); PG8_STAGE(PG8_SB(0, 1), cB + hstepB, voffB); PG8_STAGE(PG8_SA(0, 0), cA, voffA); PG8_STAGE(PG8_SA(0, 1), cA + hstepA, voffA);
    if (wr == 1) PG8_BAR;
    PG8_WAIT_V(2); PG8_BAR;
    PG8_STAGE(PG8_SB(1, 0), cB + kstep, voffB); PG8_STAGE(PG8_SA(1, 0), cA + kstep, voffA); PG8_STAGE(PG8_SB(1, 1), cB + hstepB + kstep, voffB);
    PG8_WAIT_V(6); PG8_BAR;
    for (;;) {
        const bool has_next = P.next(ui + 1, nxt);
        const int nt = P.nt(cur);
        const char* nA = has_next ? P.aptr(nxt) : cA; const char* nB = has_next ? P.bptr(nxt) : cB;
        for (int t = 0; t < nt; t += 2) {
            const bool last = (t == nt - 2);
            const char* a1 = cA + (size_t)(t + 1) * kstep;
            const char* a2 = last ? nA : cA + (size_t)(t + 2) * kstep; const char* b2 = last ? nB : cB + (size_t)(t + 2) * kstep;
            const char* a3 = a2 + kstep; const char* b3 = b2 + kstep;
            PG8_LDB(B0, 0, 0); PG8_LDB(B1, 0, 1); PG8_SCHED; PG8_LDA(At, 0, 0); PG8_STAGE(PG8_SA(1, 1), a1 + hstepA, voffA);
            PG8_WAIT_V(8); PG8_WAIT_L(0); PG8_BAR; PG8_MMA(0, 0, At, B0); PG8_MMA(0, 1, At, B1); PG8_BAR; PG8_SCHED;
            PG8_LDA(At, 0, 1); PG8_STAGE(PG8_SB(0, 0), b2, voffB); PG8_STAGE(PG8_SB(0, 1), b2 + hstepB, voffB); PG8_STAGE(PG8_SA(0, 0), a2, voffA);
            PG8_WAIT_V(8); PG8_WAIT_L(0); PG8_BAR; PG8_MMA(1, 0, At, B0); PG8_MMA(1, 1, At, B1); PG8_BAR; PG8_SCHED;
            PG8_LDB(B0, 1, 0); PG8_LDB(B1, 1, 1); PG8_SCHED; PG8_LDA(At, 1, 0); PG8_STAGE(PG8_SA(0, 1), a2 + hstepA, voffA);
            PG8_WAIT_V(8); PG8_WAIT_L(0); PG8_BAR; PG8_MMA(0, 0, At, B0); PG8_MMA(0, 1, At, B1); PG8_BAR; PG8_SCHED;
            PG8_LDA(At, 1, 1); PG8_STAGE(PG8_SB(1, 0), b3, voffB); PG8_STAGE(PG8_SB(1, 1), b3 + hstepB, voffB); PG8_STAGE(PG8_SA(1, 0), a3, voffA);
            PG8_WAIT_V(8); PG8_WAIT_L(0); PG8_BAR; PG8_MMA(1, 0, At, B0); PG8_MMA(1, 1, At, B1); PG8_BAR; PG8_SCHED;
        }
        if (wr == 0) PG8_BAR;
        P.epi(acc, cur, wr, wc, fr, fq);
        if (!has_next) break;
#pragma unroll
        for (int a = 0; a < 2; ++a)
#pragma unroll
            for (int b = 0; b < 2; ++b)
#pragma unroll
                for (int m = 0; m < 4; ++m)
#pragma unroll
                    for (int n = 0; n < 2; ++n) acc[a][b][m][n] = (f32x4){0.f, 0.f, 0.f, 0.f};
        cur = nxt; cA = nA; cB = nB; ++ui;
        if (wr == 1) PG8_BAR;
    }
    PG8_WAIT_V(0);
    PG8_BAR;
#undef PG8_SA
#undef PG8_SB
#undef PG8_STAGE
#undef PG8_LDA
#undef PG8_LDB
#undef PG8_MMA
#undef PG8_WAIT_V
#undef PG8_WAIT_L
#undef PG8_SCHED
}
}
using pg8::Unit;
typedef f32x4 Acc[2][2][4][2];

struct Args {
    const float* in[24];
    float* out;
    unsigned char* ws;
};

struct ProgIn {
    int K, lda, ldb, G, c;
    const bf16_t* H; const bf16_t* Wt;
    bf16_t *U, *Vt, *CQ, *CKV, *KR; float* SSQ; float* out; const float* rope; const float *kvg, *krg;
    LAS float* xl;
    static constexpr int NM = 130, NMAIN = 130 * 5, NSW = 2 * 130, NTOT = NMAIN + NSW;
    __device__ __forceinline__ bool next(int i, Unit& u) const {
        const int L = i * G + c; if (L >= NTOT) return false;
        const int w = pg8::xcd_map(L, NTOT);
        if (w < NMAIN) { pg8::grouped(w, NM, 5, u.pm, u.pn); u.kind = u.pn < 2 ? 0 : (u.pn == 2 ? 1 : 2); }
        else { pg8::grouped(w - NMAIN, 2, NM, u.pm, u.pn); u.kind = 3; }
        return true;
    }
    __device__ __forceinline__ int nt(const Unit&) const { return K / 64; }
    __device__ __forceinline__ const char* aptr(const Unit& u) const { return u.kind < 3 ? (const char*)(H + (size_t)u.pm * 256 * DM) : (const char*)(Wt + (size_t)(1280 + u.pm * 256) * DM); }
    __device__ __forceinline__ const char* bptr(const Unit& u) const { return u.kind < 3 ? (const char*)(Wt + (size_t)u.pn * 256 * DM) : (const char*)(H + (size_t)u.pn * 256 * DM); }
    __device__ __forceinline__ void epi(Acc& acc, const Unit& u, int wr, int wc, int fr, int fq) const {
        asm volatile("" : "+v"(fr), "+v"(fq));
        const int rl0 = wr * 64 + fr;
        if (u.kind == 0) {
#pragma unroll
            for (int ai = 0; ai < 2; ++ai)
#pragma unroll
                for (int m = 0; m < 4; ++m) { const size_t row = (size_t)u.pm * 256 + ai * 128 + rl0 + m * 16;
#pragma unroll
                    for (int bj = 0; bj < 2; ++bj) { const f32x4 v0 = acc[ai][bj][m][0], v1 = acc[ai][bj][m][1]; u32x4 w;
                        w.x = cvt_pk_bf16(gelu_tanh(v0[0]), gelu_tanh(v0[1])); w.y = cvt_pk_bf16(gelu_tanh(v0[2]), gelu_tanh(v0[3]));
                        w.z = cvt_pk_bf16(gelu_tanh(v1[0]), gelu_tanh(v1[1])); w.w = cvt_pk_bf16(gelu_tanh(v1[2]), gelu_tanh(v1[3]));
                        *(u32x4*)(U + row * 512 + u.pn * 256 + bj * 128 + wc * 32 + fq * 8) = w; } }
        } else if (u.kind == 3) {
            const bool samp = u.pn >= 128;
#pragma unroll
            for (int ai = 0; ai < 2; ++ai)
#pragma unroll
                for (int m = 0; m < 4; ++m) { const int ch = u.pm * 256 + ai * 128 + rl0 + m * 16;
#pragma unroll
                    for (int bj = 0; bj < 2; ++bj) { const f32x4 v0 = acc[ai][bj][m][0], v1 = acc[ai][bj][m][1];
                        float g[8] = {gelu_tanh(v0[0]), gelu_tanh(v0[1]), gelu_tanh(v0[2]), gelu_tanh(v0[3]), gelu_tanh(v1[0]), gelu_tanh(v1[1]), gelu_tanh(v1[2]), gelu_tanh(v1[3])};
                        u32x4 w; w.x = cvt_pk_bf16(g[0], g[1]); w.y = cvt_pk_bf16(g[2], g[3]); w.z = cvt_pk_bf16(g[4], g[5]); w.w = cvt_pk_bf16(g[6], g[7]);
                        const int tok = u.pn * 256 + bj * 128 + wc * 32 + fq * 8;
                        *(u32x4*)(Vt + (size_t)ch * MT + tok) = w;
                        if (samp) {
#pragma unroll
                            for (int e = 0; e < 8; ++e) out[OFF_VS + (size_t)(tok - MP + e) * 512 + ch] = g[e]; } } }
        } else if (u.kind == 1) {
#pragma unroll
            for (int ai = 0; ai < 2; ++ai)
#pragma unroll
                for (int m = 0; m < 4; ++m) { float s = 0.f;
#pragma unroll
                    for (int bj = 0; bj < 2; ++bj)
#pragma unroll
                        for (int n = 0; n < 2; ++n) { const f32x4 x = acc[ai][bj][m][n]; s += (x[0] * x[0] + x[1] * x[1]) + (x[2] * x[2] + x[3] * x[3]); }
                    s += __shfl_xor(s, 16); s += __shfl_xor(s, 32);
                    if (fq == 0) xl[(ai * 128 + rl0 + m * 16) * 4 + wc] = s; }
            LDS_WAIT(); __builtin_amdgcn_s_barrier(); asm volatile("" ::: "memory");
            f32x4 gv[2][2];
#pragma unroll
            for (int bj = 0; bj < 2; ++bj)
#pragma unroll
                for (int n = 0; n < 2; ++n) gv[bj][n] = *(const f32x4*)(kvg + bj * 128 + wc * 32 + fq * 8 + n * 4);
#pragma unroll
            for (int ai = 0; ai < 2; ++ai)
#pragma unroll
                for (int m = 0; m < 4; ++m) { const int rl = ai * 128 + rl0 + m * 16; const f32x4 p = *(const LAS f32x4*)(xl + rl * 4);
                    const float rstd = rsqrtf(((p[0] + p[1]) + (p[2] + p[3])) * (1.f / 256.f) + EPS);
                    const int row = u.pm * 256 + rl; size_t kvrow; float* o;
                    if (row < MP) { kvrow = row; o = out + OFF_CKVP + (size_t)row * 256; }
                    else { const int s = row - MP, b = s >> 6, t = s & 63; kvrow = (size_t)MP + b * 2112 + 2048 + t; o = out + OFF_CKVS + (size_t)s * 256; }
#pragma unroll
                    for (int bj = 0; bj < 2; ++bj) { const f32x4 v0 = acc[ai][bj][m][0] * rstd * gv[bj][0], v1 = acc[ai][bj][m][1] * rstd * gv[bj][1];
                        const int col = bj * 128 + wc * 32 + fq * 8;
                        __builtin_nontemporal_store(v0, (f32x4*)(o + col)); __builtin_nontemporal_store(v1, (f32x4*)(o + col + 4));
                        u32x4 w; w.x = cvt_pk_bf16(v0[0], v0[1]); w.y = cvt_pk_bf16(v0[2], v0[3]); w.z = cvt_pk_bf16(v1[0], v1[1]); w.w = cvt_pk_bf16(v1[2], v1[3]);
                        *(u32x4*)(CKV + kvrow * 256 + col) = w; } }
            LDS_WAIT(); __builtin_amdgcn_s_barrier(); asm volatile("" ::: "memory");
        } else {
            const int t2 = u.pn - 3;
#pragma unroll
            for (int ai = 0; ai < 2; ++ai)
#pragma unroll
                for (int m = 0; m < 4; ++m) { const int row = u.pm * 256 + ai * 128 + rl0 + m * 16; float s = 0.f;
#pragma unroll
                    for (int bj = 0; bj < 2; ++bj) { if (t2 == 1 && bj == 1) continue;
                        const f32x4 v0 = acc[ai][bj][m][0], v1 = acc[ai][bj][m][1];
                        s += (v0[0] * v0[0] + v0[1] * v0[1]) + (v0[2] * v0[2] + v0[3] * v0[3]) + (v1[0] * v1[0] + v1[1] * v1[1]) + (v1[2] * v1[2] + v1[3] * v1[3]);
                        u32x4 w; w.x = cvt_pk_bf16(v0[0], v0[1]); w.y = cvt_pk_bf16(v0[2], v0[3]); w.z = cvt_pk_bf16(v1[0], v1[1]); w.w = cvt_pk_bf16(v1[2], v1[3]);
                        *(u32x4*)(CQ + (size_t)row * 384 + t2 * 256 + bj * 128 + wc * 32 + fq * 8) = w; }
                    s += __shfl_xor(s, 16); s += __shfl_xor(s, 32);
                    if (fq == 0) SSQ[(size_t)row * 8 + t2 * 4 + wc] = s; }
            if (t2 == 1 && wc == 0) {
                const f32x4 g0 = *(const f32x4*)(krg + fq * 8), g1 = *(const f32x4*)(krg + fq * 8 + 4);
#pragma unroll
                for (int ai = 0; ai < 2; ++ai)
#pragma unroll
                    for (int m = 0; m < 4; ++m) { const int row = u.pm * 256 + ai * 128 + rl0 + m * 16;
                        f32x4 v0 = acc[ai][1][m][0], v1 = acc[ai][1][m][1];
                        float s = (v0[0] * v0[0] + v0[1] * v0[1]) + (v0[2] * v0[2] + v0[3] * v0[3]) + (v1[0] * v1[0] + v1[1] * v1[1]) + (v1[2] * v1[2] + v1[3] * v1[3]);
                        s += __shfl_xor(s, 16); s += __shfl_xor(s, 32);
                        const float rstd = rsqrtf(s * (1.f / 32.f) + EPS);
                        v0 = v0 * rstd * g0; v1 = v1 * rstd * g1;
                        int pos; size_t kvrow; float* o;
                        if (row < MP) { pos = row & 4095; kvrow = row; o = out + OFF_KRP + (size_t)row * 32; }
                        else { const int sr = row - MP, b = sr >> 6, t = sr & 63; pos = 2048 + t; kvrow = (size_t)MP + b * 2112 + 2048 + t; o = out + OFF_KRS + (size_t)sr * 32; }
                        const float* rp = rope + (size_t)pos * 32 + (fq & 1) * 8;
                        const f32x4 c0 = *(const f32x4*)rp, c1 = *(const f32x4*)(rp + 4), s0 = *(const f32x4*)(rp + 16), s1 = *(const f32x4*)(rp + 20);
                        f32x4 p0, p1;
#pragma unroll
                        for (int e = 0; e < 4; ++e) { p0[e] = __shfl_xor(v0[e], 32); p1[e] = __shfl_xor(v1[e], 32); }
                        const float sg = fq < 2 ? -1.f : 1.f;
                        const f32x4 r0 = v0 * c0 + p0 * s0 * sg, r1 = v1 * c1 + p1 * s1 * sg;
                        __builtin_nontemporal_store(r0, (f32x4*)(o + fq * 8)); __builtin_nontemporal_store(r1, (f32x4*)(o + fq * 8 + 4));
                        u32x4 w; w.x = cvt_pk_bf16(r0[0], r0[1]); w.y = cvt_pk_bf16(r0[2], r0[3]); w.z = cvt_pk_bf16(r1[0], r1[1]); w.w = cvt_pk_bf16(r1[2], r1[3]);
                        *(u32x4*)(KR + kvrow * 32 + fq * 8) = w; }
            }
        }
    }
};

struct ProgQ {
    int K, lda, ldb, G, c;
    const bf16_t* CQ; const bf16_t* Wt; const float* SSQ; bf16_t* Q; const float* rope; const float *qng, *qrg;
    static constexpr int NM = 130, NTOT = 130 * 3;
    __device__ __forceinline__ bool next(int i, Unit& u) const { const int L = i * G + c; if (L >= NTOT) return false; pg8::grouped(pg8::xcd_map(L, NTOT), NM, 3, u.pm, u.pn); u.kind = 0; return true; }
    __device__ __forceinline__ int nt(const Unit&) const { return K / 64; }
    __device__ __forceinline__ const char* aptr(const Unit& u) const { return (const char*)(CQ + (size_t)u.pm * 256 * 384); }
    __device__ __forceinline__ const char* bptr(const Unit& u) const { return (const char*)(Wt + (size_t)u.pn * 256 * 384); }
    __device__ __forceinline__ void epi(Acc& acc, const Unit& u, int wr, int wc, int fr, int fq) const {
        asm volatile("" : "+v"(fr), "+v"(fq));
        const int rl0 = wr * 64 + fr;
#pragma unroll
        for (int ai = 0; ai < 2; ++ai)
#pragma unroll
            for (int m = 0; m < 4; ++m) { const int row = u.pm * 256 + ai * 128 + rl0 + m * 16;
                const f32x4 q0 = *(const f32x4*)(SSQ + (size_t)row * 8), q1 = *(const f32x4*)(SSQ + (size_t)row * 8 + 4);
                const float rq = rsqrtf((((q0[0] + q0[1]) + (q0[2] + q0[3])) + ((q1[0] + q1[1]) + (q1[2] + q1[3]))) * (1.f / 384.f) + EPS);
                if (u.pn < 2) {
                    const int head = u.pn * 4 + wc; float s = 0.f; f32x4 v[2][2];
#pragma unroll
                    for (int bj = 0; bj < 2; ++bj)
#pragma unroll
                        for (int n = 0; n < 2; ++n) { v[bj][n] = acc[ai][bj][m][n] * rq; const f32x4 x = v[bj][n]; s += (x[0] * x[0] + x[1] * x[1]) + (x[2] * x[2] + x[3] * x[3]); }
                    s += __shfl_xor(s, 16); s += __shfl_xor(s, 32);
                    const float r2 = rsqrtf(s * (1.f / 64.f) + EPS) * QSCALE;
#pragma unroll
                    for (int bj = 0; bj < 2; ++bj) { const f32x4 g0 = *(const f32x4*)(qng + bj * 32 + fq * 8), g1 = *(const f32x4*)(qng + bj * 32 + fq * 8 + 4);
                        const f32x4 a = v[bj][0] * r2 * g0, b = v[bj][1] * r2 * g1;
                        u32x4 w; w.x = cvt_pk_bf16(a[0], a[1]); w.y = cvt_pk_bf16(a[2], a[3]); w.z = cvt_pk_bf16(b[0], b[1]); w.w = cvt_pk_bf16(b[2], b[3]);
                        *(u32x4*)(Q + (size_t)row * 768 + head * 96 + bj * 32 + fq * 8) = w; }
                } else {
                    const int pos = row < MP ? (row & 4095) : 2048 + ((row - MP) & 63);
                    const float* rp = rope + (size_t)pos * 32 + (fq & 1) * 8;
                    const f32x4 c0 = *(const f32x4*)rp, c1 = *(const f32x4*)(rp + 4), s0 = *(const f32x4*)(rp + 16), s1 = *(const f32x4*)(rp + 20);
                    const f32x4 g0 = *(const f32x4*)(qrg + fq * 8), g1 = *(const f32x4*)(qrg + fq * 8 + 4);
                    const float sg = fq < 2 ? -1.f : 1.f;
#pragma unroll
                    for (int bj = 0; bj < 2; ++bj) { const int head = bj * 4 + wc;
                        f32x4 v0 = acc[ai][bj][m][0] * rq, v1 = acc[ai][bj][m][1] * rq;
                        float s = (v0[0] * v0[0] + v0[1] * v0[1]) + (v0[2] * v0[2] + v0[3] * v0[3]) + (v1[0] * v1[0] + v1[1] * v1[1]) + (v1[2] * v1[2] + v1[3] * v1[3]);
                        s += __shfl_xor(s, 16); s += __shfl_xor(s, 32);
                        const float r2 = rsqrtf(s * (1.f / 32.f) + EPS);
                        v0 = v0 * r2 * g0; v1 = v1 * r2 * g1;
                        f32x4 p0, p1;
#pragma unroll
                        for (int e = 0; e < 4; ++e) { p0[e] = __shfl_xor(v0[e], 32); p1[e] = __shfl_xor(v1[e], 32); }
                        const f32x4 r0 = (v0 * c0 + p0 * s0 * sg) * QSCALE, r1 = (v1 * c1 + p1 * s1 * sg) * QSCALE;
                        u32x4 w; w.x = cvt_pk_bf16(r0[0], r0[1]); w.y = cvt_pk_bf16(r0[2], r0[3]); w.z = cvt_pk_bf16(r1[0], r1[1]); w.w = cvt_pk_bf16(r1[2], r1[3]);
                        *(u32x4*)(Q + (size_t)row * 768 + head * 96 + 64 + fq * 8) = w; }
                } }
    }
};

struct ProgKV {
    int K, lda, ldb, G, c;
    const bf16_t* CKV; const bf16_t* Wt; bf16_t *KN, *VVt; const float* kng;
    static constexpr int NM = 194, NA = 194 * 2, NTOT = 194 * 4;
    __device__ __forceinline__ bool next(int i, Unit& u) const {
        const int L = i * G + c; if (L >= NTOT) return false;
        const int w = pg8::xcd_map(L, NTOT);
        if (w < NA) { pg8::grouped(w, NM, 2, u.pm, u.pn); u.kind = 0; } else { pg8::grouped(w - NA, 2, NM, u.pm, u.pn); u.kind = 1; }
        return true;
    }
    __device__ __forceinline__ int nt(const Unit&) const { return K / 64; }
    __device__ __forceinline__ const char* aptr(const Unit& u) const { return u.kind == 0 ? (const char*)(CKV + (size_t)u.pm * 256 * 256) : (const char*)(Wt + (size_t)(512 + u.pm * 256) * 256); }
    __device__ __forceinline__ const char* bptr(const Unit& u) const { return u.kind == 0 ? (const char*)(Wt + (size_t)u.pn * 256 * 256) : (const char*)(CKV + (size_t)u.pn * 256 * 256); }
    __device__ __forceinline__ void epi(Acc& acc, const Unit& u, int wr, int wc, int fr, int fq) const {
        asm volatile("" : "+v"(fr), "+v"(fq));
        const int rl0 = wr * 64 + fr;
#pragma unroll
        for (int ai = 0; ai < 2; ++ai)
#pragma unroll
            for (int m = 0; m < 4; ++m) { const size_t row = (size_t)u.pm * 256 + ai * 128 + rl0 + m * 16;
                if (u.kind == 0) {
                    const int head = u.pn * 4 + wc; float s = 0.f;
#pragma unroll
                    for (int bj = 0; bj < 2; ++bj)
#pragma unroll
                        for (int n = 0; n < 2; ++n) { const f32x4 x = acc[ai][bj][m][n]; s += (x[0] * x[0] + x[1] * x[1]) + (x[2] * x[2] + x[3] * x[3]); }
                    s += __shfl_xor(s, 16); s += __shfl_xor(s, 32);
                    const float r2 = rsqrtf(s * (1.f / 64.f) + EPS);
#pragma unroll
                    for (int bj = 0; bj < 2; ++bj) { const f32x4 g0 = *(const f32x4*)(kng + bj * 32 + fq * 8), g1 = *(const f32x4*)(kng + bj * 32 + fq * 8 + 4);
                        const f32x4 a = acc[ai][bj][m][0] * r2 * g0, b = acc[ai][bj][m][1] * r2 * g1;
                        u32x4 w; w.x = cvt_pk_bf16(a[0], a[1]); w.y = cvt_pk_bf16(a[2], a[3]); w.z = cvt_pk_bf16(b[0], b[1]); w.w = cvt_pk_bf16(b[2], b[3]);
                        *(u32x4*)(KN + row * 512 + head * 64 + bj * 32 + fq * 8) = w; }
                } else {
#pragma unroll
                    for (int bj = 0; bj < 2; ++bj) { const f32x4 a = acc[ai][bj][m][0], b = acc[ai][bj][m][1];
                        u32x4 w; w.x = cvt_pk_bf16(a[0], a[1]); w.y = cvt_pk_bf16(a[2], a[3]); w.z = cvt_pk_bf16(b[0], b[1]); w.w = cvt_pk_bf16(b[2], b[3]);
                        *(u32x4*)(VVt + row * KVR + (size_t)u.pn * 256 + bj * 128 + wc * 32 + fq * 8) = w; }
                } }
    }
};

template <int MODE>
struct ProgRes {
    int K, lda, ldb, G, c, nsk;
    const bf16_t* Ab; const bf16_t* Wt; const float* xp; float* Y; bf16_t* X1; const float* gate; float* part;
    __device__ __forceinline__ bool next(int i, Unit& u) const {
        const int L = i * G + c; if (L >= 512 + 8 * nsk) return false;
        int pm, pn; pg8::grouped(pg8::xcd_map(L < 512 ? L : 0, 512), 128, 4, pm, pn);
        const int idx = L - 512, rem = idx & 7; const bool sp = L >= 512;
        u.pm = sp ? 128 + (rem >> 2) : pm; u.pn = sp ? (rem & 3) : pn; u.kind = sp ? 1 + (idx >> 3) : 0;
        return true;
    }
    __device__ __forceinline__ int nt(const Unit& u) const { return u.kind == 0 ? K / 64 : 4; }
    __device__ __forceinline__ const char* aptr(const Unit& u) const { return (const char*)(Ab + (size_t)u.pm * 256 * K + (u.kind ? (u.kind - 1) * 256 : 0)); }
    __device__ __forceinline__ const char* bptr(const Unit& u) const { return (const char*)(Wt + (size_t)u.pn * 256 * K + (u.kind ? (u.kind - 1) * 256 : 0)); }
    __device__ __forceinline__ void epi(Acc& acc, const Unit& u, int wr, int wc, int fr, int fq) const {
        asm volatile("" : "+v"(fr), "+v"(fq));
        const int rl0 = wr * 64 + fr;
        if (u.kind == 0) {
            const int b16 = u.pm >> 4;
#pragma unroll
            for (int ai = 0; ai < 2; ++ai) {
                f32x4 gv[2][2];
#pragma unroll
                for (int bj = 0; bj < 2; ++bj)
#pragma unroll
                    for (int n = 0; n < 2; ++n) gv[bj][n] = *(const f32x4*)(gate + (size_t)b16 * 6144 + u.pn * 256 + bj * 128 + wc * 32 + fq * 8 + n * 4);
#pragma unroll
                for (int m = 0; m < 4; ++m) { const int row = u.pm * 256 + ai * 128 + rl0 + m * 16;
#pragma unroll
                    for (int bj = 0; bj < 2; ++bj) { const int col = u.pn * 256 + bj * 128 + wc * 32 + fq * 8;
                        if constexpr (MODE == 0) {
                            const float* bp = xp + (size_t)row * DM;
                            const f32x4 r0 = *(const f32x4*)(bp + col) + gv[bj][0] * acc[ai][bj][m][0], r1 = *(const f32x4*)(bp + col + 4) + gv[bj][1] * acc[ai][bj][m][1];
                            u32x4 w; w.x = cvt_pk_bf16(r0[0], r0[1]); w.y = cvt_pk_bf16(r0[2], r0[3]); w.z = cvt_pk_bf16(r1[0], r1[1]); w.w = cvt_pk_bf16(r1[2], r1[3]);
                            *(u32x4*)(X1 + (size_t)row * DM + col) = w;
                        } else {
                            const u32x4 w = *(const u32x4*)(X1 + (size_t)row * DM + col);
                            const f32x4 b0 = (f32x4){__uint_as_float(w.x << 16), __uint_as_float(w.x & 0xffff0000u), __uint_as_float(w.y << 16), __uint_as_float(w.y & 0xffff0000u)};
                            const f32x4 b1 = (f32x4){__uint_as_float(w.z << 16), __uint_as_float(w.z & 0xffff0000u), __uint_as_float(w.w << 16), __uint_as_float(w.w & 0xffff0000u)};
                            __builtin_nontemporal_store(b0 + gv[bj][0] * acc[ai][bj][m][0], (f32x4*)(Y + (size_t)row * DM + col));
                            __builtin_nontemporal_store(b1 + gv[bj][1] * acc[ai][bj][m][1], (f32x4*)(Y + (size_t)row * DM + col + 4));
                        } } }
            }
        } else {
            float* pb = part + (size_t)(u.kind - 1) * 512 * DM;
#pragma unroll
            for (int ai = 0; ai < 2; ++ai)
#pragma unroll
                for (int m = 0; m < 4; ++m) { const int srow = (u.pm - 128) * 256 + ai * 128 + rl0 + m * 16;
#pragma unroll
                    for (int bj = 0; bj < 2; ++bj) { const int col = u.pn * 256 + bj * 128 + wc * 32 + fq * 8;
                        *(f32x4*)(pb + (size_t)srow * DM + col) = acc[ai][bj][m][0];
                        *(f32x4*)(pb + (size_t)srow * DM + col + 4) = acc[ai][bj][m][1]; } }
        }
    }
};

struct ProgFfn {
    int K, lda, ldb, G, c;
    const bf16_t* Ab; const bf16_t* Wt; bf16_t* Gb;
    static constexpr int NM = 130, NN = 22, NTOT = 130 * 22;
    __device__ __forceinline__ bool next(int i, Unit& u) const { const int L = i * G + c; if (L >= NTOT) return false; pg8::grouped(pg8::xcd_map(L, NTOT), NM, NN, u.pm, u.pn); u.kind = 0; return true; }
    __device__ __forceinline__ int nt(const Unit&) const { return K / 64; }
    __device__ __forceinline__ const char* aptr(const Unit& u) const { return (const char*)(Ab + (size_t)u.pm * 256 * DM); }
    __device__ __forceinline__ const char* bptr(const Unit& u) const { return (const char*)(Wt + (size_t)u.pn * 256 * DM); }
    __device__ __forceinline__ void epi(Acc& acc, const Unit& u, int wr, int wc, int fr, int fq) const {
        asm volatile("" : "+v"(fr), "+v"(fq));
        const int rl0 = wr * 64 + fr;
#pragma unroll
        for (int ai = 0; ai < 2; ++ai)
#pragma unroll
            for (int m = 0; m < 4; ++m) { const size_t row = (size_t)u.pm * 256 + ai * 128 + rl0 + m * 16;
                const f32x4 g0 = acc[ai][0][m][0], g1 = acc[ai][0][m][1], u0 = acc[ai][1][m][0], u1 = acc[ai][1][m][1];
                u32x4 w; w.x = cvt_pk_bf16(silu_f(g0[0]) * u0[0], silu_f(g0[1]) * u0[1]); w.y = cvt_pk_bf16(silu_f(g0[2]) * u0[2], silu_f(g0[3]) * u0[3]);
                w.z = cvt_pk_bf16(silu_f(g1[0]) * u1[0], silu_f(g1[1]) * u1[1]); w.w = cvt_pk_bf16(silu_f(g1[2]) * u1[2], silu_f(g1[3]) * u1[3]);
                *(u32x4*)(Gb + row * DFF + u.pn * 128 + wc * 32 + fq * 8) = w; }
    }
};

__device__ __forceinline__ void p0_transpose_item(const float* W, int ldw, int c0, int k0, bf16_t* WT, int K, int n0, const float* kscale, LAS float* scr, int lane) {
#pragma unroll
    for (int i = 0; i < 32; ++i) { const int kk = 2 * i + (lane >> 5); float v = 0.f;
        if (c0 >= 0) v = __builtin_nontemporal_load(W + (size_t)(k0 + kk) * ldw + c0 + (lane & 31));
        if (kscale) v *= kscale[k0 + kk];
        scr[kk * 33 + (lane & 31)] = v; }
    LDS_WAIT(); asm volatile("" ::: "memory");
    const int c = lane & 7;
#pragma unroll
    for (int j = 0; j < 4; ++j) { const int n = (lane >> 3) + 8 * j; const LAS float* s = scr + (8 * c) * 33 + n;
        u32x4 o; o.x = cvt_pk_bf16(s[0 * 33], s[1 * 33]); o.y = cvt_pk_bf16(s[2 * 33], s[3 * 33]); o.z = cvt_pk_bf16(s[4 * 33], s[5 * 33]); o.w = cvt_pk_bf16(s[6 * 33], s[7 * 33]);
        *(u32x4*)(WT + (size_t)(n0 + n) * K + k0 + 8 * c) = o; }
    LDS_WAIT(); asm volatile("" ::: "memory");
}
__device__ __forceinline__ void norm_load(const float* xrow, f32x4 (&v)[4], int lane) {
#pragma unroll
    for (int j = 0; j < 4; ++j) v[j] = __builtin_nontemporal_load((const f32x4*)xrow + lane + 64 * j);
}
__device__ __forceinline__ void norm_apply(const f32x4 (&v)[4], const float* g, const float* sc, const float* sh, bf16_t* orow, int lane) {
    float s = 0.f;
#pragma unroll
    for (int j = 0; j < 4; ++j) s += (v[j][0] * v[j][0] + v[j][1] * v[j][1]) + (v[j][2] * v[j][2] + v[j][3] * v[j][3]);
    const float rstd = rsqrtf(wave_sum(s) * (1.f / 1024.f) + EPS);
#pragma unroll
    for (int j = 0; j < 4; ++j) { const int c4 = lane + 64 * j;
        const f32x4 gg = *((const f32x4*)g + c4), cc = *((const f32x4*)sc + c4), hh = *((const f32x4*)sh + c4);
        const f32x4 h = v[j] * rstd * gg * (cc + 1.f) + hh;
        u32x2 w; w.x = cvt_pk_bf16(h[0], h[1]); w.y = cvt_pk_bf16(h[2], h[3]);
        *((u32x2*)orow + c4) = w; }
}
__device__ __forceinline__ void sample_combine(const float* gate, const float* part, int nsk, int srow, f32x4 (&v)[4], int lane) {
#pragma unroll
    for (int j = 0; j < 4; ++j) { const int c4 = lane + 64 * j; f32x4 a = (f32x4){0.f, 0.f, 0.f, 0.f};
        for (int k = 0; k < nsk; ++k) a += *((const f32x4*)(part + ((size_t)k * 512 + srow) * DM) + c4);
        v[j] = v[j] + *((const f32x4*)gate + c4) * a; }
}
__device__ __forceinline__ void row_load_bf16(const bf16_t* row, f32x4 (&v)[4], int lane) {
#pragma unroll
    for (int j = 0; j < 4; ++j) { const u32x2 w = __builtin_nontemporal_load((const u32x2*)row + lane + 64 * j);
        v[j] = (f32x4){__uint_as_float(w.x << 16), __uint_as_float(w.x & 0xffff0000u), __uint_as_float(w.y << 16), __uint_as_float(w.y & 0xffff0000u)}; }
}
__device__ __forceinline__ void row_store_bf16(bf16_t* row, const f32x4 (&v)[4], int lane) {
#pragma unroll
    for (int j = 0; j < 4; ++j) { u32x2 w; w.x = cvt_pk_bf16(v[j][0], v[j][1]); w.y = cvt_pk_bf16(v[j][2], v[j][3]); *((u32x2*)row + lane + 64 * j) = w; }
}

constexpr int GM_PITCH = 272;
__device__ __forceinline__ void gmlp_phase(LAS unsigned char* lds, int it0, int G, const bf16_t* Wm, const bf16_t* Vt, const bf16_t* U, const float* bs, bf16_t* YAB) {
    const int tid = fresh_tid(), lane = tid & 63, wid = __builtin_amdgcn_readfirstlane(tid >> 6), fr = lane & 15, fq = lane >> 4;
    constexpr int NIT = 1024 + 32;
    u32x4 st[4];
#define GM_LOAD(item) do { const bool samp_ = (item) >= 1024; const int g_ = (item) & 3; const int tok_ = samp_ ? MP + 64 * (((item) - 1024) >> 2) : 128 * ((item) >> 2); \
        _Pragma("unroll") for (int q = 0; q < 4; ++q) { const int c_ = tid + 512 * q, row_ = c_ >> 4, ch_ = c_ & 15; \
            if (!samp_ || ch_ < 8) st[q] = __builtin_nontemporal_load((const u32x4*)(Vt + (size_t)(128 * g_ + row_) * MT + tok_ + ch_ * 8)); else st[q] = (u32x4){0u, 0u, 0u, 0u}; } } while (0)
    int item = it0;
    if (item < NIT) GM_LOAD(item);
    for (; item < NIT; item += G) {
        const bool samp = item >= 1024; const int g = item & 3;
        const int tok0 = samp ? MP + 64 * ((item - 1024) >> 2) : 128 * (item >> 2);
        const bool active = !(samp && wid >= 4);
        const int nk = (samp || wid < 4) ? 2 : 4;
        const int row = tok0 + 16 * wid + fr;
        bf16x8 bfr[4]; u32x2 uu8[8]; float bias = 0.f;
        if (active) {
            const bf16_t* wrow = Wm + (size_t)(g * 128 + 16 * wid + fr) * 128 + 8 * fq;
#pragma unroll
            for (int kk = 0; kk < 4; ++kk) bfr[kk] = *(const bf16x8*)(wrow + 32 * kk);
#pragma unroll
            for (int n = 0; n < 8; ++n) uu8[n] = __builtin_nontemporal_load((const u32x2*)(U + (size_t)row * 512 + 128 * g + 16 * n + 4 * fq));
            bias = bs[g * 128 + 16 * wid + fr];
        }
#pragma unroll
        for (int q = 0; q < 4; ++q) { const int c = tid + 512 * q; *(LAS u32x4*)(lds + (c >> 4) * GM_PITCH + (c & 15) * 16) = st[q]; }
        __syncthreads();
        if (item + G < NIT) GM_LOAD(item + G);
        if (active) {
            f32x4 acc[8];
#pragma unroll
            for (int n = 0; n < 8; ++n) acc[n] = (f32x4){0.f, 0.f, 0.f, 0.f};
            const LAS unsigned char* ab = lds + fr * GM_PITCH + fq * 16;
#pragma unroll
            for (int kk = 0; kk < 4; ++kk) { if (kk < nk) {
#pragma unroll
                for (int n = 0; n < 8; ++n) { const bf16x8 afr = *(const LAS bf16x8*)(ab + (16 * n) * GM_PITCH + kk * 64);
                    acc[n] = __builtin_amdgcn_mfma_f32_16x16x32_bf16(afr, bfr[kk], acc[n], 0, 0, 0); } } }
#pragma unroll
            for (int n = 0; n < 8; ++n) { const int col = 128 * g + 16 * n + 4 * fq; const u32x2 uu = uu8[n];
                const float y0 = __uint_as_float(uu.x << 16) * (acc[n][0] + bias), y1 = __uint_as_float(uu.x & 0xffff0000u) * (acc[n][1] + bias);
                const float y2 = __uint_as_float(uu.y << 16) * (acc[n][2] + bias), y3 = __uint_as_float(uu.y & 0xffff0000u) * (acc[n][3] + bias);
                u32x2 w; w.x = cvt_pk_bf16(y0, y1); w.y = cvt_pk_bf16(y2, y3);
                *(u32x2*)(YAB + (size_t)row * DM + col) = w; }
        }
        __syncthreads();
    }
#undef GM_LOAD
}

constexpr int KPITCH = 208, VPITCH = 136, KBUF = 64 * KPITCH, VBUF = 64 * VPITCH, ATT_V0 = 2 * KBUF;
template <bool QK, bool SM>
__device__ __forceinline__ void attn_step(const LAS unsigned char* kb, const LAS unsigned char* vbp, const bf16x8 (&qr)[6],
                                          f32x16& s0, f32x16& s1, f32x16& o0, f32x16& o1, float& mrow, float& lsum) {
    f32x16 n0 = {}, n1 = {};
    if constexpr (QK) {
#pragma unroll
        for (int s = 0; s < 6; ++s) { const bf16x8 ka = *(const LAS bf16x8*)(kb + s * 32), kc = *(const LAS bf16x8*)(kb + 32 * KPITCH + s * 32);
            n0 = __builtin_amdgcn_mfma_f32_32x32x16_bf16(ka, qr[s], n0, 0, 0, 0); n1 = __builtin_amdgcn_mfma_f32_32x32x16_bf16(kc, qr[s], n1, 0, 0, 0); }
    }
    if constexpr (SM) {
        float mx = max3f(s0[0], s1[0], s0[1]); mx = max3f(mx, s1[1], s0[2]); float my = max3f(s1[2], s0[3], s1[3]);
#pragma unroll
        for (int r = 4; r < 16; r += 4) { mx = max3f(mx, s0[r], s1[r]); my = max3f(my, s0[r + 1], s1[r + 1]); mx = max3f(mx, s0[r + 2], s1[r + 2]); my = max3f(my, s0[r + 3], s1[r + 3]); }
        mx = fmaxf(mx, my);
        { const auto rr = __builtin_amdgcn_permlane32_swap(__float_as_uint(mx), __float_as_uint(mx), false, false); mx = fmaxf(__uint_as_float(rr[0]), __uint_as_float(rr[1])); }
        const float mnew = fmaxf(mrow, mx), alpha = __builtin_amdgcn_exp2f(mrow - mnew); mrow = mnew;
        const f32x2 m2 = (f32x2){mnew, mnew}; f32x2 ps2 = (f32x2){0.f, 0.f};
#pragma unroll
        for (int r = 0; r < 16; r += 2) { f32x2 a = (f32x2){s0[r], s0[r + 1]} - m2, b = (f32x2){s1[r], s1[r + 1]} - m2;
            a.x = __builtin_amdgcn_exp2f(a.x); a.y = __builtin_amdgcn_exp2f(a.y); b.x = __builtin_amdgcn_exp2f(b.x); b.y = __builtin_amdgcn_exp2f(b.y);
            s0[r] = a.x; s0[r + 1] = a.y; s1[r] = b.x; s1[r + 1] = b.y; ps2 += a + b; }
        const float ps = ps2.x + ps2.y;
        lsum = lsum * alpha + ps;
#pragma unroll
        for (int r = 0; r < 16; ++r) { o0[r] *= alpha; o1[r] *= alpha; }
        bf16x8 pb[4];
#pragma unroll
        for (int S = 0; S < 4; ++S) { u32x4 w;
            if (S < 2) { w.x = cvt_pk_bf16(s0[8 * S + 0], s0[8 * S + 1]); w.y = cvt_pk_bf16(s0[8 * S + 2], s0[8 * S + 3]); w.z = cvt_pk_bf16(s0[8 * S + 4], s0[8 * S + 5]); w.w = cvt_pk_bf16(s0[8 * S + 6], s0[8 * S + 7]); }
            else { w.x = cvt_pk_bf16(s1[8 * S - 16], s1[8 * S - 15]); w.y = cvt_pk_bf16(s1[8 * S - 14], s1[8 * S - 13]); w.z = cvt_pk_bf16(s1[8 * S - 12], s1[8 * S - 11]); w.w = cvt_pk_bf16(s1[8 * S - 10], s1[8 * S - 9]); }
            pb[S] = __builtin_bit_cast(bf16x8, w); }
#pragma unroll
        for (int S = 0; S < 4; ++S) {
            const u32x2 a0 = *(const LAS u32x2*)(vbp + S * 32), a1 = *(const LAS u32x2*)(vbp + S * 32 + 16);
            const u32x2 c0 = *(const LAS u32x2*)(vbp + 32 * VPITCH + S * 32), c1 = *(const LAS u32x2*)(vbp + 32 * VPITCH + S * 32 + 16);
            const bf16x8 va = __builtin_bit_cast(bf16x8, (u32x4){a0.x, a0.y, a1.x, a1.y}), vc = __builtin_bit_cast(bf16x8, (u32x4){c0.x, c0.y, c1.x, c1.y});
            o0 = __builtin_amdgcn_mfma_f32_32x32x16_bf16(va, pb[S], o0, 0, 0, 0); o1 = __builtin_amdgcn_mfma_f32_32x32x16_bf16(vc, pb[S], o1, 0, 0, 0); }
    }
    s0 = n0; s1 = n1;
}
__device__ __forceinline__ void attn_unit(LAS unsigned char* lds, const bf16_t* Qrow0, int nqw, int limbase, bool prompt, size_t kv0, int NT, int h,
                                          const bf16_t* KN, const bf16_t* KR, const bf16_t* VVt, bf16_t* Yrow0, unsigned* tkctr, int& tick) {
    const int tid = fresh_tid(), lane = tid & 63, wid = __builtin_amdgcn_readfirstlane(tid >> 6), r32 = lane & 31, hi = lane >> 5;
    const int lim = wid < nqw ? (prompt ? limbase + (wid >> 1) + 1 : NT) : 0;
    const int kr0 = tid / 12, kp0 = tid % 12, kr1 = (tid + 512) / 12, kp1 = (tid + 512) % 12;
    const bf16_t* ksrc0 = kp0 < 8 ? KN + (kv0 + kr0) * 512 + h * 64 + kp0 * 8 : KR + (kv0 + kr0) * 32 + (kp0 - 8) * 8;
    const size_t kstr0 = kp0 < 8 ? 512 * 64 : 32 * 64;
    const bf16_t* ksrc1 = kp1 < 8 ? KN + (kv0 + kr1) * 512 + h * 64 + kp1 * 8 : KR + (kv0 + kr1) * 32 + (kp1 - 8) * 8;
    const size_t kstr1 = kp1 < 8 ? 512 * 64 : 32 * 64;
    const bool k1 = tid < 256;
    const bf16_t* vsrc = VVt + (size_t)(h * 64 + (tid >> 3)) * KVR + kv0 + (tid & 7) * 8;
    const int kd0 = kr0 * KPITCH + kp0 * 16, kd1 = kr1 * KPITCH + kp1 * 16, vd = (tid >> 3) * VPITCH + (tid & 7) * 16;
    u32x4 ak0, ak1, av, bk0, bk1, bv;
    const bf16_t* ksrc1c = k1 ? ksrc1 : ksrc0; const size_t kstr1c = k1 ? kstr1 : kstr0;
    const int ntm = NT - 1;
#define ATT_LDK(K0, K1, t) do { const int t_ = (t) < ntm ? (t) : ntm; K0 = *(const u32x4*)(ksrc0 + (size_t)t_ * kstr0); K1 = *(const u32x4*)(ksrc1c + (size_t)t_ * kstr1c); } while (0)
#define ATT_LDV(V, t) do { const int t_ = (t) < ntm ? (t) : ntm; V = *(const u32x4*)(vsrc + (size_t)t_ * 64); } while (0)
#define ATT_STK(K0, K1, b) do { *(LAS u32x4*)(lds + (b) * KBUF + kd0) = K0; if (k1) *(LAS u32x4*)(lds + (b) * KBUF + kd1) = K1; } while (0)
#define ATT_STV(V, b) do { *(LAS u32x2*)(lds + ATT_V0 + (b) * VBUF + vd) = (u32x2){V.x, V.y}; *(LAS u32x2*)(lds + ATT_V0 + (b) * VBUF + vd + 8) = (u32x2){V.z, V.w}; } while (0)
#define ATT_BAR() asm volatile("s_waitcnt lgkmcnt(0)\n\ts_barrier" ::: "memory")
    ATT_LDK(ak0, ak1, 0); ATT_LDV(av, 0); ATT_LDK(bk0, bk1, 1);
    bf16x8 qr[6];
    if (wid < nqw) {
#pragma unroll
        for (int s = 0; s < 6; ++s) qr[s] = *(const bf16x8*)(Qrow0 + (size_t)(wid * 32 + r32) * 768 + h * 96 + s * 16 + hi * 8);
    } else {
#pragma unroll
        for (int s = 0; s < 6; ++s) qr[s] = (bf16x8){0, 0, 0, 0, 0, 0, 0, 0};
    }
    ATT_STK(ak0, ak1, 0); ATT_STV(av, 0); ATT_STK(bk0, bk1, 1);
    ATT_LDK(ak0, ak1, 2); ATT_LDV(av, 1);
    ATT_BAR();
    float mrow = -1e30f, lsum = 0.f; f32x16 o0 = {}, o1 = {}, s0 = {}, s1 = {};
    if (wid >= 4) __builtin_amdgcn_s_setprio(1);
    const LAS unsigned char* kbase = lds + r32 * KPITCH + hi * 16;
    const LAS unsigned char* vbase = lds + ATT_V0 + r32 * VPITCH + hi * 8;
    if (lim > 0) attn_step<true, false>(kbase, vbase, qr, s0, s1, o0, o1, mrow, lsum);
    ATT_BAR();
    if (tkctr && tid == 0) tick = (int)atomicAdd(tkctr, 1u);
#define ATT_ITER(t, XK0, XK1, XV, YK0, YK1, YV) do { const int buf_ = (t) & 1; \
        ATT_LDK(YK0, YK1, (t) + 3); ATT_LDV(YV, (t) + 2); \
        if ((t) + 1 < lim) attn_step<true, true>(kbase + (buf_ ^ 1) * KBUF, vbase + buf_ * VBUF, qr, s0, s1, o0, o1, mrow, lsum); \
        else if ((t) < lim) attn_step<false, true>(kbase + (buf_ ^ 1) * KBUF, vbase + buf_ * VBUF, qr, s0, s1, o0, o1, mrow, lsum); \
        ATT_STK(XK0, XK1, buf_); ATT_STV(XV, buf_ ^ 1); \
        ATT_BAR(); } while (0)
    for (int t = 0; t < NT; t += 2) {
        ATT_ITER(t, ak0, ak1, av, bk0, bk1, bv);
        if (t + 1 < NT) ATT_ITER(t + 1, bk0, bk1, bv, ak0, ak1, av);
    }
    asm volatile("s_waitcnt vmcnt(0)" ::: "memory");
    __builtin_amdgcn_s_setprio(0);
#undef ATT_LDK
#undef ATT_LDV
#undef ATT_STK
#undef ATT_STV
#undef ATT_ITER
    if (wid < nqw) {
        lsum += __shfl_xor(lsum, 32);
        const float inv = 1.f / lsum;
        bf16_t* yp = Yrow0 + (size_t)(wid * 32 + r32) * DM + 512 + h * 64 + 4 * hi;
#pragma unroll
        for (int g = 0; g < 4; ++g) {
            u32x2 w; w.x = cvt_pk_bf16(o0[4 * g] * inv, o0[4 * g + 1] * inv); w.y = cvt_pk_bf16(o0[4 * g + 2] * inv, o0[4 * g + 3] * inv);
            *(u32x2*)(yp + 8 * g) = w;
            u32x2 x; x.x = cvt_pk_bf16(o1[4 * g] * inv, o1[4 * g + 1] * inv); x.y = cvt_pk_bf16(o1[4 * g + 2] * inv, o1[4 * g + 3] * inv);
            *(u32x2*)(yp + 32 + 8 * g) = x; }
    }
}


#define XB_TMO      128
#define XB_XCNT(j)  (256  + 64 * (j))
#define XB_XSUB(j)  (1280 + 64 * (j))
#define XB_XGEN(j)  (2304 + 64 * (j))
#define XB_TOP      3328
#define XB_TOPGEN   3392
#define XCD_BAR_WORDS 3456
#define XB_SPIN_CAP (1u << 18)
__device__ __forceinline__ unsigned xb_ld(unsigned* p)              { return __hip_atomic_load(p, __ATOMIC_RELAXED, __HIP_MEMORY_SCOPE_AGENT); }
__device__ __forceinline__ unsigned xb_add(unsigned* p, unsigned v) { return __hip_atomic_fetch_add(p, v, __ATOMIC_RELAXED, __HIP_MEMORY_SCOPE_AGENT); }
__device__ __forceinline__ unsigned xb_xcc_id() { return (unsigned)__builtin_amdgcn_s_getreg((3 << 11) | 20) & 0xFu; }
#define XB_SPIN(cond, bar) do { unsigned _sp = 0; while (cond) { __builtin_amdgcn_s_sleep(1); \
    if ((++_sp & 255u) == 0u) { if (xb_ld(&(bar)[XB_TMO])) break; if (_sp > XB_SPIN_CAP) { atomicAdd(&(bar)[XB_TMO], 1u); break; } } } } while (0)
struct XcdBarrier { unsigned* bar; unsigned x; volatile LAS unsigned* st; };
__device__ __forceinline__ XcdBarrier xcd_barrier_post(unsigned* bar, volatile LAS unsigned* st) {
    XcdBarrier b; b.bar = bar; b.x = xb_xcc_id(); b.st = st;
    if (threadIdx.x == 0) (void)xb_add(&bar[XB_XCNT(b.x)], 1u);
    return b;
}
__device__ __forceinline__ void xcd_barrier_complete(unsigned* bar, unsigned x, unsigned& nloc, unsigned& nx) {
    const unsigned G = gridDim.x * gridDim.y * gridDim.z;
    unsigned sum, cnt, mine, sp = 0u;
    for (;;) {
        sum = 0u; cnt = 0u; mine = 0u;
#pragma unroll
        for (unsigned j = 0; j < 16; ++j) { const unsigned c = xb_ld(&bar[XB_XCNT(j)]); sum += c; cnt += (c > 0u) ? 1u : 0u; mine = (j == x) ? c : mine; }
        if (sum == G) break;
        __builtin_amdgcn_s_sleep(1);
        if ((++sp & 255u) == 0u) { if (xb_ld(&bar[XB_TMO])) break; if (sp > XB_SPIN_CAP) { atomicAdd(&bar[XB_TMO], 1u); break; } }
    }
    nloc = mine > 0u ? mine : 1u; nx = cnt > 0u ? cnt : 1u;
}
__device__ __forceinline__ void xcd_barrier(const XcdBarrier& b) {
    asm volatile("s_waitcnt vmcnt(0)" ::: "memory");
    __syncthreads();
    if (threadIdx.x == 0) {
        unsigned* bar = b.bar;
        __builtin_amdgcn_s_waitcnt(0);
        unsigned nloc = b.st[0], nx = b.st[1];
        if (nloc == 0u) { xcd_barrier_complete(bar, b.x, nloc, nx); b.st[0] = nloc; b.st[1] = nx; }
        const unsigned old = xb_add(&bar[XB_XSUB(b.x)], 1u);
        const unsigned gen = old / nloc;
        if (old + 1u == (gen + 1u) * nloc) {
            __builtin_amdgcn_fence(__ATOMIC_RELEASE, "agent");
            asm volatile("s_waitcnt vmcnt(0)" ::: "memory");
            const unsigned og = xb_add(&bar[XB_TOP], 1u);
            const unsigned tg = og / nx;
            if (og + 1u == (tg + 1u) * nx) xb_add(&bar[XB_TOPGEN], 1u);
            else XB_SPIN(xb_ld(&bar[XB_TOPGEN]) == tg, bar);
            __builtin_amdgcn_fence(__ATOMIC_ACQUIRE, "agent");
            xb_add(&bar[XB_XGEN(b.x)], 1u);
            asm volatile("s_waitcnt vmcnt(0)" ::: "memory");
        } else {
            XB_SPIN(xb_ld(&bar[XB_XGEN(b.x)]) == gen, bar);
            __builtin_amdgcn_fence(__ATOMIC_ACQUIRE, "agent");
            asm volatile("s_waitcnt vmcnt(0)" ::: "memory");
        }
    }
    __syncthreads();
}

__global__ void __launch_bounds__(512, 2) mega_fwd(Args a) {
    extern __shared__ __attribute__((aligned(16))) unsigned char lds_raw[];
    LAS unsigned char* lds = (LAS unsigned char*)lds_raw;
    cg::grid_group grid = cg::this_grid();
    const int G = gridDim.x, bx = blockIdx.x;
#define FRESH_IDS() const int tid = fresh_tid(), lane = tid & 63, wid = __builtin_amdgcn_readfirstlane(tid >> 6); (void)tid; (void)lane; (void)wid
    unsigned char* ws = a.ws;
    const float *x_p = a.in[0], *x_s = a.in[1], *cache_ckv = a.in[2], *cache_kr = a.in[3], *c_p = a.in[4], *c_s = a.in[5], *w_ada = a.in[6], *b_ada = a.in[7],
                *norm1_g = a.in[8], *w_in = a.in[9], *w_s = a.in[10], *b_s = a.in[11], *q_norm_g = a.in[12], *w_uq = a.in[13], *kv_norm_g = a.in[14], *w_ukv = a.in[15],
                *qn_g = a.in[16], *qr_g = a.in[17], *kn_g = a.in[18], *kr_g = a.in[19], *w_out = a.in[20], *norm2_g = a.in[21], *w_fi = a.in[22], *w_fo = a.in[23];
    float* out = a.out;
    float* PART = (float*)(ws + WS_PART); bf16_t* X1B = (bf16_t*)(ws + WS_X1B);
    float* MOD = (float*)(ws + WS_MOD); float* ROPE = (float*)(ws + WS_ROPE); float* SSQ = (float*)(ws + WS_SSQ);
    bf16_t *Wm = (bf16_t*)(ws + WS_WM), *Wt_in = (bf16_t*)(ws + WS_WIN), *Wt_uq = (bf16_t*)(ws + WS_WUQ), *Wt_ukv = (bf16_t*)(ws + WS_WUKV), *Wt_out = (bf16_t*)(ws + WS_WOUT),
           *Wt_fi = (bf16_t*)(ws + WS_WFI), *Wt_fo = (bf16_t*)(ws + WS_WFO), *Hb = (bf16_t*)(ws + WS_H), *YAB = (bf16_t*)(ws + WS_YAB), *Gb = (bf16_t*)(ws + WS_G),
           *Ub = (bf16_t*)(ws + WS_U), *Vt = (bf16_t*)(ws + WS_VT), *CQ = (bf16_t*)(ws + WS_CQ), *CKV = (bf16_t*)(ws + WS_CKV), *KR = (bf16_t*)(ws + WS_KR),
           *KN = (bf16_t*)(ws + WS_KN), *VVt = (bf16_t*)(ws + WS_VVT), *Qb = (bf16_t*)(ws + WS_Q);

    { const int t0 = threadIdx.x; if (t0 < 2) ((volatile LAS unsigned*)(lds + LDS_X + 8192))[t0] = 0u; }
    __syncthreads();
    const XcdBarrier xbar = xcd_barrier_post((unsigned*)(ws + WS_BAR), (volatile LAS unsigned*)(lds + LDS_X + 8192));
    {
        FRESH_IDS();
        for (int it = bx; it < 96; it += G) {
            LAS float* sl = (LAS float*)lds; LAS float* red = (LAS float*)(lds + 65536);
            for (int e = tid; e < 16384; e += 512) { const int r = e >> 10, k = e & 1023; const float c = r < 8 ? c_p[r * 1024 + k] : c_s[(r - 8) * 1024 + k]; sl[e] = silu_f(c); }
            __syncthreads();
            float acc[16];
#pragma unroll
            for (int r = 0; r < 16; ++r) acc[r] = 0.f;
            const float* wp = w_ada + (size_t)(wid * 128) * 6144 + it * 64 + lane;
            for (int k = 0; k < 128; k += 16) {
                float wv[16];
#pragma unroll
                for (int j = 0; j < 16; ++j) wv[j] = __builtin_nontemporal_load(wp + (size_t)(k + j) * 6144);
#pragma unroll
                for (int jj = 0; jj < 4; ++jj)
#pragma unroll
                    for (int r = 0; r < 16; ++r) { const f32x4 s4 = *(const LAS f32x4*)(sl + r * 1024 + wid * 128 + k + 4 * jj);
                        acc[r] += (s4[0] * wv[4 * jj] + s4[1] * wv[4 * jj + 1]) + (s4[2] * wv[4 * jj + 2] + s4[3] * wv[4 * jj + 3]); }
            }
#pragma unroll
            for (int r = 0; r < 16; ++r) red[(wid * 16 + r) * 64 + lane] = acc[r];
            __syncthreads();
            for (int e = tid; e < 1024; e += 512) { const int r = e >> 6, col = e & 63; float s = b_ada[it * 64 + col];
#pragma unroll
                for (int w = 0; w < 8; ++w) s += red[(w * 16 + r) * 64 + col];
                MOD[(size_t)r * 6144 + it * 64 + col] = s; }
            __syncthreads();
        }
        LAS float* scr = (LAS float*)(lds + wid * 16384);
        const bool ada_wg = (G > 128) && bx < 96;
        const int gw = ada_wg ? 0x7fffffff : ((G > 128 ? bx - 96 : bx) * 8 + wid), NGW = (G > 128 ? G - 96 : G) * 8;
        constexpr int I_IN = 16 * 56, I_UQ = 6 * 24, I_UKV = 4 * 32, I_OUT = 16 * 32, I_FI = 16 * 176, I_FO = 44 * 32, I_CKV = 4096, I_CKR = 2048, I_ROPE = 1024, I_WM = 1024;
        constexpr int NITEMS = I_IN + I_UQ + I_UKV + I_OUT + I_FI + I_FO + I_CKV + I_CKR + I_ROPE + I_WM;
        for (int it = gw; it < NITEMS; it += NGW) {
            int r = it;
            if (r < I_IN) { const int kb = r / 56, nb = r % 56, n0 = nb * 32;
                const int c0 = n0 < 512 ? n0 : n0 < 768 ? 1408 + (n0 - 512) : n0 < 1152 ? 1024 + (n0 - 768) : n0 < 1184 ? 1664 : n0 < 1280 ? -1 : 512 + (n0 - 1280);
                p0_transpose_item(w_in, 1696, c0, kb * 64, Wt_in, 1024, n0, nullptr, scr, lane); continue; } r -= I_IN;
            if (r < I_UQ) { const int kb = r / 24, nb = r % 24, pn = nb >> 3, bj = (nb >> 2) & 1, wc = nb & 3;
                const int c0 = pn < 2 ? 96 * (4 * pn + wc) + 32 * bj : 96 * (4 * bj + wc) + 64;
                p0_transpose_item(w_uq, 768, c0, kb * 64, Wt_uq, 384, nb * 32, q_norm_g, scr, lane); continue; } r -= I_UQ;
            if (r < I_UKV) { const int kb = r / 32, nb = r % 32; int c0;
                if (nb < 16) { const int pn = nb >> 3, bj = (nb >> 2) & 1, wc = nb & 3; c0 = 128 * (4 * pn + wc) + 32 * bj; }
                else { const int ch0 = (nb - 16) * 32; c0 = 128 * (ch0 >> 6) + 64 + (ch0 & 63); }
                p0_transpose_item(w_ukv, 1024, c0, kb * 64, Wt_ukv, 256, nb * 32, nullptr, scr, lane); continue; } r -= I_UKV;
            if (r < I_OUT) { const int kb = r / 32, nb = r % 32; p0_transpose_item(w_out, 1024, nb * 32, kb * 64, Wt_out, 1024, nb * 32, nullptr, scr, lane); continue; } r -= I_OUT;
            if (r < I_FI) { const int kb = r / 176, nb = r % 176, n0 = nb * 32, pn = n0 >> 8, bj = (n0 >> 7) & 1, rr = n0 & 127;
                p0_transpose_item(w_fi, 5632, bj * 2816 + 128 * pn + rr, kb * 64, Wt_fi, 1024, n0, nullptr, scr, lane); continue; } r -= I_FI;
            if (r < I_FO) { const int kb = r / 32, nb = r % 32; p0_transpose_item(w_fo, 1024, nb * 32, kb * 64, Wt_fo, 2816, nb * 32, nullptr, scr, lane); continue; } r -= I_FO;
            if (r < I_CKV) { const int row0 = r * 4, b = row0 >> 11, p = row0 & 2047; f32x4 v[4];
#pragma unroll
                for (int q = 0; q < 4; ++q) v[q] = __builtin_nontemporal_load((const f32x4*)(cache_ckv + (size_t)(row0 + q) * 256) + lane);
#pragma unroll
                for (int q = 0; q < 4; ++q) { u32x2 w; w.x = cvt_pk_bf16(v[q][0], v[q][1]); w.y = cvt_pk_bf16(v[q][2], v[q][3]);
                    *((u32x2*)(CKV + ((size_t)MP + b * 2112 + p + q) * 256) + lane) = w; }
                continue; } r -= I_CKV;
            if (r < I_CKR) { const int row = r * 8 + (lane >> 3), b = row >> 11, p = row & 2047; const f32x4 v = *((const f32x4*)(cache_kr + (size_t)row * 32) + (lane & 7));
                u32x2 w; w.x = cvt_pk_bf16(v[0], v[1]); w.y = cvt_pk_bf16(v[2], v[3]);
                *((u32x2*)(KR + ((size_t)MP + b * 2112 + p) * 32) + (lane & 7)) = w; continue; } r -= I_CKR;
            if (r < I_ROPE) { const int e = r * 64 + lane, pos = e >> 4, j = e & 15;
                const double inv = exp(-(double)j * (1.0 / 16.0) * 9.210340371976184);
                const double rev = (double)pos * inv * 0.15915494309189535; const float fr = (float)(rev - floor(rev));
                ROPE[(size_t)pos * 32 + j] = __builtin_amdgcn_cosf(fr); ROPE[(size_t)pos * 32 + 16 + j] = __builtin_amdgcn_sinf(fr); continue; } r -= I_ROPE;
            { const int e = r * 64 + lane, i = (e >> 7) & 127, j = e & 127; const float v = (j >> 6) <= (i >> 6) ? w_s[e] : 0.f; Wm[e] = (bf16_t)(cvt_pk_bf16(v, 0.f) & 0xffffu); }
        }
    }
    xcd_barrier(xbar);
    if (G == 0x7fffffff) grid.sync();

    { FRESH_IDS();
        int row = bx * 8 + wid; f32x4 nv[4];
        if (row < MT) norm_load(row < MP ? x_p + (size_t)row * DM : x_s + (size_t)(row - MP) * DM, nv, lane);
        for (; row < MT; row += G * 8) {
            f32x4 v[4];
#pragma unroll
            for (int j = 0; j < 4; ++j) v[j] = nv[j];
            const int nr = row + G * 8;
            if (nr < MT) norm_load(nr < MP ? x_p + (size_t)nr * DM : x_s + (size_t)(nr - MP) * DM, nv, lane);
            const int b16 = row < MP ? (row >> 12) : 8 + ((row - MP) >> 6);
            norm_apply(v, norm1_g, MOD + (size_t)b16 * 6144 + 1024, MOD + (size_t)b16 * 6144, Hb + (size_t)row * DM, lane);
        } }
    xcd_barrier(xbar);

    {
        ProgIn P; P.K = 1024; P.lda = 1024; P.ldb = 1024; P.G = G; P.c = bx; P.H = Hb; P.Wt = Wt_in; P.U = Ub; P.Vt = Vt; P.CQ = CQ; P.CKV = CKV; P.KR = KR; P.SSQ = SSQ; P.out = out;
        P.rope = ROPE; P.kvg = kv_norm_g; P.krg = kr_g; P.xl = (LAS float*)(lds + LDS_X);
        pg8::gemm_phase(lds, P);
    }
    xcd_barrier(xbar);

    {
        ProgQ P; P.K = 384; P.lda = 384; P.ldb = 384; P.G = G; P.c = bx; P.CQ = CQ; P.Wt = Wt_uq; P.SSQ = SSQ; P.Q = Qb; P.rope = ROPE; P.qng = qn_g; P.qrg = qr_g;
        pg8::gemm_phase(lds, P);
    }
    {
        ProgKV P; P.K = 256; P.lda = 256; P.ldb = 256; P.G = G; P.c = (G == 256) ? ((bx + 140) & 255) : bx;
        P.CKV = CKV; P.Wt = Wt_ukv; P.KN = KN; P.VVt = VVt; P.kng = kn_g;
        pg8::gemm_phase(lds, P);
    }
    gmlp_phase(lds, (G == 256) ? ((bx + 96) & 255) : bx, G, Wm, Vt, Ub, b_s, YAB);
    xcd_barrier(xbar);

    {
        const int vcu = (G % 8 == 0) ? (bx % 8) * (G / 8) + bx / 8 : bx;
        if (G == 256) {
            const int xcd = bx & 7; unsigned* ctr = (unsigned*)(ws + WS_CTR) + xcd * 64;
            volatile LAS int* qw = (volatile LAS int*)(lds + LDS_X + 8192 + 64);
            int tick = 0; if (threadIdx.x == 0) tick = (int)atomicAdd(ctr, 1u);
            for (int par = 0;; par ^= 1) {
                if (threadIdx.x == 0) qw[par] = tick;
                __syncthreads();
                const int j = qw[par];
                if (j >= 136) break;
                if (j < 96 || j >= 104) { const int jj = j < 96 ? j : j - 104, qb = j < 96 ? 15 - (jj >> 3) : 3 - (jj >> 3), bh = xcd * 8 + (jj & 7), b = bh >> 3, h = bh & 7;
                    const size_t r0 = (size_t)b * 4096 + qb * 256;
                    attn_unit(lds, Qb + r0 * 768, 8, 4 * qb, true, (size_t)b * 4096, 4 * qb + 4, h, KN, KR, VVt, YAB + r0 * DM, ctr, tick);
                } else { const int bh = xcd * 8 + (j - 96), b2 = bh >> 3, h2 = bh & 7; const size_t r0 = (size_t)MP + b2 * 64;
                    attn_unit(lds, Qb + r0 * 768, 2, 0, false, (size_t)MP + b2 * 2112, 33, h2, KN, KR, VVt, YAB + r0 * DM, ctr, tick); }
            }
        } else {
            for (int it = vcu; it < 1024 + 64; it += G) {
                if (it < 1024) { const int bh = it >> 4, qb = it & 15, b = bh >> 3, h = bh & 7;
                    const size_t r0 = (size_t)b * 4096 + qb * 256;
                    { int tk = 0; attn_unit(lds, Qb + r0 * 768, 8, 4 * qb, true, (size_t)b * 4096, 4 * qb + 4, h, KN, KR, VVt, YAB + r0 * DM, nullptr, tk); }
                } else { const int bh = it - 1024, b = bh >> 3, h = bh & 7; const size_t r0 = (size_t)MP + b * 64;
                    { int tk = 0; attn_unit(lds, Qb + r0 * 768, 2, 0, false, (size_t)MP + b * 2112, 33, h, KN, KR, VVt, YAB + r0 * DM, nullptr, tk); } }
            }
        }
    }
    xcd_barrier(xbar);

    {
        ProgRes<0> P; P.K = 1024; P.lda = 1024; P.ldb = 1024; P.G = G; P.c = bx; P.Ab = YAB; P.Wt = Wt_out; P.xp = x_p; P.Y = out; P.X1 = X1B; P.gate = MOD + 2048; P.part = PART; P.nsk = 4;
        pg8::gemm_phase(lds, P);
    }
    xcd_barrier(xbar);

    { FRESH_IDS();
        int row = bx * 8 + wid; f32x4 nv[4];
        if (row < MP) row_load_bf16(X1B + (size_t)row * DM, nv, lane);
        for (; row < MP; row += G * 8) {
            f32x4 v[4];
#pragma unroll
            for (int j = 0; j < 4; ++j) v[j] = nv[j];
            const int nr = row + G * 8;
            if (nr < MP) row_load_bf16(X1B + (size_t)nr * DM, nv, lane);
            const int b16 = row >> 12;
            norm_apply(v, norm2_g, MOD + (size_t)b16 * 6144 + 4096, MOD + (size_t)b16 * 6144 + 3072, Hb + (size_t)row * DM, lane);
        }
        for (int sr = ((bx + 128) % G) * 8 + wid; sr < MS; sr += G * 8) { const int b16 = 8 + (sr >> 6); f32x4 v[4];
            norm_load(x_s + (size_t)sr * DM, v, lane);
            sample_combine(MOD + (size_t)b16 * 6144 + 2048, PART, 4, sr, v, lane);
            row_store_bf16(X1B + (size_t)(MP + sr) * DM, v, lane);
            row_load_bf16(X1B + (size_t)(MP + sr) * DM, v, lane);
            norm_apply(v, norm2_g, MOD + (size_t)b16 * 6144 + 4096, MOD + (size_t)b16 * 6144 + 3072, Hb + (size_t)(MP + sr) * DM, lane);
        } }
    xcd_barrier(xbar);

    {
        ProgFfn P; P.K = 1024; P.lda = 1024; P.ldb = 1024; P.G = G; P.c = bx; P.Ab = Hb; P.Wt = Wt_fi; P.Gb = Gb;
        pg8::gemm_phase(lds, P);
    }
    xcd_barrier(xbar);

    {
        ProgRes<1> P; P.K = DFF; P.lda = DFF; P.ldb = DFF; P.G = G; P.c = bx; P.Ab = Gb; P.Wt = Wt_fo; P.xp = nullptr; P.Y = out; P.X1 = X1B; P.gate = MOD + 5120; P.part = PART; P.nsk = 11;
        pg8::gemm_phase(lds, P);
    }
    xcd_barrier(xbar);

    { FRESH_IDS();
        for (int sr = bx * 8 + wid; sr < MS; sr += G * 8) { const int b16 = 8 + (sr >> 6); f32x4 v[4];
            row_load_bf16(X1B + (size_t)(MP + sr) * DM, v, lane);
            sample_combine(MOD + (size_t)b16 * 6144 + 5120, PART, 11, sr, v, lane);
#pragma unroll
            for (int j = 0; j < 4; ++j) *((f32x4*)(out + (size_t)(MP + sr) * DM) + lane + 64 * j) = v[j]; } }
}

extern "C" void kernel_launch(void* const* d_in, const int* in_sizes, int n_in, void* d_out, int out_size, void* d_ws, size_t ws_size, hipStream_t stream) {
    static int grid = 0;
    if (grid == 0) {
        if (n_in != 24 || ws_size < WS_END) { fprintf(stderr, "kernel_launch: unexpected n_in %d / ws_size %zu (need %zu)\n", n_in, ws_size, (size_t)WS_END); grid = -1; return; }
        int dev = 0, cus = 0, per_cu = 0;
        hipGetDevice(&dev); hipDeviceGetAttribute(&cus, hipDeviceAttributeMultiprocessorCount, dev);
        if (hipFuncSetAttribute((const void*)mega_fwd, hipFuncAttributeMaxDynamicSharedMemorySize, LDS_BYTES) != hipSuccess) { fprintf(stderr, "kernel_launch: hipFuncSetAttribute failed\n"); grid = -1; return; }
        if (hipOccupancyMaxActiveBlocksPerMultiprocessor(&per_cu, (const void*)mega_fwd, 512, LDS_BYTES) != hipSuccess || per_cu < 1) { fprintf(stderr, "kernel_launch: occupancy query gave %d\n", per_cu); per_cu = 1; }
        (void)hipGetLastError();
        grid = cus;
        fprintf(stderr, "kernel_launch: grid %d (cus %d, per_cu %d)\n", grid, cus, per_cu);
    }
    if (grid < 0) return;
    if (hipMemsetAsync((char*)d_ws + WS_BAR, 0, 32768, stream) != hipSuccess) { fprintf(stderr, "kernel_launch: memset of control words failed\n"); return; }
    Args a{};
    for (int i = 0; i < 24; ++i) a.in[i] = (const float*)d_in[i];
    a.out = (float*)d_out; a.ws = (unsigned char*)d_ws;
    void* args[] = {&a};
    hipError_t e = hipLaunchCooperativeKernel((const void*)mega_fwd, dim3(grid), dim3(512), args, LDS_BYTES, stream);
    if (e != hipSuccess) fprintf(stderr, "kernel_launch: cooperative launch failed: %s (grid %d)\n", hipGetErrorString(e), grid);
}
```

```cpp
#include <hip/hip_runtime.h>
#include <hip/hip_cooperative_groups.h>
#include <cstdio>
#include <cstdint>
namespace cg = cooperative_groups;

#define LAS __attribute__((address_space(3)))
typedef unsigned short bf16_t;
typedef short bf16x8 __attribute__((ext_vector_type(8)));
typedef short s16x4 __attribute__((ext_vector_type(4)));
typedef float f32x4 __attribute__((ext_vector_type(4)));
typedef float f32x16 __attribute__((ext_vector_type(16)));
typedef unsigned u32x4 __attribute__((ext_vector_type(4)));
typedef unsigned u32x2 __attribute__((ext_vector_type(2)));

constexpr int MP = 32768, MS = 512, MT = MP + MS;
constexpr int DM = 1024, DFF = 2816;
constexpr int KVR = MP + 8 * 2112;
constexpr float EPS = 1e-6f;
constexpr float QSCALE = 0.10206207261596577f * 1.4426950408889634f;
constexpr size_t OFF_CKVP = 34078720, OFF_KRP = 42467328, OFF_CKVS = 43515904, OFF_KRS = 43646976, OFF_VS = 43663360;

constexpr size_t MiB = 1u << 20;
constexpr size_t WS_MOD = 0, WS_ROPE = 512 * 1024, WS_SSQ = 1 * MiB, WS_WM = 3 * MiB, WS_WIN = 4 * MiB, WS_WUQ = 8 * MiB, WS_WUKV = 9 * MiB,
                 WS_WOUT = 10 * MiB, WS_WFI = 12 * MiB, WS_WFO = 23 * MiB, WS_H = 29 * MiB, WS_YAB = 94 * MiB, WS_G = 159 * MiB,
                 WS_U = 159 * MiB, WS_VT = 192 * MiB, WS_CQ = 225 * MiB, WS_CKV = 250 * MiB, WS_KR = 275 * MiB, WS_KN = 279 * MiB,
                 WS_VVT = 328 * MiB, WS_Q = 377 * MiB, WS_END = 450 * MiB, WS_CTR = 3 * MiB - 4096, WS_BAR = 3 * MiB - 32768, WS_PART = 426 * MiB, WS_X1B = 345 * MiB;

constexpr int LDS_BYTES = 147456;
constexpr int LDS_X = 131072;

__device__ __forceinline__ unsigned cvt_pk_bf16(float lo, float hi) { unsigned r; asm("v_cvt_pk_bf16_f32 %0, %1, %2" : "=v"(r) : "v"(lo), "v"(hi)); return r; }
__device__ __forceinline__ float bf2f(unsigned short h) { return __uint_as_float(((unsigned)h) << 16); }
__device__ __forceinline__ float gelu_tanh(float x) {
    const float y2 = 1.5957691216057308f * x * (1.f + 0.044715f * x * x);
    const float e = __builtin_amdgcn_exp2f(-y2 * 1.4426950408889634f);
    return x * __builtin_amdgcn_rcpf(1.f + e);
}
__device__ __forceinline__ float silu_f(float x) { const float e = __builtin_amdgcn_exp2f(-x * 1.4426950408889634f); return x * __builtin_amdgcn_rcpf(1.f + e); }
typedef float f32x2v __attribute__((ext_vector_type(2)));
__device__ __forceinline__ f32x2v gelu_tanh2(f32x2v x) {
    const f32x2v p = (x * x) * 0.044715f + 1.f;
    const f32x2v t = (x * (-1.5957691216057308f * 1.4426950408889634f)) * p;
    f32x2v e; e.x = __builtin_amdgcn_exp2f(t.x); e.y = __builtin_amdgcn_exp2f(t.y);
    const f32x2v d = e + 1.f;
    f32x2v r; r.x = __builtin_amdgcn_rcpf(d.x); r.y = __builtin_amdgcn_rcpf(d.y);
    return x * r;
}
__device__ __forceinline__ f32x2v silu_mul2(f32x2v g, f32x2v u) {
    const f32x2v t = g * (-1.4426950408889634f);
    f32x2v e; e.x = __builtin_amdgcn_exp2f(t.x); e.y = __builtin_amdgcn_exp2f(t.y);
    const f32x2v d = e + 1.f;
    f32x2v r; r.x = __builtin_amdgcn_rcpf(d.x); r.y = __builtin_amdgcn_rcpf(d.y);
    return (g * u) * r;
}
__device__ __forceinline__ float wave_sum(float v) {
#pragma unroll
    for (int o = 1; o < 64; o <<= 1) v += __shfl_xor(v, o);
    return v;
}
typedef float f32x2 __attribute__((ext_vector_type(2)));
__device__ __forceinline__ float max3f(float a, float b, float c) { float r; asm("v_max3_f32 %0, %1, %2, %3" : "=v"(r) : "v"(a), "v"(b), "v"(c)); return r; }
#define LDS_WAIT() asm volatile("s_waitcnt lgkmcnt(0)" ::: "memory")
__device__ __forceinline__ int fresh_tid() { int t = threadIdx.x; asm volatile("" : "+v"(t)); return t; }

namespace pg8 {
constexpr int BM = 256, BK = 64, HALF = 128, HTB = HALF * BK * 2, STAGE_BYTES = 8 * HTB, NXCD = 8, WGM = 8;
__host__ __device__ __forceinline__ int lds_byte(int r, int c) { const int st = (r >> 4) * 2 + (c >> 5), rr = r & 15, cc = c & 31, ob = rr * 64 + cc * 2; return st * 1024 + (ob ^ (((ob >> 9) & 1) << 5)); }
__host__ __device__ __forceinline__ void stage_rc(int b, int& R, int& C) { const int st = b / 1024, sb = b % 1024, swz = sb ^ (((sb >> 9) & 1) << 5); R = (st >> 1) * 16 + swz / 64; C = (st & 1) * 32 + (swz % 64) / 2; }
__host__ __device__ __forceinline__ int perm32(int rho) { const int n = rho >> 4, i = rho & 15; return 8 * (i >> 2) + 4 * n + (i & 3); }

struct Unit { int pm, pn, kind; };
__device__ __forceinline__ int xcd_map(int L, int nwg) { const int q = nwg / NXCD, r = nwg % NXCD, xcd = L % NXCD, off = L / NXCD; return (xcd < r ? xcd * (q + 1) : r * (q + 1) + (xcd - r) * q) + off; }
__device__ __forceinline__ void grouped(int wgid, int nM, int nN, int& pm, int& pn) {
    const int nig = WGM * nN, gid = wgid / nig, fm = gid * WGM, gsz = (nM - fm) < WGM ? (nM - fm) : WGM;
    pm = fm + ((wgid % nig) % gsz); pn = (wgid % nig) / gsz;
}
template <class Prog>
__device__ __forceinline__ void gemm_phase(LAS unsigned char* lds, const Prog& P) {
    const int tid = fresh_tid(), wid = __builtin_amdgcn_readfirstlane(tid >> 6), lane = tid & 63, wr = wid >> 2, wc = wid & 3, fr = lane & 15, fq = lane >> 4;
    const int lda = P.lda, ldb = P.ldb;
    unsigned voffA[2], voffB[2];
#pragma unroll
    for (int i = 0; i < 2; ++i) { int R, C; stage_rc(tid * 16 + i * 8192, R, C); const int Rb = (R & ~31) + perm32(R & 31);
        voffA[i] = (unsigned)(R * lda + C) * 2u; voffB[i] = (unsigned)(Rb * ldb + C) * 2u; }
    const size_t kstep = (size_t)(BK * 2);
    const size_t hstepA = (size_t)HALF * lda * 2, hstepB = (size_t)HALF * ldb * 2;
    const unsigned ldsw = (unsigned)wid * 1024u;
    const int aoff = lds_byte(wr * 64 + fr, fq * 8), boff = lds_byte(wc * 32 + fr, fq * 8);
#define PG8_SA(b, h) (((b) * 2 + (h)) * HTB)
#define PG8_SB(b, h) ((4 + (b) * 2 + (h)) * HTB)
#define PG8_STAGE(bufoff, gbase, voff) do { _Pragma("unroll") for (int _i = 0; _i < 2; ++_i) \
        __builtin_amdgcn_global_load_lds((const unsigned*)((const char*)(gbase) + (voff)[_i]), (LAS unsigned*)(lds + (bufoff) + ldsw + _i * 8192), 16, 0, 0); } while (0)
#define PG8_LDA(dst, b, h) do { _Pragma("unroll") for (int m = 0; m < 4; ++m) _Pragma("unroll") for (int k = 0; k < 2; ++k) dst[m][k] = *(const LAS bf16x8*)(lds + PG8_SA(b, h) + aoff + m * 2048 + k * 1024); } while (0)
#define PG8_LDB(dst, b, h) do { _Pragma("unroll") for (int n = 0; n < 2; ++n) _Pragma("unroll") for (int k = 0; k < 2; ++k) dst[n][k] = *(const LAS bf16x8*)(lds + PG8_SB(b, h) + boff + n * 2048 + k * 1024); } while (0)
#define PG8_MMA(ai, bj, At, Bt) do { __builtin_amdgcn_s_setprio(1); _Pragma("unroll") for (int m = 0; m < 4; ++m) _Pragma("unroll") for (int n = 0; n < 2; ++n) _Pragma("unroll") for (int k = 0; k < 2; ++k) \
        acc[ai][bj][m][n] = __builtin_amdgcn_mfma_f32_16x16x32_bf16(Bt[n][k], At[m][k], acc[ai][bj][m][n], 0, 0, 0); __builtin_amdgcn_s_setprio(0); } while (0)
#define PG8_WAIT_V(n) asm volatile("s_waitcnt vmcnt(" #n ")" ::: "memory")
#define PG8_WAIT_L(n) asm volatile("s_waitcnt lgkmcnt(" #n ")" ::: "memory")
#define PG8_BAR __builtin_amdgcn_s_barrier()
#define PG8_SCHED __builtin_amdgcn_sched_barrier(0)
    Unit cur, nxt; int ui = 0;
    if (!P.next(0, cur)) return;
    f32x4 acc[2][2][4][2];
#pragma unroll
    for (int a = 0; a < 2; ++a)
#pragma unroll
        for (int b = 0; b < 2; ++b)
#pragma unroll
            for (int m = 0; m < 4; ++m)
#pragma unroll
                for (int n = 0; n < 2; ++n) acc[a][b][m][n] = (f32x4){0.f, 0.f, 0.f, 0.f};
    bf16x8 At[4][2], B0[2][2], B1[2][2];
    const char* cA = P.aptr(cur); const char* cB = P.bptr(cur);
    PG8_STAGE(PG8_SB(0, 0), cB, voffB); PG8_STAGE(PG8_SB(0, 1), cB + hstepB, voffB); PG8_STAGE(PG8_SA(0, 0), cA, voffA); PG8_STAGE(PG8_SA(0, 1), cA + hstepA, voffA);
    if (wr == 1) PG8_BAR;
    PG8_WAIT_V(2); PG8_BAR;
    PG8_STAGE(PG8_SB(1, 0), cB + kstep, voffB); PG8_STAGE(PG8_SA(1, 0), cA + kstep, voffA); PG8_STAGE(PG8_SB(1, 1), cB + hstepB + kstep, voffB);
    PG8_WAIT_V(6); PG8_BAR;
    for (;;) {
        const bool has_next = P.next(ui + 1, nxt);
        const int nt = P.nt(cur);
        const char* nA = has_next ? P.aptr(nxt) : cA; const char* nB = has_next ? P.bptr(nxt) : cB;
        for (int t = 0; t < nt; t += 2) {
            const bool last = (t == nt - 2);
            const char* a1 = cA + (size_t)(t + 1) * kstep;
            const char* a2 = last ? nA : cA + (size_t)(t + 2) * kstep; const char* b2 = last ? nB : cB + (size_t)(t + 2) * kstep;
            const char* a3 = a2 + kstep; const char* b3 = b2 + kstep;
            PG8_LDB(B0, 0, 0); PG8_LDB(B1, 0, 1); PG8_SCHED; PG8_LDA(At, 0, 0); PG8_STAGE(PG8_SA(1, 1), a1 + hstepA, voffA);
            PG8_WAIT_V(8); PG8_WAIT_L(0); PG8_BAR; PG8_MMA(0, 0, At, B0); PG8_MMA(0, 1, At, B1); PG8_BAR; PG8_SCHED;
            PG8_LDA(At, 0, 1); PG8_STAGE(PG8_SB(0, 0), b2, voffB); PG8_STAGE(PG8_SB(0, 1), b2 + hstepB, voffB); PG8_STAGE(PG8_SA(0, 0), a2, voffA);
            PG8_WAIT_V(8); PG8_WAIT_L(0); PG8_BAR; PG8_MMA(1, 0, At, B0); PG8_MMA(1, 1, At, B1); PG8_BAR; PG8_SCHED;
            PG8_LDB(B0, 1, 0); PG8_LDB(B1, 1, 1); PG8_SCHED; PG8_LDA(At, 1, 0); PG8_STAGE(PG8_SA(0, 1), a2 + hstepA, voffA);
            PG8_WAIT_V(8); PG8_WAIT_L(0); PG8_BAR; PG8_MMA(0, 0, At, B0); PG8_MMA(0, 1, At, B1); PG8_BAR; PG8_SCHED;
            PG8_LDA(At, 1, 1); PG8_STAGE(PG8_SB(1, 0), b3, voffB); PG8_STAGE(PG8_SB(1, 1), b3 + hstepB, voffB); PG8_STAGE(PG8_SA(1, 0), a3, voffA);
            PG8_WAIT_V(8); PG8_WAIT_L(0); PG8_BAR; PG8_MMA(1, 0, At, B0); PG8_MMA(1, 1, At, B1); PG8_BAR; PG8_SCHED;
        }
        if (wr == 0) PG8_BAR;
        P.epi(acc, cur, wr, wc, fr, fq);
        if (!has_next) break;
#pragma unroll
        for (int a = 0; a < 2; ++a)
#pragma unroll
            for (int b = 0; b < 2; ++b)
#pragma unroll
                for (int m = 0; m < 4; ++m)
#pragma unroll
                    for (int n = 0; n < 2; ++n) acc[a][b][m][n] = (f32x4){0.f, 0.f, 0.f, 0.f};
        cur = nxt; cA = nA; cB = nB; ++ui;
        if (wr == 1) PG8_BAR;
    }
    PG8_WAIT_V(0);
    PG8_BAR;
#undef PG8_SA
#undef PG8_SB
#undef PG8_STAGE
#undef PG8_LDA
#undef PG8_LDB
#undef PG8_MMA
#undef PG8_WAIT_V
#undef PG8_WAIT_L
#undef PG8_SCHED
}
}
using pg8::Unit;
typedef f32x4 Acc[2][2][4][2];

struct Args {
    const float* in[24];
    float* out;
    unsigned char* ws;
};

struct ProgIn {
    int K, lda, ldb, G, c;
    const bf16_t* H; const bf16_t* Wt;
    bf16_t *U, *Vt, *CQ, *CKV, *KR; float* SSQ; float* out; const float* rope; const float *kvg, *krg;
    LAS float* xl;
    static constexpr int NM = 130, NMAIN = 130 * 5, NSW = 2 * 130, NTOT = NMAIN + NSW;
    __device__ __forceinline__ bool next(int i, Unit& u) const {
        const int L = i * G + c; if (L >= NTOT) return false;
        const int w = pg8::xcd_map(L, NTOT);
        if (w < NMAIN) { pg8::grouped(w, NM, 5, u.pm, u.pn); u.kind = u.pn < 2 ? 0 : (u.pn == 2 ? 1 : 2); }
        else { pg8::grouped(w - NMAIN, 2, NM, u.pm, u.pn); u.kind = 3; }
        return true;
    }
    __device__ __forceinline__ int nt(const Unit&) const { return K / 64; }
    __device__ __forceinline__ const char* aptr(const Unit& u) const { return u.kind < 3 ? (const char*)(H + (size_t)u.pm * 256 * DM) : (const char*)(Wt + (size_t)(1280 + u.pm * 256) * DM); }
    __device__ __forceinline__ const char* bptr(const Unit& u) const { return u.kind < 3 ? (const char*)(Wt + (size_t)u.pn * 256 * DM) : (const char*)(H + (size_t)u.pn * 256 * DM); }
    __device__ __forceinline__ void epi(Acc& acc, const Unit& u, int wr, int wc, int fr, int fq) const {
        asm volatile("" : "+v"(fr), "+v"(fq));
        const int rl0 = wr * 64 + fr;
        if (u.kind == 0) {
#pragma unroll
            for (int ai = 0; ai < 2; ++ai)
#pragma unroll
                for (int m = 0; m < 4; ++m) { const size_t row = (size_t)u.pm * 256 + ai * 128 + rl0 + m * 16;
#pragma unroll
                    for (int bj = 0; bj < 2; ++bj) { const f32x4 v0 = acc[ai][bj][m][0], v1 = acc[ai][bj][m][1]; u32x4 w;
                        { const f32x2v a = gelu_tanh2((f32x2v){v0[0], v0[1]}), b = gelu_tanh2((f32x2v){v0[2], v0[3]}), c = gelu_tanh2((f32x2v){v1[0], v1[1]}), d = gelu_tanh2((f32x2v){v1[2], v1[3]});
                          w.x = cvt_pk_bf16(a.x, a.y); w.y = cvt_pk_bf16(b.x, b.y); w.z = cvt_pk_bf16(c.x, c.y); w.w = cvt_pk_bf16(d.x, d.y); }
                        *(u32x4*)(U + row * 512 + u.pn * 256 + bj * 128 + wc * 32 + fq * 8) = w; } }
        } else if (u.kind == 3) {
            const bool samp = u.pn >= 128;
#pragma unroll
            for (int ai = 0; ai < 2; ++ai)
#pragma unroll
                for (int m = 0; m < 4; ++m) { const int ch = u.pm * 256 + ai * 128 + rl0 + m * 16;
#pragma unroll
                    for (int bj = 0; bj < 2; ++bj) { const f32x4 v0 = acc[ai][bj][m][0], v1 = acc[ai][bj][m][1];
                        const f32x2v ga = gelu_tanh2((f32x2v){v0[0], v0[1]}), gb = gelu_tanh2((f32x2v){v0[2], v0[3]}), gc = gelu_tanh2((f32x2v){v1[0], v1[1]}), gd = gelu_tanh2((f32x2v){v1[2], v1[3]});
                        float g[8] = {ga.x, ga.y, gb.x, gb.y, gc.x, gc.y, gd.x, gd.y};
                        u32x4 w; w.x = cvt_pk_bf16(g[0], g[1]); w.y = cvt_pk_bf16(g[2], g[3]); w.z = cvt_pk_bf16(g[4], g[5]); w.w = cvt_pk_bf16(g[6], g[7]);
                        const int tok = u.pn * 256 + bj * 128 + wc * 32 + fq * 8;
                        *(u32x4*)(Vt + (size_t)ch * MT + tok) = w;
                        if (samp) {
#pragma unroll
                            for (int e = 0; e < 8; ++e) out[OFF_VS + (size_t)(tok - MP + e) * 512 + ch] = g[e]; } } }
        } else if (u.kind == 1) {
#pragma unroll
            for (int ai = 0; ai < 2; ++ai)
#pragma unroll
                for (int m = 0; m < 4; ++m) { float s = 0.f;
#pragma unroll
                    for (int bj = 0; bj < 2; ++bj)
#pragma unroll
                        for (int n = 0; n < 2; ++n) { const f32x4 x = acc[ai][bj][m][n]; s += (x[0] * x[0] + x[1] * x[1]) + (x[2] * x[2] + x[3] * x[3]); }
                    s += __shfl_xor(s, 16); s += __shfl_xor(s, 32);
                    if (fq == 0) xl[(ai * 128 + rl0 + m * 16) * 4 + wc] = s; }
            LDS_WAIT(); __builtin_amdgcn_s_barrier(); asm volatile("" ::: "memory");
            f32x4 gv[2][2];
#pragma unroll
            for (int bj = 0; bj < 2; ++bj)
#pragma unroll
                for (int n = 0; n < 2; ++n) gv[bj][n] = *(const f32x4*)(kvg + bj * 128 + wc * 32 + fq * 8 + n * 4);
#pragma unroll
            for (int ai = 0; ai < 2; ++ai)
#pragma unroll
                for (int m = 0; m < 4; ++m) { const int rl = ai * 128 + rl0 + m * 16; const f32x4 p = *(const LAS f32x4*)(xl + rl * 4);
                    const float rstd = rsqrtf(((p[0] + p[1]) + (p[2] + p[3])) * (1.f / 256.f) + EPS);
                    const int row = u.pm * 256 + rl; size_t kvrow; float* o;
                    if (row < MP) { kvrow = row; o = out + OFF_CKVP + (size_t)row * 256; }
                    else { const int s = row - MP, b = s >> 6, t = s & 63; kvrow = (size_t)MP + b * 2112 + 2048 + t; o = out + OFF_CKVS + (size_t)s * 256; }
#pragma unroll
                    for (int bj = 0; bj < 2; ++bj) { const f32x4 v0 = acc[ai][bj][m][0] * rstd * gv[bj][0], v1 = acc[ai][bj][m][1] * rstd * gv[bj][1];
                        const int col = bj * 128 + wc * 32 + fq * 8;
                        __builtin_nontemporal_store(v0, (f32x4*)(o + col)); __builtin_nontemporal_store(v1, (f32x4*)(o + col + 4));
                        u32x4 w; w.x = cvt_pk_bf16(v0[0], v0[1]); w.y = cvt_pk_bf16(v0[2], v0[3]); w.z = cvt_pk_bf16(v1[0], v1[1]); w.w = cvt_pk_bf16(v1[2], v1[3]);
                        *(u32x4*)(CKV + kvrow * 256 + col) = w; } }
            LDS_WAIT(); __builtin_amdgcn_s_barrier(); asm volatile("" ::: "memory");
        } else {
            const int t2 = u.pn - 3;
#pragma unroll
            for (int ai = 0; ai < 2; ++ai)
#pragma unroll
                for (int m = 0; m < 4; ++m) { const int row = u.pm * 256 + ai * 128 + rl0 + m * 16; float s = 0.f;
#pragma unroll
                    for (int bj = 0; bj < 2; ++bj) { if (t2 == 1 && bj == 1) continue;
                        const f32x4 v0 = acc[ai][bj][m][0], v1 = acc[ai][bj][m][1];
                        s += (v0[0] * v0[0] + v0[1] * v0[1]) + (v0[2] * v0[2] + v0[3] * v0[3]) + (v1[0] * v1[0] + v1[1] * v1[1]) + (v1[2] * v1[2] + v1[3] * v1[3]);
                        u32x4 w; w.x = cvt_pk_bf16(v0[0], v0[1]); w.y = cvt_pk_bf16(v0[2], v0[3]); w.z = cvt_pk_bf16(v1[0], v1[1]); w.w = cvt_pk_bf16(v1[2], v1[3]);
                        *(u32x4*)(CQ + (size_t)row * 384 + t2 * 256 + bj * 128 + wc * 32 + fq * 8) = w; }
                    s += __shfl_xor(s, 16); s += __shfl_xor(s, 32);
                    if (fq == 0) SSQ[(size_t)row * 8 + t2 * 4 + wc] = s; }
            if (t2 == 1 && wc == 0) {
                const f32x4 g0 = *(const f32x4*)(krg + fq * 8), g1 = *(const f32x4*)(krg + fq * 8 + 4);
#pragma unroll
                for (int ai = 0; ai < 2; ++ai)
#pragma unroll
                    for (int m = 0; m < 4; ++m) { const int row = u.pm * 256 + ai * 128 + rl0 + m * 16;
                        f32x4 v0 = acc[ai][1][m][0], v1 = acc[ai][1][m][1];
                        float s = (v0[0] * v0[0] + v0[1] * v0[1]) + (v0[2] * v0[2] + v0[3] * v0[3]) + (v1[0] * v1[0] + v1[1] * v1[1]) + (v1[2] * v1[2] + v1[3] * v1[3]);
                        s += __shfl_xor(s, 16); s += __shfl_xor(s, 32);
                        const float rstd = rsqrtf(s * (1.f / 32.f) + EPS);
                        v0 = v0 * rstd * g0; v1 = v1 * rstd * g1;
                        int pos; size_t kvrow; float* o;
                        if (row < MP) { pos = row & 4095; kvrow = row; o = out + OFF_KRP + (size_t)row * 32; }
                        else { const int sr = row - MP, b = sr >> 6, t = sr & 63; pos = 2048 + t; kvrow = (size_t)MP + b * 2112 + 2048 + t; o = out + OFF_KRS + (size_t)sr * 32; }
                        const float* rp = rope + (size_t)pos * 32 + (fq & 1) * 8;
                        const f32x4 c0 = *(const f32x4*)rp, c1 = *(const f32x4*)(rp + 4), s0 = *(const f32x4*)(rp + 16), s1 = *(const f32x4*)(rp + 20);
                        f32x4 p0, p1;
#pragma unroll
                        for (int e = 0; e < 4; ++e) { p0[e] = __shfl_xor(v0[e], 32); p1[e] = __shfl_xor(v1[e], 32); }
                        const float sg = fq < 2 ? -1.f : 1.f;
                        const f32x4 r0 = v0 * c0 + p0 * s0 * sg, r1 = v1 * c1 + p1 * s1 * sg;
                        __builtin_nontemporal_store(r0, (f32x4*)(o + fq * 8)); __builtin_nontemporal_store(r1, (f32x4*)(o + fq * 8 + 4));
                        u32x4 w; w.x = cvt_pk_bf16(r0[0], r0[1]); w.y = cvt_pk_bf16(r0[2], r0[3]); w.z = cvt_pk_bf16(r1[0], r1[1]); w.w = cvt_pk_bf16(r1[2], r1[3]);
                        *(u32x4*)(KR + kvrow * 32 + fq * 8) = w; }
            }
        }
    }
};

struct ProgQ {
    int K, lda, ldb, G, c;
    const bf16_t* CQ; const bf16_t* Wt; const float* SSQ; bf16_t* Q; const float* rope; const float *qng, *qrg;
    static constexpr int NM = 130, NTOT = 130 * 3;
    __device__ __forceinline__ bool next(int i, Unit& u) const { const int L = i * G + c; if (L >= NTOT) return false; pg8::grouped(pg8::xcd_map(L, NTOT), NM, 3, u.pm, u.pn); u.kind = 0; return true; }
    __device__ __forceinline__ int nt(const Unit&) const { return K / 64; }
    __device__ __forceinline__ const char* aptr(const Unit& u) const { return (const char*)(CQ + (size_t)u.pm * 256 * 384); }
    __device__ __forceinline__ const char* bptr(const Unit& u) const { return (const char*)(Wt + (size_t)u.pn * 256 * 384); }
    __device__ __forceinline__ void epi(Acc& acc, const Unit& u, int wr, int wc, int fr, int fq) const {
        asm volatile("" : "+v"(fr), "+v"(fq));
        const int rl0 = wr * 64 + fr;
#pragma unroll
        for (int ai = 0; ai < 2; ++ai)
#pragma unroll
            for (int m = 0; m < 4; ++m) { const int row = u.pm * 256 + ai * 128 + rl0 + m * 16;
                const f32x4 q0 = *(const f32x4*)(SSQ + (size_t)row * 8), q1 = *(const f32x4*)(SSQ + (size_t)row * 8 + 4);
                const float rq = rsqrtf((((q0[0] + q0[1]) + (q0[2] + q0[3])) + ((q1[0] + q1[1]) + (q1[2] + q1[3]))) * (1.f / 384.f) + EPS);
                if (u.pn < 2) {
                    const int head = u.pn * 4 + wc; float s = 0.f; f32x4 v[2][2];
#pragma unroll
                    for (int bj = 0; bj < 2; ++bj)
#pragma unroll
                        for (int n = 0; n < 2; ++n) { v[bj][n] = acc[ai][bj][m][n] * rq; const f32x4 x = v[bj][n]; s += (x[0] * x[0] + x[1] * x[1]) + (x[2] * x[2] + x[3] * x[3]); }
                    s += __shfl_xor(s, 16); s += __shfl_xor(s, 32);
                    const float r2 = rsqrtf(s * (1.f / 64.f) + EPS) * QSCALE;
#pragma unroll
                    for (int bj = 0; bj < 2; ++bj) { const f32x4 g0 = *(const f32x4*)(qng + bj * 32 + fq * 8), g1 = *(const f32x4*)(qng + bj * 32 + fq * 8 + 4);
                        const f32x4 a = v[bj][0] * r2 * g0, b = v[bj][1] * r2 * g1;
                        u32x4 w; w.x = cvt_pk_bf16(a[0], a[1]); w.y = cvt_pk_bf16(a[2], a[3]); w.z = cvt_pk_bf16(b[0], b[1]); w.w = cvt_pk_bf16(b[2], b[3]);
                        *(u32x4*)(Q + (size_t)row * 768 + head * 96 + bj * 32 + fq * 8) = w; }
                } else {
                    const int pos = row < MP ? (row & 4095) : 2048 + ((row - MP) & 63);
                    const float* rp = rope + (size_t)pos * 32 + (fq & 1) * 8;
                    const f32x4 c0 = *(const f32x4*)rp, c1 = *(const f32x4*)(rp + 4), s0 = *(const f32x4*)(rp + 16), s1 = *(const f32x4*)(rp + 20);
                    const f32x4 g0 = *(const f32x4*)(qrg + fq * 8), g1 = *(const f32x4*)(qrg + fq * 8 + 4);
                    const float sg = fq < 2 ? -1.f : 1.f;
#pragma unroll
                    for (int bj = 0; bj < 2; ++bj) { const int head = bj * 4 + wc;
                        f32x4 v0 = acc[ai][bj][m][0] * rq, v1 = acc[ai][bj][m][1] * rq;
                        float s = (v0[0] * v0[0] + v0[1] * v0[1]) + (v0[2] * v0[2] + v0[3] * v0[3]) + (v1[0] * v1[0] + v1[1] * v1[1]) + (v1[2] * v1[2] + v1[3] * v1[3]);
                        s += __shfl_xor(s, 16); s += __shfl_xor(s, 32);
                        const float r2 = rsqrtf(s * (1.f / 32.f) + EPS);
                        v0 = v0 * r2 * g0; v1 = v1 * r2 * g1;
                        f32x4 p0, p1;
#pragma unroll
                        for (int e = 0; e < 4; ++e) { p0[e] = __shfl_xor(v0[e], 32); p1[e] = __shfl_xor(v1[e], 32); }
                        const f32x4 r0 = (v0 * c0 + p0 * s0 * sg) * QSCALE, r1 = (v1 * c1 + p1 * s1 * sg) * QSCALE;
                        u32x4 w; w.x = cvt_pk_bf16(r0[0], r0[1]); w.y = cvt_pk_bf16(r0[2], r0[3]); w.z = cvt_pk_bf16(r1[0], r1[1]); w.w = cvt_pk_bf16(r1[2], r1[3]);
                        *(u32x4*)(Q + (size_t)row * 768 + head * 96 + 64 + fq * 8) = w; }
                } }
    }
};

struct ProgKV {
    int K, lda, ldb, G, c;
    const bf16_t* CKV; const bf16_t* Wt; bf16_t *KN, *VVt; const float* kng;
    static constexpr int NM = 194, NA = 194 * 2, NTOT = 194 * 4;
    __device__ __forceinline__ bool next(int i, Unit& u) const {
        const int L = i * G + c; if (L >= NTOT) return false;
        const int w = pg8::xcd_map(L, NTOT);
        if (w < NA) { pg8::grouped(w, NM, 2, u.pm, u.pn); u.kind = 0; } else { pg8::grouped(w - NA, 2, NM, u.pm, u.pn); u.kind = 1; }
        return true;
    }
    __device__ __forceinline__ int nt(const Unit&) const { return K / 64; }
    __device__ __forceinline__ const char* aptr(const Unit& u) const { return u.kind == 0 ? (const char*)(CKV + (size_t)u.pm * 256 * 256) : (const char*)(Wt + (size_t)(512 + u.pm * 256) * 256); }
    __device__ __forceinline__ const char* bptr(const Unit& u) const { return u.kind == 0 ? (const char*)(Wt + (size_t)u.pn * 256 * 256) : (const char*)(CKV + (size_t)u.pn * 256 * 256); }
    __device__ __forceinline__ void epi(Acc& acc, const Unit& u, int wr, int wc, int fr, int fq) const {
        asm volatile("" : "+v"(fr), "+v"(fq));
        const int rl0 = wr * 64 + fr;
#pragma unroll
        for (int ai = 0; ai < 2; ++ai)
#pragma unroll
            for (int m = 0; m < 4; ++m) { const size_t row = (size_t)u.pm * 256 + ai * 128 + rl0 + m * 16;
                if (u.kind == 0) {
                    const int head = u.pn * 4 + wc; float s = 0.f;
#pragma unroll
                    for (int bj = 0; bj < 2; ++bj)
#pragma unroll
                        for (int n = 0; n < 2; ++n) { const f32x4 x = acc[ai][bj][m][n]; s += (x[0] * x[0] + x[1] * x[1]) + (x[2] * x[2] + x[3] * x[3]); }
                    s += __shfl_xor(s, 16); s += __shfl_xor(s, 32);
                    const float r2 = rsqrtf(s * (1.f / 64.f) + EPS);
#pragma unroll
                    for (int bj = 0; bj < 2; ++bj) { const f32x4 g0 = *(const f32x4*)(kng + bj * 32 + fq * 8), g1 = *(const f32x4*)(kng + bj * 32 + fq * 8 + 4);
                        const f32x4 a = acc[ai][bj][m][0] * r2 * g0, b = acc[ai][bj][m][1] * r2 * g1;
                        u32x4 w; w.x = cvt_pk_bf16(a[0], a[1]); w.y = cvt_pk_bf16(a[2], a[3]); w.z = cvt_pk_bf16(b[0], b[1]); w.w = cvt_pk_bf16(b[2], b[3]);
                        *(u32x4*)(KN + row * 512 + head * 64 + bj * 32 + fq * 8) = w; }
                } else {
#pragma unroll
                    for (int bj = 0; bj < 2; ++bj) { const f32x4 a = acc[ai][bj][m][0], b = acc[ai][bj][m][1];
                        u32x4 w; w.x = cvt_pk_bf16(a[0], a[1]); w.y = cvt_pk_bf16(a[2], a[3]); w.z = cvt_pk_bf16(b[0], b[1]); w.w = cvt_pk_bf16(b[2], b[3]);
                        *(u32x4*)(VVt + row * KVR + (size_t)u.pn * 256 + bj * 128 + wc * 32 + fq * 8) = w; }
                } }
    }
};

template <int MODE>
struct ProgRes {
    int K, lda, ldb, G, c, nsk;
    const bf16_t* Ab; const bf16_t* Wt; const float* xp; float* Y; bf16_t* X1; const float* gate; float* part;
    __device__ __forceinline__ bool next(int i, Unit& u) const {
        const int L = i * G + c; if (L >= 512 + 8 * nsk) return false;
        int pm, pn; pg8::grouped(pg8::xcd_map(L < 512 ? L : 0, 512), 128, 4, pm, pn);
        const int idx = L - 512, rem = idx & 7; const bool sp = L >= 512;
        u.pm = sp ? 128 + (rem >> 2) : pm; u.pn = sp ? (rem & 3) : pn; u.kind = sp ? 1 + (idx >> 3) : 0;
        return true;
    }
    __device__ __forceinline__ int nt(const Unit& u) const { return u.kind == 0 ? K / 64 : 4; }
    __device__ __forceinline__ const char* aptr(const Unit& u) const { return (const char*)(Ab + (size_t)u.pm * 256 * K + (u.kind ? (u.kind - 1) * 256 : 0)); }
    __device__ __forceinline__ const char* bptr(const Unit& u) const { return (const char*)(Wt + (size_t)u.pn * 256 * K + (u.kind ? (u.kind - 1) * 256 : 0)); }
    __device__ __forceinline__ void epi(Acc& acc, const Unit& u, int wr, int wc, int fr, int fq) const {
        asm volatile("" : "+v"(fr), "+v"(fq));
        const int rl0 = wr * 64 + fr;
        if (u.kind == 0) {
            const int b16 = u.pm >> 4;
#pragma unroll
            for (int ai = 0; ai < 2; ++ai) {
                f32x4 gv[2][2];
#pragma unroll
                for (int bj = 0; bj < 2; ++bj)
#pragma unroll
                    for (int n = 0; n < 2; ++n) gv[bj][n] = *(const f32x4*)(gate + (size_t)b16 * 6144 + u.pn * 256 + bj * 128 + wc * 32 + fq * 8 + n * 4);
#pragma unroll
                for (int m = 0; m < 4; ++m) { const int row = u.pm * 256 + ai * 128 + rl0 + m * 16;
#pragma unroll
                    for (int bj = 0; bj < 2; ++bj) { const int col = u.pn * 256 + bj * 128 + wc * 32 + fq * 8;
                        if constexpr (MODE == 0) {
                            const float* bp = xp + (size_t)row * DM;
                            const f32x4 r0 = *(const f32x4*)(bp + col) + gv[bj][0] * acc[ai][bj][m][0], r1 = *(const f32x4*)(bp + col + 4) + gv[bj][1] * acc[ai][bj][m][1];
                            u32x4 w; w.x = cvt_pk_bf16(r0[0], r0[1]); w.y = cvt_pk_bf16(r0[2], r0[3]); w.z = cvt_pk_bf16(r1[0], r1[1]); w.w = cvt_pk_bf16(r1[2], r1[3]);
                            *(u32x4*)(X1 + (size_t)row * DM + col) = w;
                        } else {
                            const u32x4 w = *(const u32x4*)(X1 + (size_t)row * DM + col);
                            const f32x4 b0 = (f32x4){__uint_as_float(w.x << 16), __uint_as_float(w.x & 0xffff0000u), __uint_as_float(w.y << 16), __uint_as_float(w.y & 0xffff0000u)};
                            const f32x4 b1 = (f32x4){__uint_as_float(w.z << 16), __uint_as_float(w.z & 0xffff0000u), __uint_as_float(w.w << 16), __uint_as_float(w.w & 0xffff0000u)};
                            __builtin_nontemporal_store(b0 + gv[bj][0] * acc[ai][bj][m][0], (f32x4*)(Y + (size_t)row * DM + col));
                            __builtin_nontemporal_store(b1 + gv[bj][1] * acc[ai][bj][m][1], (f32x4*)(Y + (size_t)row * DM + col + 4));
                        } } }
            }
        } else {
            float* pb = part + (size_t)(u.kind - 1) * 512 * DM;
#pragma unroll
            for (int ai = 0; ai < 2; ++ai)
#pragma unroll
                for (int m = 0; m < 4; ++m) { const int srow = (u.pm - 128) * 256 + ai * 128 + rl0 + m * 16;
#pragma unroll
                    for (int bj = 0; bj < 2; ++bj) { const int col = u.pn * 256 + bj * 128 + wc * 32 + fq * 8;
                        *(f32x4*)(pb + (size_t)srow * DM + col) = acc[ai][bj][m][0];
                        *(f32x4*)(pb + (size_t)srow * DM + col + 4) = acc[ai][bj][m][1]; } }
        }
    }
};

struct ProgFfn {
    int K, lda, ldb, G, c;
    const bf16_t* Ab; const bf16_t* Wt; bf16_t* Gb;
    static constexpr int NM = 130, NN = 22, NTOT = 130 * 22;
    __device__ __forceinline__ bool next(int i, Unit& u) const { const int L = i * G + c; if (L >= NTOT) return false; pg8::grouped(pg8::xcd_map(L, NTOT), NM, NN, u.pm, u.pn); u.kind = 0; return true; }
    __device__ __forceinline__ int nt(const Unit&) const { return K / 64; }
    __device__ __forceinline__ const char* aptr(const Unit& u) const { return (const char*)(Ab + (size_t)u.pm * 256 * DM); }
    __device__ __forceinline__ const char* bptr(const Unit& u) const { return (const char*)(Wt + (size_t)u.pn * 256 * DM); }
    __device__ __forceinline__ void epi(Acc& acc, const Unit& u, int wr, int wc, int fr, int fq) const {
        asm volatile("" : "+v"(fr), "+v"(fq));
        const int rl0 = wr * 64 + fr;
#pragma unroll
        for (int ai = 0; ai < 2; ++ai)
#pragma unroll
            for (int m = 0; m < 4; ++m) { const size_t row = (size_t)u.pm * 256 + ai * 128 + rl0 + m * 16;
                const f32x4 g0 = acc[ai][0][m][0], g1 = acc[ai][0][m][1], u0 = acc[ai][1][m][0], u1 = acc[ai][1][m][1];
                const f32x2v sa = silu_mul2((f32x2v){g0[0], g0[1]}, (f32x2v){u0[0], u0[1]}), sb = silu_mul2((f32x2v){g0[2], g0[3]}, (f32x2v){u0[2], u0[3]});
                const f32x2v sc = silu_mul2((f32x2v){g1[0], g1[1]}, (f32x2v){u1[0], u1[1]}), sd = silu_mul2((f32x2v){g1[2], g1[3]}, (f32x2v){u1[2], u1[3]});
                u32x4 w; w.x = cvt_pk_bf16(sa.x, sa.y); w.y = cvt_pk_bf16(sb.x, sb.y); w.z = cvt_pk_bf16(sc.x, sc.y); w.w = cvt_pk_bf16(sd.x, sd.y);
                *(u32x4*)(Gb + row * DFF + u.pn * 128 + wc * 32 + fq * 8) = w; }
    }
};

__device__ __forceinline__ void p0_transpose_item(const float* W, int ldw, int c0, int k0, bf16_t* WT, int K, int n0, const float* kscale, LAS float* scr, int lane) {
#pragma unroll
    for (int i = 0; i < 32; ++i) { const int kk = 2 * i + (lane >> 5); float v = 0.f;
        if (c0 >= 0) v = __builtin_nontemporal_load(W + (size_t)(k0 + kk) * ldw + c0 + (lane & 31));
        if (kscale) v *= kscale[k0 + kk];
        scr[kk * 33 + (lane & 31)] = v; }
    LDS_WAIT(); asm volatile("" ::: "memory");
    const int c = lane & 7;
#pragma unroll
    for (int j = 0; j < 4; ++j) { const int n = (lane >> 3) + 8 * j; const LAS float* s = scr + (8 * c) * 33 + n;
        u32x4 o; o.x = cvt_pk_bf16(s[0 * 33], s[1 * 33]); o.y = cvt_pk_bf16(s[2 * 33], s[3 * 33]); o.z = cvt_pk_bf16(s[4 * 33], s[5 * 33]); o.w = cvt_pk_bf16(s[6 * 33], s[7 * 33]);
        *(u32x4*)(WT + (size_t)(n0 + n) * K + k0 + 8 * c) = o; }
    LDS_WAIT(); asm volatile("" ::: "memory");
}
__device__ __forceinline__ void norm_load(const float* xrow, f32x4 (&v)[4], int lane) {
#pragma unroll
    for (int j = 0; j < 4; ++j) v[j] = __builtin_nontemporal_load((const f32x4*)xrow + lane + 64 * j);
}
__device__ __forceinline__ void norm_apply(const f32x4 (&v)[4], const float* g, const float* sc, const float* sh, bf16_t* orow, int lane) {
    float s = 0.f;
#pragma unroll
    for (int j = 0; j < 4; ++j) s += (v[j][0] * v[j][0] + v[j][1] * v[j][1]) + (v[j][2] * v[j][2] + v[j][3] * v[j][3]);
    const float rstd = rsqrtf(wave_sum(s) * (1.f / 1024.f) + EPS);
#pragma unroll
    for (int j = 0; j < 4; ++j) { const int c4 = lane + 64 * j;
        const f32x4 gg = *((const f32x4*)g + c4), cc = *((const f32x4*)sc + c4), hh = *((const f32x4*)sh + c4);
        const f32x4 h = v[j] * rstd * gg * (cc + 1.f) + hh;
        u32x2 w; w.x = cvt_pk_bf16(h[0], h[1]); w.y = cvt_pk_bf16(h[2], h[3]);
        *((u32x2*)orow + c4) = w; }
}
__device__ __forceinline__ void sample_combine(const float* gate, const float* part, int nsk, int srow, f32x4 (&v)[4], int lane) {
#pragma unroll
    for (int j = 0; j < 4; ++j) { const int c4 = lane + 64 * j; f32x4 a = (f32x4){0.f, 0.f, 0.f, 0.f};
        for (int k = 0; k < nsk; ++k) a += *((const f32x4*)(part + ((size_t)k * 512 + srow) * DM) + c4);
        v[j] = v[j] + *((const f32x4*)gate + c4) * a; }
}
__device__ __forceinline__ void row_load_bf16(const bf16_t* row, f32x4 (&v)[4], int lane) {
#pragma unroll
    for (int j = 0; j < 4; ++j) { const u32x2 w = __builtin_nontemporal_load((const u32x2*)row + lane + 64 * j);
        v[j] = (f32x4){__uint_as_float(w.x << 16), __uint_as_float(w.x & 0xffff0000u), __uint_as_float(w.y << 16), __uint_as_float(w.y & 0xffff0000u)}; }
}
__device__ __forceinline__ void row_store_bf16(bf16_t* row, const f32x4 (&v)[4], int lane) {
#pragma unroll
    for (int j = 0; j < 4; ++j) { u32x2 w; w.x = cvt_pk_bf16(v[j][0], v[j][1]); w.y = cvt_pk_bf16(v[j][2], v[j][3]); *((u32x2*)row + lane + 64 * j) = w; }
}

constexpr int GM_PITCH = 272;
__device__ __forceinline__ void gmlp_phase(LAS unsigned char* lds, int it0, int G, const bf16_t* Wm, const bf16_t* Vt, const bf16_t* U, const float* bs, bf16_t* YAB) {
    const int tid = fresh_tid(), lane = tid & 63, wid = __builtin_amdgcn_readfirstlane(tid >> 6), fr = lane & 15, fq = lane >> 4;
    constexpr int NIT = 1024 + 32;
    u32x4 st[4];
#define GM_LOAD(item) do { const bool samp_ = (item) >= 1024; const int g_ = (item) & 3; const int tok_ = samp_ ? MP + 64 * (((item) - 1024) >> 2) : 128 * ((item) >> 2); \
        _Pragma("unroll") for (int q = 0; q < 4; ++q) { const int c_ = tid + 512 * q, row_ = c_ >> 4, ch_ = c_ & 15; \
            if (!samp_ || ch_ < 8) st[q] = __builtin_nontemporal_load((const u32x4*)(Vt + (size_t)(128 * g_ + row_) * MT + tok_ + ch_ * 8)); else st[q] = (u32x4){0u, 0u, 0u, 0u}; } } while (0)
    int item = it0;
    if (item < NIT) GM_LOAD(item);
    for (; item < NIT; item += G) {
        const bool samp = item >= 1024; const int g = item & 3;
        const int tok0 = samp ? MP + 64 * ((item - 1024) >> 2) : 128 * (item >> 2);
        const bool active = !(samp && wid >= 4);
        const int nk = (samp || wid < 4) ? 2 : 4;
        const int row = tok0 + 16 * wid + fr;
        bf16x8 bfr[4]; u32x2 uu8[8]; float bias = 0.f;
        if (active) {
            const bf16_t* wrow = Wm + (size_t)(g * 128 + 16 * wid + fr) * 128 + 8 * fq;
#pragma unroll
            for (int kk = 0; kk < 4; ++kk) bfr[kk] = *(const bf16x8*)(wrow + 32 * kk);
#pragma unroll
            for (int n = 0; n < 8; ++n) uu8[n] = __builtin_nontemporal_load((const u32x2*)(U + (size_t)row * 512 + 128 * g + 16 * n + 4 * fq));
            bias = bs[g * 128 + 16 * wid + fr];
        }
#pragma unroll
        for (int q = 0; q < 4; ++q) { const int c = tid + 512 * q; *(LAS u32x4*)(lds + (c >> 4) * GM_PITCH + (c & 15) * 16) = st[q]; }
        __syncthreads();
        if (item + G < NIT) GM_LOAD(item + G);
        if (active) {
            f32x4 acc[8];
#pragma unroll
            for (int n = 0; n < 8; ++n) acc[n] = (f32x4){0.f, 0.f, 0.f, 0.f};
            const LAS unsigned char* ab = lds + fr * GM_PITCH + fq * 16;
#pragma unroll
            for (int kk = 0; kk < 4; ++kk) { if (kk < nk) {
#pragma unroll
                for (int n = 0; n < 8; ++n) { const bf16x8 afr = *(const LAS bf16x8*)(ab + (16 * n) * GM_PITCH + kk * 64);
                    acc[n] = __builtin_amdgcn_mfma_f32_16x16x32_bf16(afr, bfr[kk], acc[n], 0, 0, 0); } } }
#pragma unroll
            for (int n = 0; n < 8; ++n) { const int col = 128 * g + 16 * n + 4 * fq; const u32x2 uu = uu8[n];
                const float y0 = __uint_as_float(uu.x << 16) * (acc[n][0] + bias), y1 = __uint_as_float(uu.x & 0xffff0000u) * (acc[n][1] + bias);
                const float y2 = __uint_as_float(uu.y << 16) * (acc[n][2] + bias), y3 = __uint_as_float(uu.y & 0xffff0000u) * (acc[n][3] + bias);
                u32x2 w; w.x = cvt_pk_bf16(y0, y1); w.y = cvt_pk_bf16(y2, y3);
                *(u32x2*)(YAB + (size_t)row * DM + col) = w; }
        }
        __syncthreads();
    }
#undef GM_LOAD
}

constexpr int KPITCH = 208, VPITCH = 136, KBUF = 64 * KPITCH, VBUF = 64 * VPITCH, ATT_V0 = 2 * KBUF;
template <bool QK, bool SM>
__device__ __forceinline__ void attn_step(const LAS unsigned char* kb, const LAS unsigned char* vbp, const bf16x8 (&qr)[6],
                                          f32x16& s0, f32x16& s1, f32x16& o0, f32x16& o1, float& mrow, float& lsum) {
    f32x16 n0 = {}, n1 = {};
    if constexpr (QK) {
#pragma unroll
        for (int s = 0; s < 6; ++s) { const bf16x8 ka = *(const LAS bf16x8*)(kb + s * 32), kc = *(const LAS bf16x8*)(kb + 32 * KPITCH + s * 32);
            n0 = __builtin_amdgcn_mfma_f32_32x32x16_bf16(ka, qr[s], n0, 0, 0, 0); n1 = __builtin_amdgcn_mfma_f32_32x32x16_bf16(kc, qr[s], n1, 0, 0, 0); }
    }
    if constexpr (SM) {
        float mx = max3f(s0[0], s1[0], s0[1]); mx = max3f(mx, s1[1], s0[2]); float my = max3f(s1[2], s0[3], s1[3]);
#pragma unroll
        for (int r = 4; r < 16; r += 4) { mx = max3f(mx, s0[r], s1[r]); my = max3f(my, s0[r + 1], s1[r + 1]); mx = max3f(mx, s0[r + 2], s1[r + 2]); my = max3f(my, s0[r + 3], s1[r + 3]); }
        mx = fmaxf(mx, my);
        { const auto rr = __builtin_amdgcn_permlane32_swap(__float_as_uint(mx), __float_as_uint(mx), false, false); mx = fmaxf(__uint_as_float(rr[0]), __uint_as_float(rr[1])); }
        const float mnew = fmaxf(mrow, mx), alpha = __builtin_amdgcn_exp2f(mrow - mnew); mrow = mnew;
        const f32x2 m2 = (f32x2){mnew, mnew}; f32x2 ps2 = (f32x2){0.f, 0.f};
#pragma unroll
        for (int r = 0; r < 16; r += 2) { f32x2 a = (f32x2){s0[r], s0[r + 1]} - m2, b = (f32x2){s1[r], s1[r + 1]} - m2;
            a.x = __builtin_amdgcn_exp2f(a.x); a.y = __builtin_amdgcn_exp2f(a.y); b.x = __builtin_amdgcn_exp2f(b.x); b.y = __builtin_amdgcn_exp2f(b.y);
            s0[r] = a.x; s0[r + 1] = a.y; s1[r] = b.x; s1[r + 1] = b.y; ps2 += a + b; }
        const float ps = ps2.x + ps2.y;
        lsum = lsum * alpha + ps;
#pragma unroll
        for (int r = 0; r < 16; ++r) { o0[r] *= alpha; o1[r] *= alpha; }
        bf16x8 pb[4];
#pragma unroll
        for (int S = 0; S < 4; ++S) { u32x4 w;
            if (S < 2) { w.x = cvt_pk_bf16(s0[8 * S + 0], s0[8 * S + 1]); w.y = cvt_pk_bf16(s0[8 * S + 2], s0[8 * S + 3]); w.z = cvt_pk_bf16(s0[8 * S + 4], s0[8 * S + 5]); w.w = cvt_pk_bf16(s0[8 * S + 6], s0[8 * S + 7]); }
            else { w.x = cvt_pk_bf16(s1[8 * S - 16], s1[8 * S - 15]); w.y = cvt_pk_bf16(s1[8 * S - 14], s1[8 * S - 13]); w.z = cvt_pk_bf16(s1[8 * S - 12], s1[8 * S - 11]); w.w = cvt_pk_bf16(s1[8 * S - 10], s1[8 * S - 9]); }
            pb[S] = __builtin_bit_cast(bf16x8, w); }
#pragma unroll
        for (int S = 0; S < 4; ++S) {
            const u32x2 a0 = *(const LAS u32x2*)(vbp + S * 32), a1 = *(const LAS u32x2*)(vbp + S * 32 + 16);
            const u32x2 c0 = *(const LAS u32x2*)(vbp + 32 * VPITCH + S * 32), c1 = *(const LAS u32x2*)(vbp + 32 * VPITCH + S * 32 + 16);
            const bf16x8 va = __builtin_bit_cast(bf16x8, (u32x4){a0.x, a0.y, a1.x, a1.y}), vc = __builtin_bit_cast(bf16x8, (u32x4){c0.x, c0.y, c1.x, c1.y});
            o0 = __builtin_amdgcn_mfma_f32_32x32x16_bf16(va, pb[S], o0, 0, 0, 0); o1 = __builtin_amdgcn_mfma_f32_32x32x16_bf16(vc, pb[S], o1, 0, 0, 0); }
    }
    s0 = n0; s1 = n1;
}
__device__ __forceinline__ void attn_unit(LAS unsigned char* lds, const bf16_t* Qrow0, int nqw, int limbase, bool prompt, size_t kv0, int NT, int h,
                                          const bf16_t* KN, const bf16_t* KR, const bf16_t* VVt, bf16_t* Yrow0, unsigned* tkctr, int& tick) {
    const int tid = fresh_tid(), lane = tid & 63, wid = __builtin_amdgcn_readfirstlane(tid >> 6), r32 = lane & 31, hi = lane >> 5;
    const int lim = wid < nqw ? (prompt ? limbase + (wid >> 1) + 1 : NT) : 0;
    const int kr0 = tid / 12, kp0 = tid % 12, kr1 = (tid + 512) / 12, kp1 = (tid + 512) % 12;
    const bf16_t* ksrc0 = kp0 < 8 ? KN + (kv0 + kr0) * 512 + h * 64 + kp0 * 8 : KR + (kv0 + kr0) * 32 + (kp0 - 8) * 8;
    const size_t kstr0 = kp0 < 8 ? 512 * 64 : 32 * 64;
    const bf16_t* ksrc1 = kp1 < 8 ? KN + (kv0 + kr1) * 512 + h * 64 + kp1 * 8 : KR + (kv0 + kr1) * 32 + (kp1 - 8) * 8;
    const size_t kstr1 = kp1 < 8 ? 512 * 64 : 32 * 64;
    const bool k1 = tid < 256;
    const bf16_t* vsrc = VVt + (size_t)(h * 64 + (tid >> 3)) * KVR + kv0 + (tid & 7) * 8;
    const int kd0 = kr0 * KPITCH + kp0 * 16, kd1 = kr1 * KPITCH + kp1 * 16, vd = (tid >> 3) * VPITCH + (tid & 7) * 16;
    u32x4 ak0, ak1, av, bk0, bk1, bv;
    const bf16_t* ksrc1c = k1 ? ksrc1 : ksrc0; const size_t kstr1c = k1 ? kstr1 : kstr0;
    const int ntm = NT - 1;
#define ATT_LDK(K0, K1, t) do { const int t_ = (t) < ntm ? (t) : ntm; K0 = *(const u32x4*)(ksrc0 + (size_t)t_ * kstr0); K1 = *(const u32x4*)(ksrc1c + (size_t)t_ * kstr1c); } while (0)
#define ATT_LDV(V, t) do { const int t_ = (t) < ntm ? (t) : ntm; V = *(const u32x4*)(vsrc + (size_t)t_ * 64); } while (0)
#define ATT_STK(K0, K1, b) do { *(LAS u32x4*)(lds + (b) * KBUF + kd0) = K0; if (k1) *(LAS u32x4*)(lds + (b) * KBUF + kd1) = K1; } while (0)
#define ATT_STV(V, b) do { *(LAS u32x2*)(lds + ATT_V0 + (b) * VBUF + vd) = (u32x2){V.x, V.y}; *(LAS u32x2*)(lds + ATT_V0 + (b) * VBUF + vd + 8) = (u32x2){V.z, V.w}; } while (0)
#define ATT_BAR() asm volatile("s_waitcnt lgkmcnt(0)\n\ts_barrier" ::: "memory")
    ATT_LDK(ak0, ak1, 0); ATT_LDV(av, 0); ATT_LDK(bk0, bk1, 1);
    bf16x8 qr[6];
    if (wid < nqw) {
#pragma unroll
        for (int s = 0; s < 6; ++s) qr[s] = *(const bf16x8*)(Qrow0 + (size_t)(wid * 32 + r32) * 768 + h * 96 + s * 16 + hi * 8);
    } else {
#pragma unroll
        for (int s = 0; s < 6; ++s) qr[s] = (bf16x8){0, 0, 0, 0, 0, 0, 0, 0};
    }
    ATT_STK(ak0, ak1, 0); ATT_STV(av, 0); ATT_STK(bk0, bk1, 1);
    ATT_LDK(ak0, ak1, 2); ATT_LDV(av, 1);
    ATT_BAR();
    float mrow = -1e30f, lsum = 0.f; f32x16 o0 = {}, o1 = {}, s0 = {}, s1 = {};
    if (wid >= 4) __builtin_amdgcn_s_setprio(1);
    const LAS unsigned char* kbase = lds + r32 * KPITCH + hi * 16;
    const LAS unsigned char* vbase = lds + ATT_V0 + r32 * VPITCH + hi * 8;
    if (lim > 0) attn_step<true, false>(kbase, vbase, qr, s0, s1, o0, o1, mrow, lsum);
    ATT_BAR();
    if (tkctr && tid == 0) tick = (int)atomicAdd(tkctr, 1u);
#define ATT_ITER(t, XK0, XK1, XV, YK0, YK1, YV) do { const int buf_ = (t) & 1; \
        ATT_LDK(YK0, YK1, (t) + 3); ATT_LDV(YV, (t) + 2); \
        if ((t) + 1 < lim) attn_step<true, true>(kbase + (buf_ ^ 1) * KBUF, vbase + buf_ * VBUF, qr, s0, s1, o0, o1, mrow, lsum); \
        else if ((t) < lim) attn_step<false, true>(kbase + (buf_ ^ 1) * KBUF, vbase + buf_ * VBUF, qr, s0, s1, o0, o1, mrow, lsum); \
        ATT_STK(XK0, XK1, buf_); ATT_STV(XV, buf_ ^ 1); \
        ATT_BAR(); } while (0)
    for (int t = 0; t < NT; t += 2) {
        ATT_ITER(t, ak0, ak1, av, bk0, bk1, bv);
        if (t + 1 < NT) ATT_ITER(t + 1, bk0, bk1, bv, ak0, ak1, av);
    }
    asm volatile("s_waitcnt vmcnt(0)" ::: "memory");
    __builtin_amdgcn_s_setprio(0);
#undef ATT_LDK
#undef ATT_LDV
#undef ATT_STK
#undef ATT_STV
#undef ATT_ITER
    if (wid < nqw) {
        lsum += __shfl_xor(lsum, 32);
        const float inv = 1.f / lsum;
        bf16_t* yp = Yrow0 + (size_t)(wid * 32 + r32) * DM + 512 + h * 64 + 4 * hi;
#pragma unroll
        for (int g = 0; g < 4; ++g) {
            u32x2 w; w.x = cvt_pk_bf16(o0[4 * g] * inv, o0[4 * g + 1] * inv); w.y = cvt_pk_bf16(o0[4 * g + 2] * inv, o0[4 * g + 3] * inv);
            *(u32x2*)(yp + 8 * g) = w;
            u32x2 x; x.x = cvt_pk_bf16(o1[4 * g] * inv, o1[4 * g + 1] * inv); x.y = cvt_pk_bf16(o1[4 * g + 2] * inv, o1[4 * g + 3] * inv);
            *(u32x2*)(yp + 32 + 8 * g) = x; }
    }
}


#define XB_TMO      128
#define XB_XCNT(j)  (256  + 64 * (j))
#define XB_XSUB(j)  (1280 + 64 * (j))
#define XB_XGEN(j)  (2304 + 64 * (j))
#define XB_TOP      3328
#define XB_TOPGEN   3392
#define XCD_BAR_WORDS 3456
#define XB_SPIN_CAP (1u << 18)
__device__ __forceinline__ unsigned xb_ld(unsigned* p)              { return __hip_atomic_load(p, __ATOMIC_RELAXED, __HIP_MEMORY_SCOPE_AGENT); }
__device__ __forceinline__ unsigned xb_add(unsigned* p, unsigned v) { return __hip_atomic_fetch_add(p, v, __ATOMIC_RELAXED, __HIP_MEMORY_SCOPE_AGENT); }
__device__ __forceinline__ unsigned xb_xcc_id() { return (unsigned)__builtin_amdgcn_s_getreg((3 << 11) | 20) & 0xFu; }
#define XB_SPIN(cond, bar) do { unsigned _sp = 0; while (cond) { __builtin_amdgcn_s_sleep(1); \
    if ((++_sp & 255u) == 0u) { if (xb_ld(&(bar)[XB_TMO])) break; if (_sp > XB_SPIN_CAP) { atomicAdd(&(bar)[XB_TMO], 1u); break; } } } } while (0)
struct XcdBarrier { unsigned* bar; unsigned x; volatile LAS unsigned* st; };
__device__ __forceinline__ XcdBarrier xcd_barrier_post(unsigned* bar, volatile LAS unsigned* st) {
    XcdBarrier b; b.bar = bar; b.x = xb_xcc_id(); b.st = st;
    if (threadIdx.x == 0) (void)xb_add(&bar[XB_XCNT(b.x)], 1u);
    return b;
}
__device__ __forceinline__ void xcd_barrier_complete(unsigned* bar, unsigned x, unsigned& nloc, unsigned& nx) {
    const unsigned G = gridDim.x * gridDim.y * gridDim.z;
    unsigned sum, cnt, mine, sp = 0u;
    for (;;) {
        sum = 0u; cnt = 0u; mine = 0u;
#pragma unroll
        for (unsigned j = 0; j < 16; ++j) { const unsigned c = xb_ld(&bar[XB_XCNT(j)]); sum += c; cnt += (c > 0u) ? 1u : 0u; mine = (j == x) ? c : mine; }
        if (sum == G) break;
        __builtin_amdgcn_s_sleep(1);
        if ((++sp & 255u) == 0u) { if (xb_ld(&bar[XB_TMO])) break; if (sp > XB_SPIN_CAP) { atomicAdd(&bar[XB_TMO], 1u); break; } }
    }
    nloc = mine > 0u ? mine : 1u; nx = cnt > 0u ? cnt : 1u;
}
__device__ __forceinline__ void xcd_barrier(const XcdBarrier& b) {
    asm volatile("s_waitcnt vmcnt(0)" ::: "memory");
    __syncthreads();
    if (threadIdx.x == 0) {
        unsigned* bar = b.bar;
        __builtin_amdgcn_s_waitcnt(0);
        unsigned nloc = b.st[0], nx = b.st[1];
        if (nloc == 0u) { xcd_barrier_complete(bar, b.x, nloc, nx); b.st[0] = nloc; b.st[1] = nx; }
        const unsigned old = xb_add(&bar[XB_XSUB(b.x)], 1u);
        const unsigned gen = old / nloc;
        if (old + 1u == (gen + 1u) * nloc) {
            __builtin_amdgcn_fence(__ATOMIC_RELEASE, "agent");
            asm volatile("s_waitcnt vmcnt(0)" ::: "memory");
            const unsigned og = xb_add(&bar[XB_TOP], 1u);
            const unsigned tg = og / nx;
            if (og + 1u == (tg + 1u) * nx) xb_add(&bar[XB_TOPGEN], 1u);
            else XB_SPIN(xb_ld(&bar[XB_TOPGEN]) == tg, bar);
            __builtin_amdgcn_fence(__ATOMIC_ACQUIRE, "agent");
            xb_add(&bar[XB_XGEN(b.x)], 1u);
            asm volatile("s_waitcnt vmcnt(0)" ::: "memory");
        } else {
            XB_SPIN(xb_ld(&bar[XB_XGEN(b.x)]) == gen, bar);
            __builtin_amdgcn_fence(__ATOMIC_ACQUIRE, "agent");
            asm volatile("s_waitcnt vmcnt(0)" ::: "memory");
        }
    }
    __syncthreads();
}

__global__ void __launch_bounds__(512, 2) mega_fwd(Args a) {
    extern __shared__ __attribute__((aligned(16))) unsigned char lds_raw[];
    LAS unsigned char* lds = (LAS unsigned char*)lds_raw;
    cg::grid_group grid = cg::this_grid();
    const int G = gridDim.x, bx = blockIdx.x;
#define FRESH_IDS() const int tid = fresh_tid(), lane = tid & 63, wid = __builtin_amdgcn_readfirstlane(tid >> 6); (void)tid; (void)lane; (void)wid
    unsigned char* ws = a.ws;
    const float *x_p = a.in[0], *x_s = a.in[1], *cache_ckv = a.in[2], *cache_kr = a.in[3], *c_p = a.in[4], *c_s = a.in[5], *w_ada = a.in[6], *b_ada = a.in[7],
                *norm1_g = a.in[8], *w_in = a.in[9], *w_s = a.in[10], *b_s = a.in[11], *q_norm_g = a.in[12], *w_uq = a.in[13], *kv_norm_g = a.in[14], *w_ukv = a.in[15],
                *qn_g = a.in[16], *qr_g = a.in[17], *kn_g = a.in[18], *kr_g = a.in[19], *w_out = a.in[20], *norm2_g = a.in[21], *w_fi = a.in[22], *w_fo = a.in[23];
    float* out = a.out;
    float* PART = (float*)(ws + WS_PART); bf16_t* X1B = (bf16_t*)(ws + WS_X1B);
    float* MOD = (float*)(ws + WS_MOD); float* ROPE = (float*)(ws + WS_ROPE); float* SSQ = (float*)(ws + WS_SSQ);
    bf16_t *Wm = (bf16_t*)(ws + WS_WM), *Wt_in = (bf16_t*)(ws + WS_WIN), *Wt_uq = (bf16_t*)(ws + WS_WUQ), *Wt_ukv = (bf16_t*)(ws + WS_WUKV), *Wt_out = (bf16_t*)(ws + WS_WOUT),
           *Wt_fi = (bf16_t*)(ws + WS_WFI), *Wt_fo = (bf16_t*)(ws + WS_WFO), *Hb = (bf16_t*)(ws + WS_H), *YAB = (bf16_t*)(ws + WS_YAB), *Gb = (bf16_t*)(ws + WS_G),
           *Ub = (bf16_t*)(ws + WS_U), *Vt = (bf16_t*)(ws + WS_VT), *CQ = (bf16_t*)(ws + WS_CQ), *CKV = (bf16_t*)(ws + WS_CKV), *KR = (bf16_t*)(ws + WS_KR),
           *KN = (bf16_t*)(ws + WS_KN), *VVt = (bf16_t*)(ws + WS_VVT), *Qb = (bf16_t*)(ws + WS_Q);

    { const int t0 = threadIdx.x; if (t0 < 2) ((volatile LAS unsigned*)(lds + LDS_X + 8192))[t0] = 0u; }
    __syncthreads();
    const XcdBarrier xbar = xcd_barrier_post((unsigned*)(ws + WS_BAR), (volatile LAS unsigned*)(lds + LDS_X + 8192));
    {
        FRESH_IDS();
        for (int it = bx; it < 96; it += G) {
            LAS float* sl = (LAS float*)lds; LAS float* red = (LAS float*)(lds + 65536);
            for (int e = tid; e < 16384; e += 512) { const int r = e >> 10, k = e & 1023; const float c = r < 8 ? c_p[r * 1024 + k] : c_s[(r - 8) * 1024 + k]; sl[e] = silu_f(c); }
            __syncthreads();
            float acc[16];
#pragma unroll
            for (int r = 0; r < 16; ++r) acc[r] = 0.f;
            const float* wp = w_ada + (size_t)(wid * 128) * 6144 + it * 64 + lane;
            for (int k = 0; k < 128; k += 16) {
                float wv[16];
#pragma unroll
                for (int j = 0; j < 16; ++j) wv[j] = __builtin_nontemporal_load(wp + (size_t)(k + j) * 6144);
#pragma unroll
                for (int jj = 0; jj < 4; ++jj)
#pragma unroll
                    for (int r = 0; r < 16; ++r) { const f32x4 s4 = *(const LAS f32x4*)(sl + r * 1024 + wid * 128 + k + 4 * jj);
                        acc[r] += (s4[0] * wv[4 * jj] + s4[1] * wv[4 * jj + 1]) + (s4[2] * wv[4 * jj + 2] + s4[3] * wv[4 * jj + 3]); }
            }
#pragma unroll
            for (int r = 0; r < 16; ++r) red[(wid * 16 + r) * 64 + lane] = acc[r];
            __syncthreads();
            for (int e = tid; e < 1024; e += 512) { const int r = e >> 6, col = e & 63; float s = b_ada[it * 64 + col];
#pragma unroll
                for (int w = 0; w < 8; ++w) s += red[(w * 16 + r) * 64 + col];
                MOD[(size_t)r * 6144 + it * 64 + col] = s; }
            __syncthreads();
        }
        LAS float* scr = (LAS float*)(lds + wid * 16384);
        const bool ada_wg = (G > 128) && bx < 96;
        const int gw = ada_wg ? 0x7fffffff : ((G > 128 ? bx - 96 : bx) * 8 + wid), NGW = (G > 128 ? G - 96 : G) * 8;
        constexpr int I_IN = 16 * 56, I_UQ = 6 * 24, I_UKV = 4 * 32, I_OUT = 16 * 32, I_FI = 16 * 176, I_FO = 44 * 32, I_CKV = 4096, I_CKR = 2048, I_ROPE = 1024, I_WM = 1024;
        constexpr int NITEMS = I_IN + I_UQ + I_UKV + I_OUT + I_FI + I_FO + I_CKV + I_CKR + I_ROPE + I_WM;
        for (int it = gw; it < NITEMS; it += NGW) {
            int r = it;
            if (r < I_IN) { const int kb = r / 56, nb = r % 56, n0 = nb * 32;
                const int c0 = n0 < 512 ? n0 : n0 < 768 ? 1408 + (n0 - 512) : n0 < 1152 ? 1024 + (n0 - 768) : n0 < 1184 ? 1664 : n0 < 1280 ? -1 : 512 + (n0 - 1280);
                p0_transpose_item(w_in, 1696, c0, kb * 64, Wt_in, 1024, n0, nullptr, scr, lane); continue; } r -= I_IN;
            if (r < I_UQ) { const int kb = r / 24, nb = r % 24, pn = nb >> 3, bj = (nb >> 2) & 1, wc = nb & 3;
                const int c0 = pn < 2 ? 96 * (4 * pn + wc) + 32 * bj : 96 * (4 * bj + wc) + 64;
                p0_transpose_item(w_uq, 768, c0, kb * 64, Wt_uq, 384, nb * 32, q_norm_g, scr, lane); continue; } r -= I_UQ;
            if (r < I_UKV) { const int kb = r / 32, nb = r % 32; int c0;
                if (nb < 16) { const int pn = nb >> 3, bj = (nb >> 2) & 1, wc = nb & 3; c0 = 128 * (4 * pn + wc) + 32 * bj; }
                else { const int ch0 = (nb - 16) * 32; c0 = 128 * (ch0 >> 6) + 64 + (ch0 & 63); }
                p0_transpose_item(w_ukv, 1024, c0, kb * 64, Wt_ukv, 256, nb * 32, nullptr, scr, lane); continue; } r -= I_UKV;
            if (r < I_OUT) { const int kb = r / 32, nb = r % 32; p0_transpose_item(w_out, 1024, nb * 32, kb * 64, Wt_out, 1024, nb * 32, nullptr, scr, lane); continue; } r -= I_OUT;
            if (r < I_FI) { const int kb = r / 176, nb = r % 176, n0 = nb * 32, pn = n0 >> 8, bj = (n0 >> 7) & 1, rr = n0 & 127;
                p0_transpose_item(w_fi, 5632, bj * 2816 + 128 * pn + rr, kb * 64, Wt_fi, 1024, n0, nullptr, scr, lane); continue; } r -= I_FI;
            if (r < I_FO) { const int kb = r / 32, nb = r % 32; p0_transpose_item(w_fo, 1024, nb * 32, kb * 64, Wt_fo, 2816, nb * 32, nullptr, scr, lane); continue; } r -= I_FO;
            if (r < I_CKV) { const int row0 = r * 4, b = row0 >> 11, p = row0 & 2047; f32x4 v[4];
#pragma unroll
                for (int q = 0; q < 4; ++q) v[q] = __builtin_nontemporal_load((const f32x4*)(cache_ckv + (size_t)(row0 + q) * 256) + lane);
#pragma unroll
                for (int q = 0; q < 4; ++q) { u32x2 w; w.x = cvt_pk_bf16(v[q][0], v[q][1]); w.y = cvt_pk_bf16(v[q][2], v[q][3]);
                    *((u32x2*)(CKV + ((size_t)MP + b * 2112 + p + q) * 256) + lane) = w; }
                continue; } r -= I_CKV;
            if (r < I_CKR) { const int row = r * 8 + (lane >> 3), b = row >> 11, p = row & 2047; const f32x4 v = *((const f32x4*)(cache_kr + (size_t)row * 32) + (lane & 7));
                u32x2 w; w.x = cvt_pk_bf16(v[0], v[1]); w.y = cvt_pk_bf16(v[2], v[3]);
                *((u32x2*)(KR + ((size_t)MP + b * 2112 + p) * 32) + (lane & 7)) = w; continue; } r -= I_CKR;
            if (r < I_ROPE) { const int e = r * 64 + lane, pos = e >> 4, j = e & 15;
                const double inv = exp(-(double)j * (1.0 / 16.0) * 9.210340371976184);
                const double rev = (double)pos * inv * 0.15915494309189535; const float fr = (float)(rev - floor(rev));
                ROPE[(size_t)pos * 32 + j] = __builtin_amdgcn_cosf(fr); ROPE[(size_t)pos * 32 + 16 + j] = __builtin_amdgcn_sinf(fr); continue; } r -= I_ROPE;
            { const int e = r * 64 + lane, i = (e >> 7) & 127, j = e & 127; const float v = (j >> 6) <= (i >> 6) ? w_s[e] : 0.f; Wm[e] = (bf16_t)(cvt_pk_bf16(v, 0.f) & 0xffffu); }
        }
    }
    xcd_barrier(xbar);
    if (G == 0x7fffffff) grid.sync();

    { FRESH_IDS();
        int row = bx * 8 + wid; f32x4 nv[4];
        if (row < MT) norm_load(row < MP ? x_p + (size_t)row * DM : x_s + (size_t)(row - MP) * DM, nv, lane);
        for (; row < MT; row += G * 8) {
            f32x4 v[4];
#pragma unroll
            for (int j = 0; j < 4; ++j) v[j] = nv[j];
            const int nr = row + G * 8;
            if (nr < MT) norm_load(nr < MP ? x_p + (size_t)nr * DM : x_s + (size_t)(nr - MP) * DM, nv, lane);
            const int b16 = row < MP ? (row >> 12) : 8 + ((row - MP) >> 6);
            norm_apply(v, norm1_g, MOD + (size_t)b16 * 6144 + 1024, MOD + (size_t)b16 * 6144, Hb + (size_t)row * DM, lane);
        } }
    xcd_barrier(xbar);

    {
        ProgIn P; P.K = 1024; P.lda = 1024; P.ldb = 1024; P.G = G; P.c = bx; P.H = Hb; P.Wt = Wt_in; P.U = Ub; P.Vt = Vt; P.CQ = CQ; P.CKV = CKV; P.KR = KR; P.SSQ = SSQ; P.out = out;
        P.rope = ROPE; P.kvg = kv_norm_g; P.krg = kr_g; P.xl = (LAS float*)(lds + LDS_X);
        pg8::gemm_phase(lds, P);
    }
    xcd_barrier(xbar);

    {
        ProgQ P; P.K = 384; P.lda = 384; P.ldb = 384; P.G = G; P.c = bx; P.CQ = CQ; P.Wt = Wt_uq; P.SSQ = SSQ; P.Q = Qb; P.rope = ROPE; P.qng = qn_g; P.qrg = qr_g;
        pg8::gemm_phase(lds, P);
    }
    {
        ProgKV P; P.K = 256; P.lda = 256; P.ldb = 256; P.G = G; P.c = (G == 256) ? ((bx + 140) & 255) : bx;
        P.CKV = CKV; P.Wt = Wt_ukv; P.KN = KN; P.VVt = VVt; P.kng = kn_g;
        pg8::gemm_phase(lds, P);
    }
    gmlp_phase(lds, (G == 256) ? ((bx + 96) & 255) : bx, G, Wm, Vt, Ub, b_s, YAB);
    xcd_barrier(xbar);

    {
        const int vcu = (G % 8 == 0) ? (bx % 8) * (G / 8) + bx / 8 : bx;
        if (G == 256) {
            const int xcd = bx & 7; unsigned* ctr = (unsigned*)(ws + WS_CTR) + xcd * 64;
            volatile LAS int* qw = (volatile LAS int*)(lds + LDS_X + 8192 + 64);
            int tick = 0; if (threadIdx.x == 0) tick = (int)atomicAdd(ctr, 1u);
            for (int par = 0;; par ^= 1) {
                if (threadIdx.x == 0) qw[par] = tick;
                __syncthreads();
                const int j = qw[par];
                if (j >= 136) break;
                if (j < 96 || j >= 104) { const int jj = j < 96 ? j : j - 104, qb = j < 96 ? 15 - (jj >> 3) : 3 - (jj >> 3), bh = xcd * 8 + (jj & 7), b = bh >> 3, h = bh & 7;
                    const size_t r0 = (size_t)b * 4096 + qb * 256;
                    attn_unit(lds, Qb + r0 * 768, 8, 4 * qb, true, (size_t)b * 4096, 4 * qb + 4, h, KN, KR, VVt, YAB + r0 * DM, ctr, tick);
                } else { const int bh = xcd * 8 + (j - 96), b2 = bh >> 3, h2 = bh & 7; const size_t r0 = (size_t)MP + b2 * 64;
                    attn_unit(lds, Qb + r0 * 768, 2, 0, false, (size_t)MP + b2 * 2112, 33, h2, KN, KR, VVt, YAB + r0 * DM, ctr, tick); }
            }
        } else {
            for (int it = vcu; it < 1024 + 64; it += G) {
                if (it < 1024) { const int bh = it >> 4, qb = it & 15, b = bh >> 3, h = bh & 7;
                    const size_t r0 = (size_t)b * 4096 + qb * 256;
                    { int tk = 0; attn_unit(lds, Qb + r0 * 768, 8, 4 * qb, true, (size_t)b * 4096, 4 * qb + 4, h, KN, KR, VVt, YAB + r0 * DM, nullptr, tk); }
                } else { const int bh = it - 1024, b = bh >> 3, h = bh & 7; const size_t r0 = (size_t)MP + b * 64;
                    { int tk = 0; attn_unit(lds, Qb + r0 * 768, 2, 0, false, (size_t)MP + b * 2112, 33, h, KN, KR, VVt, YAB + r0 * DM, nullptr, tk); } }
            }
        }
    }
    xcd_barrier(xbar);

    {
        ProgRes<0> P; P.K = 1024; P.lda = 1024; P.ldb = 1024; P.G = G; P.c = bx; P.Ab = YAB; P.Wt = Wt_out; P.xp = x_p; P.Y = out; P.X1 = X1B; P.gate = MOD + 2048; P.part = PART; P.nsk = 4;
        pg8::gemm_phase(lds, P);
    }
    xcd_barrier(xbar);

    { FRESH_IDS();
        int row = bx * 8 + wid; f32x4 nv[4];
        if (row < MP) row_load_bf16(X1B + (size_t)row * DM, nv, lane);
        for (; row < MP; row += G * 8) {
            f32x4 v[4];
#pragma unroll
            for (int j = 0; j < 4; ++j) v[j] = nv[j];
            const int nr = row + G * 8;
            if (nr < MP) row_load_bf16(X1B + (size_t)nr * DM, nv, lane);
            const int b16 = row >> 12;
            norm_apply(v, norm2_g, MOD + (size_t)b16 * 6144 + 4096, MOD + (size_t)b16 * 6144 + 3072, Hb + (size_t)row * DM, lane);
        }
        for (int sr = ((bx + 128) % G) * 8 + wid; sr < MS; sr += G * 8) { const int b16 = 8 + (sr >> 6); f32x4 v[4];
            norm_load(x_s + (size_t)sr * DM, v, lane);
            sample_combine(MOD + (size_t)b16 * 6144 + 2048, PART, 4, sr, v, lane);
            row_store_bf16(X1B + (size_t)(MP + sr) * DM, v, lane);
            row_load_bf16(X1B + (size_t)(MP + sr) * DM, v, lane);
            norm_apply(v, norm2_g, MOD + (size_t)b16 * 6144 + 4096, MOD + (size_t)b16 * 6144 + 3072, Hb + (size_t)(MP + sr) * DM, lane);
        } }
    xcd_barrier(xbar);

    {
        ProgFfn P; P.K = 1024; P.lda = 1024; P.ldb = 1024; P.G = G; P.c = bx; P.Ab = Hb; P.Wt = Wt_fi; P.Gb = Gb;
        pg8::gemm_phase(lds, P);
    }
    xcd_barrier(xbar);

    {
        ProgRes<1> P; P.K = DFF; P.lda = DFF; P.ldb = DFF; P.G = G; P.c = bx; P.Ab = Gb; P.Wt = Wt_fo; P.xp = nullptr; P.Y = out; P.X1 = X1B; P.gate = MOD + 5120; P.part = PART; P.nsk = 11;
        pg8::gemm_phase(lds, P);
    }
    xcd_barrier(xbar);

    { FRESH_IDS();
        for (int sr = bx * 8 + wid; sr < MS; sr += G * 8) { const int b16 = 8 + (sr >> 6); f32x4 v[4];
            row_load_bf16(X1B + (size_t)(MP + sr) * DM, v, lane);
            sample_combine(MOD + (size_t)b16 * 6144 + 5120, PART, 11, sr, v, lane);
#pragma unroll
            for (int j = 0; j < 4; ++j) *((f32x4*)(out + (size_t)(MP + sr) * DM) + lane + 64 * j) = v[j]; } }
}

extern "C" void kernel_launch(void* const* d_in, const int* in_sizes, int n_in, void* d_out, int out_size, void* d_ws, size_t ws_size, hipStream_t stream) {
    static int grid = 0;
    if (grid == 0) {
        if (n_in != 24 || ws_size < WS_END) { fprintf(stderr, "kernel_launch: unexpected n_in %d / ws_size %zu (need %zu)\n", n_in, ws_size, (size_t)WS_END); grid = -1; return; }
        int dev = 0, cus = 0, per_cu = 0;
        hipGetDevice(&dev); hipDeviceGetAttribute(&cus, hipDeviceAttributeMultiprocessorCount, dev);
        if (hipFuncSetAttribute((const void*)mega_fwd, hipFuncAttributeMaxDynamicSharedMemorySize, LDS_BYTES) != hipSuccess) { fprintf(stderr, "kernel_launch: hipFuncSetAttribute failed\n"); grid = -1; return; }
        if (hipOccupancyMaxActiveBlocksPerMultiprocessor(&per_cu, (const void*)mega_fwd, 512, LDS_BYTES) != hipSuccess || per_cu < 1) { fprintf(stderr, "kernel_launch: occupancy query gave %d\n", per_cu); per_cu = 1; }
        (void)hipGetLastError();
        grid = cus;
        fprintf(stderr, "kernel_launch: grid %d (cus %d, per_cu %d)\n", grid, cus, per_cu);
    }
    if (grid < 0) return;
    if (hipMemsetAsync((char*)d_ws + WS_BAR, 0, 32768, stream) != hipSuccess) { fprintf(stderr, "kernel_launch: memset of control words failed\n"); return; }
    Args a{};
    for (int i = 0; i < 24; ++i) a.in[i] = (const float*)d_in[i];
    a.out = (float*)d_out; a.ws = (unsigned char*)d_ws;
    void* args[] = {&a};
    hipError_t e = hipLaunchCooperativeKernel((const void*)mega_fwd, dim3(grid), dim3(512), args, LDS_BYTES, stream);
    if (e != hipSuccess) fprintf(stderr, "kernel_launch: cooperative launch failed: %s (grid %d)\n", hipGetErrorString(e), grid);
}
```
